# Optimizing an MI355X kernel written in HIP

```python
import jax, jax.numpy as jnp
from jax import lax
import numpy as np

D_MODEL = 1024
BATCH = 8
SEQ = 4096
DEPTH = 1

RWKV_HEADS = 8
RWKV_HEAD_DIM = 64
RWKV_DIM = RWKV_HEADS * RWKV_HEAD_DIM
DECAY_LORA = 64
AAA_LORA = 64
GATE_LORA = 128
RWKV_PROJ = 3 * RWKV_DIM + DECAY_LORA + AAA_LORA + GATE_LORA
LNX_EPS = 64e-5

SWA_Q_HEADS = 8
SWA_KV_HEADS = 2
SWA_GROUP = SWA_Q_HEADS // SWA_KV_HEADS
SWA_HEAD_DIM = 64
SWA_DIM = SWA_Q_HEADS * SWA_HEAD_DIM
SWA_KV_DIM = SWA_KV_HEADS * SWA_HEAD_DIM
SWA_PROJ = SWA_DIM + 2 * SWA_KV_DIM
WINDOW = 128
Q_BLOCK = 128
ALIBI_MAX = 8.0

MEM_LEN = 256
MEM_HEADS = 4
MEM_HEAD_DIM = 128
MEM_DIM = MEM_HEADS * MEM_HEAD_DIM

N_BRANCH = 3
BRANCH_DIM = 512
IN_PROJ = RWKV_PROJ + SWA_PROJ + MEM_DIM

N_EXPERTS = 32
TOP_K = 4
D_FF = 1024
SWIGLU_ALPHA = 1.702
SWIGLU_LIMIT = 7.0
EXPERT_BLOCK = 128

NORM_EPS = 1e-5

kernel_name = 'hybrid_rwkv7_swa_mem_moe_block'


def rms_norm(x, w):
    xf = x.astype(jnp.float32)
    y = xf * lax.rsqrt(jnp.mean(xf * xf, axis=-1, keepdims=True) + NORM_EPS)
    return (y * w).astype(x.dtype)


def token_shift_lerp(p, mu):
    prev = jnp.pad(p, ((0, 0), (1, 0), (0, 0)))[:, :-1]
    return p + (prev - p) * mu


def rwkv7_recurrence(r, decay, k, v, a, b):
    Bsz, T, H, N = r.shape

    def step(S, inp):
        r_t, w_t, k_t, v_t, a_t, b_t = inp
        Sa = jnp.einsum('bhvk,bhk->bhv', S, a_t)
        S = (S * w_t[:, :, None, :] + Sa[..., None] * b_t[:, :, None, :]
             + v_t[..., None] * k_t[:, :, None, :])
        return S, jnp.einsum('bhvk,bhk->bhv', S, r_t)

    xs = tuple(jnp.swapaxes(z, 0, 1) for z in (r, decay, k, v, a, b))
    S0 = jnp.zeros((Bsz, H, N, N), jnp.float32)
    _, y = lax.scan(step, S0, xs)
    return jnp.swapaxes(y, 0, 1)


def rwkv7_branch(p, mu, w0, w2, a0, a2, g2, k_k, k_a, r_k, lnx_w, lnx_b):
    Bsz, T, _ = p.shape
    f32 = jnp.float32
    p = token_shift_lerp(p, mu)
    r, k, v, pw, pa, pg = jnp.split(
        p, [RWKV_DIM, 2 * RWKV_DIM, 3 * RWKV_DIM, 3 * RWKV_DIM + DECAY_LORA,
            3 * RWKV_DIM + DECAY_LORA + AAA_LORA], axis=-1)
    w_log = -jax.nn.softplus(-(w0 + jnp.tanh(pw) @ w2).astype(f32)) - 0.5
    decay = jnp.exp(-jnp.exp(w_log))
    a = jax.nn.sigmoid((a0 + pa @ a2).astype(f32))
    g = jax.nn.sigmoid(pg) @ g2

    def heads(z):
        return z.astype(f32).reshape(Bsz, T, RWKV_HEADS, RWKV_HEAD_DIM)

    kk = heads(k * k_k)
    kk = kk / jnp.maximum(jnp.linalg.norm(kk, axis=-1, keepdims=True), 1e-12)
    k = k.astype(f32) * (1.0 + (a - 1.0) * k_a)
    rh, kh, vh, ah = heads(r), heads(k), heads(v), heads(a)
    y = rwkv7_recurrence(rh, heads(decay), kh, vh, -kk, kk * ah)
    m = jnp.mean(y, axis=-1, keepdims=True)
    var = jnp.mean(jnp.square(y - m), axis=-1, keepdims=True)
    y = ((y - m) * lax.rsqrt(var + LNX_EPS)).reshape(Bsz, T, RWKV_DIM) * lnx_w + lnx_b
    bonus = jnp.sum(rh * kh * r_k, axis=-1, keepdims=True) * vh
    y = y + bonus.reshape(Bsz, T, RWKV_DIM)
    return (y * g).astype(p.dtype)


def alibi_slopes(n_heads):
    return 2.0 ** (-ALIBI_MAX * jnp.arange(1, n_heads + 1, dtype=jnp.float32) / n_heads)


def swa_sink_alibi_branch(p, sinks):
    Bsz, T, _ = p.shape
    nb = T // Q_BLOCK
    f32 = jnp.float32
    q, k, v = jnp.split(p, [SWA_DIM, SWA_DIM + SWA_KV_DIM], axis=-1)
    q = q.reshape(Bsz, nb, Q_BLOCK, SWA_KV_HEADS, SWA_GROUP, SWA_HEAD_DIM)

    def band(z):
        z = z.reshape(Bsz, T, SWA_KV_HEADS, SWA_HEAD_DIM)
        prev = jnp.pad(z, ((0, 0), (Q_BLOCK, 0), (0, 0), (0, 0)))[:, :T]
        shp = (Bsz, nb, Q_BLOCK, SWA_KV_HEADS, SWA_HEAD_DIM)
        return jnp.concatenate([prev.reshape(shp), z.reshape(shp)], axis=2)

    kb, vb = band(k), band(v)
    scores = jnp.einsum('bnqhgd,bnkhd->bnhgqk', q, kb).astype(f32) * (SWA_HEAD_DIM ** -0.5)
    i = jnp.arange(Q_BLOCK)[:, None]
    j = jnp.arange(2 * Q_BLOCK)[None, :]
    dist = i + Q_BLOCK - j
    s_pos = jnp.arange(nb)[:, None, None] * Q_BLOCK - Q_BLOCK + j[None]
    valid = (dist >= 0) & (dist < WINDOW) & (s_pos >= 0)
    slopes = alibi_slopes(SWA_Q_HEADS).reshape(SWA_KV_HEADS, SWA_GROUP)
    scores = scores - slopes[:, :, None, None] * dist.astype(f32)
    scores = jnp.where(valid[None, :, None, None], scores, -jnp.inf)
    sink = jnp.broadcast_to(sinks.astype(f32).reshape(SWA_KV_HEADS, SWA_GROUP, 1, 1),
                            scores.shape[:-1] + (1,))
    probs = jax.nn.softmax(jnp.concatenate([scores, sink], axis=-1), axis=-1)[..., :-1]
    out = jnp.einsum('bnhgqk,bnkhd->bnqhgd', probs.astype(p.dtype), vb)
    return out.reshape(Bsz, T, SWA_DIM)


def memory_cross_branch(q, mem_n, w_mem_kv):
    Bsz, T, _ = q.shape
    M = mem_n.shape[1]
    km, vm = jnp.split(mem_n @ w_mem_kv, 2, axis=-1)
    qh = q.reshape(Bsz, T, MEM_HEADS, MEM_HEAD_DIM)
    km = km.reshape(Bsz, M, MEM_HEADS, MEM_HEAD_DIM)
    vm = vm.reshape(Bsz, M, MEM_HEADS, MEM_HEAD_DIM)
    scores = jnp.einsum('bthd,bmhd->bhtm', qh, km).astype(jnp.float32) * (MEM_HEAD_DIM ** -0.5)
    probs = jax.nn.softmax(scores, axis=-1).astype(q.dtype)
    return jnp.einsum('bhtm,bmhd->bthd', probs, vm).reshape(Bsz, T, MEM_DIM)


def hybrid_mixer(xn, mem_n, w_in, b_swa, rwkv_mu, rwkv_w0, rwkv_w2, rwkv_a0, rwkv_a2,
                 rwkv_g2, rwkv_kk, rwkv_ka, rwkv_rk, rwkv_lnx_w, rwkv_lnx_b, swa_sinks,
                 w_mem_kv, w_gate, w_branch, w_out):
    p = xn @ w_in
    p_rwkv, p_swa, p_mem = jnp.split(p, [RWKV_PROJ, RWKV_PROJ + SWA_PROJ], axis=-1)
    y_rwkv = rwkv7_branch(p_rwkv, rwkv_mu, rwkv_w0, rwkv_w2, rwkv_a0, rwkv_a2, rwkv_g2,
                          rwkv_kk, rwkv_ka, rwkv_rk, rwkv_lnx_w, rwkv_lnx_b)
    y_swa = swa_sink_alibi_branch(p_swa + b_swa, swa_sinks)
    y_mem = memory_cross_branch(p_mem, mem_n, w_mem_kv)
    branches = (y_rwkv, y_swa, y_mem)
    merged = jax.nn.sigmoid(xn @ w_gate[0]) * (branches[0] @ w_branch[0])
    for bi in range(1, N_BRANCH):
        merged = merged + jax.nn.sigmoid(xn @ w_gate[bi]) * (branches[bi] @ w_branch[bi])
    return merged @ w_out


def clamped_swiglu(h):
    h_glu, h_lin = h[..., ::2], h[..., 1::2]
    h_glu = jnp.minimum(h_glu, SWIGLU_LIMIT)
    h_lin = jnp.clip(h_lin, -SWIGLU_LIMIT, SWIGLU_LIMIT)
    return h_glu * jax.nn.sigmoid(SWIGLU_ALPHA * h_glu) * (h_lin + 1.0)


def sparse_moe(xn, w_router, b_router, w1, b1, w2, b2):
    Bsz, T, D = xn.shape
    xt = xn.reshape(-1, D)
    N = xt.shape[0]
    logits = (xt @ w_router + b_router).astype(jnp.float32)
    top_vals, top_idx = lax.top_k(logits, TOP_K)
    gates = jax.nn.softmax(top_vals, axis=-1)
    A = N * TOP_K
    flat_e = top_idx.reshape(-1).astype(jnp.int32)
    flat_tok = jnp.arange(A, dtype=jnp.int32) // TOP_K
    flat_g = gates.reshape(-1).astype(xt.dtype)
    order = jnp.argsort(flat_e)
    e_sorted = flat_e[order]
    counts = jnp.bincount(flat_e, length=N_EXPERTS)
    starts = jnp.cumsum(counts) - counts
    padded = ((counts + EXPERT_BLOCK - 1) // EXPERT_BLOCK) * EXPERT_BLOCK
    pad_ends = jnp.cumsum(padded)
    pad_starts = pad_ends - padded
    dest = pad_starts[e_sorted] + (jnp.arange(A, dtype=jnp.int32) - starts[e_sorted])
    n_blocks = -(-A // EXPERT_BLOCK) + N_EXPERTS
    P = n_blocks * EXPERT_BLOCK
    slot_tok = jnp.full((P,), N, jnp.int32).at[dest].set(flat_tok[order])
    slot_g = jnp.zeros((P,), xt.dtype).at[dest].set(flat_g[order])
    block_e = jnp.minimum(
        jnp.searchsorted(pad_ends, jnp.arange(n_blocks) * EXPERT_BLOCK, side='right'),
        N_EXPERTS - 1)
    x_pad = jnp.concatenate([xt, jnp.zeros((1, D), xt.dtype)], axis=0)

    def run_block(args):
        tok, e = args
        h = x_pad[tok] @ w1[e] + b1[e]
        return clamped_swiglu(h) @ w2[e] + b2[e]

    y = lax.map(run_block, (slot_tok.reshape(n_blocks, EXPERT_BLOCK), block_e))
    y = y.reshape(P, D) * slot_g[:, None]
    out = jnp.zeros((N + 1, D), y.dtype).at[slot_tok].add(y)[:N]
    return out.reshape(Bsz, T, D)


def setup_inputs(seed: int = 0) -> dict:
    key = jax.random.key(seed)
    ks = jax.random.split(key, 30)
    f32 = jnp.float32
    L, D = DEPTH, D_MODEL

    def nrm(i, shape, scale):
        return jax.random.normal(ks[i], shape, f32) * scale

    def unif(i, shape, lo, hi):
        return jax.random.uniform(ks[i], shape, f32, lo, hi)

    return {
        'x': nrm(0, (BATCH, SEQ, D), 1.0),
        'mem': nrm(1, (BATCH, MEM_LEN, D), 1.0),
        'attn_norm_w': 1.0 + nrm(2, (L, D), 0.02),
        'mem_norm_w': 1.0 + nrm(3, (L, D), 0.02),
        'w_in': nrm(4, (L, D, IN_PROJ), D ** -0.5),
        'b_swa': nrm(5, (L, SWA_PROJ), 0.01),
        'rwkv_mu': unif(6, (L, RWKV_PROJ), 0.0, 1.0),
        'rwkv_w0': unif(7, (L, RWKV_DIM), -6.0, 1.0),
        'rwkv_w2': nrm(8, (L, DECAY_LORA, RWKV_DIM), 0.1 * DECAY_LORA ** -0.5),
        'rwkv_a0': nrm(9, (L, RWKV_DIM), 0.1),
        'rwkv_a2': nrm(10, (L, AAA_LORA, RWKV_DIM), 0.1 * AAA_LORA ** -0.5),
        'rwkv_g2': nrm(11, (L, GATE_LORA, RWKV_DIM), GATE_LORA ** -0.5),
        'rwkv_kk': 0.85 + nrm(12, (L, RWKV_DIM), 0.02),
        'rwkv_ka': 1.0 + nrm(13, (L, RWKV_DIM), 0.02),
        'rwkv_rk': nrm(14, (L, RWKV_HEADS, RWKV_HEAD_DIM), 0.1),
        'rwkv_lnx_w': 1.0 + nrm(15, (L, RWKV_DIM), 0.02),
        'rwkv_lnx_b': nrm(16, (L, RWKV_DIM), 0.01),
        'swa_sinks': nrm(17, (L, SWA_Q_HEADS), 1.0),
        'w_mem_kv': nrm(18, (L, D, 2 * MEM_DIM), D ** -0.5),
        'w_gate': nrm(19, (L, N_BRANCH, D, D), D ** -0.5),
        'w_branch': nrm(20, (L, N_BRANCH, BRANCH_DIM, D), BRANCH_DIM ** -0.5),
        'w_out': nrm(21, (L, D, D), D ** -0.5),
        'ffn_norm_w': 1.0 + nrm(22, (L, D), 0.02),
        'w_router': nrm(23, (L, D, N_EXPERTS), D ** -0.5),
        'b_router': nrm(24, (L, N_EXPERTS), 0.01),
        'w_exp1': nrm(25, (L, N_EXPERTS, D, 2 * D_FF), D ** -0.5),
        'b_exp1': nrm(26, (L, N_EXPERTS, 2 * D_FF), 0.01),
        'w_exp2': nrm(27, (L, N_EXPERTS, D_FF, D), D_FF ** -0.5),
        'b_exp2': nrm(28, (L, N_EXPERTS, D), 0.01),
        'final_norm_w': 1.0 + nrm(29, (D,), 0.02),
    }


def reference(x, mem, attn_norm_w, mem_norm_w, w_in, b_swa, rwkv_mu, rwkv_w0, rwkv_w2,
              rwkv_a0, rwkv_a2, rwkv_g2, rwkv_kk, rwkv_ka, rwkv_rk, rwkv_lnx_w, rwkv_lnx_b,
              swa_sinks, w_mem_kv, w_gate, w_branch, w_out, ffn_norm_w, w_router, b_router,
              w_exp1, b_exp1, w_exp2, b_exp2, final_norm_w):
    h = x
    for l in range(DEPTH):
        xn = rms_norm(h, attn_norm_w[l])
        mem_n = rms_norm(mem, mem_norm_w[l])
        h = h + hybrid_mixer(xn, mem_n, w_in[l], b_swa[l], rwkv_mu[l], rwkv_w0[l], rwkv_w2[l],
                             rwkv_a0[l], rwkv_a2[l], rwkv_g2[l], rwkv_kk[l], rwkv_ka[l],
                             rwkv_rk[l], rwkv_lnx_w[l], rwkv_lnx_b[l], swa_sinks[l],
                             w_mem_kv[l], w_gate[l], w_branch[l], w_out[l])
        h = h + sparse_moe(rms_norm(h, ffn_norm_w[l]), w_router[l], b_router[l],
                           w_exp1[l], b_exp1[l], w_exp2[l], b_exp2[l])
    return rms_norm(h, final_norm_w)
```

```cpp
#include <hip/hip_runtime.h>
#include <hip/hip_cooperative_groups.h>
#include <cstdio>
#include <cstdint>
namespace cg = cooperative_groups;

#define LAS __attribute__((address_space(3)))
#define GAS __attribute__((address_space(1)))
typedef unsigned short bf16_t;
typedef short bf16x8 __attribute__((ext_vector_type(8)));
typedef short s16x4 __attribute__((ext_vector_type(4)));
typedef float f32x4 __attribute__((ext_vector_type(4)));
typedef float f32x2 __attribute__((ext_vector_type(2)));
typedef unsigned u32x4 __attribute__((ext_vector_type(4)));
typedef unsigned u32x2 __attribute__((ext_vector_type(2)));

constexpr int BATCH = 8, SEQ = 4096, NTOK = BATCH * SEQ, DM = 1024;
constexpr int RW_PROJ = 1792, SWA_OFF = 1792, MEMQ_OFF = 2560, IN_PROJ = 3072;
constexpr int MEM_LEN = 256, NMEM = BATCH * MEM_LEN;
constexpr int NEXP = 32, TOPK = 4, DFF = 1024;
constexpr int MAXSLOT = NTOK * TOPK + NEXP * 256;
constexpr int NWAVES = 8;

constexpr size_t MiB = 1u << 20;
constexpr size_t WS_CTL = 0, CTL_BYTES = 1 * MiB;
constexpr size_t WS_WBIG = 1 * MiB;
constexpr size_t WS_WMKV = 13 * MiB;
constexpr size_t WS_WBR = 15 * MiB;
constexpr size_t WS_WOUT = 18 * MiB;
constexpr size_t WS_WRW = 20 * MiB;
constexpr size_t WS_MISC = 21 * MiB;
constexpr size_t WS_W2T = 32 * MiB;
constexpr size_t WS_W1T = 96 * MiB;
constexpr size_t WS_YSLOT = 96 * MiB;
constexpr size_t WS_PREP = 224 * MiB;
constexpr size_t WS_R = WS_PREP, WS_KR = WS_PREP + 32 * MiB, WS_V = WS_PREP + 64 * MiB, WS_ASIG = WS_PREP + 96 * MiB, WS_W = WS_PREP + 128 * MiB, WS_LIN = WS_PREP + 192 * MiB;
constexpr size_t WS_MERGED = 224 * MiB;
constexpr size_t WS_HB = 288 * MiB;
constexpr size_t WS_XN = 448 * MiB;
constexpr size_t WS_YB = 448 * MiB;
constexpr size_t WS_MEMN = 544 * MiB;
constexpr size_t WS_KVM = 548 * MiB;
constexpr size_t WS_P = 552 * MiB;
constexpr size_t WS_GATE = 744 * MiB;
constexpr size_t WS_YRAW = 552 * MiB;
constexpr size_t WS_ACT = 552 * MiB;
constexpr size_t WS_END = 936 * MiB;
constexpr size_t MS_RSTD2 = WS_MISC;
constexpr size_t MS_TOKE = WS_MISC + 1 * MiB / 2;
constexpr size_t MS_TOKPOS = WS_MISC + 1 * MiB;
constexpr size_t MS_TOKSLOT = WS_MISC + 3 * MiB / 2;
constexpr size_t MS_TOKG = WS_MISC + 2 * MiB;
constexpr size_t MS_SLOTTOK = WS_MISC + 5 * MiB / 2;
constexpr size_t MS_SLOTG = WS_MISC + 7 * MiB / 2;
constexpr size_t MS_SLOTRS = WS_MISC + 9 * MiB / 2;
constexpr size_t MS_TILEE = WS_MISC + 11 * MiB / 2;
constexpr size_t MS_BONUS = WS_MISC + 6 * MiB;
constexpr size_t MS_WRT = WS_MISC + 7 * MiB;
constexpr int CW_CNT = 64;
constexpr int CW_NTILES = 128;

constexpr int LDS_BYTES = 147456;

__device__ __forceinline__ unsigned f2bf(float f) { unsigned u = __builtin_bit_cast(unsigned, f); return (u + 0x7fffu + ((u >> 16) & 1u)) >> 16; }
__device__ __forceinline__ unsigned pk2(float lo, float hi) { return f2bf(lo) | (f2bf(hi) << 16); }
__device__ __forceinline__ unsigned cvt_pk_bf16(float lo, float hi) { unsigned r; asm volatile("v_cvt_pk_bf16_f32 %0, %1, %2" : "=v"(r) : "v"(lo), "v"(hi)); return r; }
__device__ __forceinline__ float bf_lo(unsigned u) { return __builtin_bit_cast(float, u << 16); }
__device__ __forceinline__ float bf_hi(unsigned u) { return __builtin_bit_cast(float, u & 0xffff0000u); }
__device__ __forceinline__ float bf1(bf16_t u) { return __builtin_bit_cast(float, (unsigned)u << 16); }
__device__ __forceinline__ float fexp(float x) { return __builtin_amdgcn_exp2f(x * 1.44269504f); }
__device__ __forceinline__ float fsigmoid(float x) { return __builtin_amdgcn_rcpf(1.0f + fexp(-x)); }
__device__ __forceinline__ float wave_sum(float v) {
#pragma unroll
    for (int o = 1; o < 64; o <<= 1) v += __shfl_xor(v, o);
    return v;
}
#define LDS_WAIT() asm volatile("s_waitcnt lgkmcnt(0)" ::: "memory")
#define VM_WAIT() asm volatile("s_waitcnt vmcnt(0)" ::: "memory")

namespace pg8 {
constexpr int BM = 256, BK = 64, HALF = 128, HTB = HALF * BK * 2, STAGE_BYTES = 8 * HTB, NXCD = 8, WGM = 8;
__host__ __device__ __forceinline__ int lds_byte(int r, int c) { const int st = (r >> 4) * 2 + (c >> 5), rr = r & 15, cc = c & 31, ob = rr * 64 + cc * 2; return st * 1024 + (ob ^ (((ob >> 9) & 1) << 5)); }
__host__ __device__ __forceinline__ void stage_rc(int b, int& R, int& C) { const int st = b / 1024, sb = b % 1024, swz = sb ^ (((sb >> 9) & 1) << 5); R = (st >> 1) * 16 + swz / 64; C = (st & 1) * 32 + (swz % 64) / 2; }
__host__ __device__ __forceinline__ int perm32(int rho) { const int n = rho >> 4, i = rho & 15; return 8 * (i >> 2) + 4 * n + (i & 3); }

struct Unit { int pm, pn, aux; const char* a; const char* b; };

__device__ __forceinline__ void tile_of(int L, int nM, int nN, int& pm, int& pn) {
    const int nwg = nM * nN; int wgid = L;
    { const int q = nwg / NXCD, r = nwg % NXCD, xcd = wgid % NXCD, off = wgid / NXCD; wgid = (xcd < r ? xcd * (q + 1) : r * (q + 1) + (xcd - r) * q) + off; }
    const int nig = WGM * nN, gid = wgid / nig, fm = gid * WGM, gsz = (nM - fm) < WGM ? (nM - fm) : WGM;
    pm = fm + ((wgid % nig) % gsz); pn = (wgid % nig) / gsz;
}

template <class Epi, class Sched, bool GATHER>
__device__ __forceinline__ void gemm_phase(LAS unsigned char* lds, const int K, const Sched& S, const Epi& E) {
    const int tid = threadIdx.x, wid = __builtin_amdgcn_readfirstlane(tid >> 6), lane = tid & 63, wr = wid >> 2, wc = wid & 3, fr = lane & 15, fq = lane >> 4;
    const int nt = K / BK;
    unsigned voffA[2], voffB[2];
#pragma unroll
    for (int i = 0; i < 2; ++i) { int R, C; stage_rc(tid * 16 + i * 8192, R, C); const int Rb = (R & ~31) + perm32(R & 31); voffA[i] = (unsigned)(R * K + C) * 2u; voffB[i] = (unsigned)(Rb * K + C) * 2u; }
    const size_t kstep = (size_t)(BK * 2);
    const size_t hstep = (size_t)HALF * K * 2;
    const unsigned ldsw = (unsigned)wid * 1024u;
    const int aoff = lds_byte(wr * 64 + fr, fq * 8), boff = lds_byte(wc * 32 + fr, fq * 8);
    LAS unsigned char* tokbuf = lds + STAGE_BYTES + wid * 1024;
#define PG8_SA(b, h) (((b) * 2 + (h)) * HTB)
#define PG8_SB(b, h) ((4 + (b) * 2 + (h)) * HTB)
#define PG8_STAGE(bufoff, gbase, voff) do { _Pragma("unroll") for (int _i = 0; _i < 2; ++_i) \
        __builtin_amdgcn_global_load_lds((const unsigned*)((const char*)(gbase) + (voff)[_i]), (LAS unsigned*)(lds + (bufoff) + ldsw + _i * 8192), 16, 0, 0); } while (0)
#define PG8_STAGE_A(bufoff, gbase, h) do { if constexpr (GATHER) { PG8_STAGE(bufoff, gbase, vG[h]); } else { PG8_STAGE(bufoff, (gbase) + (h) * hstep, voffA); } } while (0)
#define PG8_TOK_DMA(u) do { const int* _tp = S.arow_ptr(u); _Pragma("unroll") for (int _h = 0; _h < 2; ++_h) _Pragma("unroll") for (int _i = 0; _i < 2; ++_i) { int _R, _C; stage_rc(tid * 16 + _i * 8192, _R, _C); \
        __builtin_amdgcn_global_load_lds((const unsigned*)(_tp + _h * HALF + _R), (LAS unsigned*)(tokbuf + (_h * 2 + _i) * 256), 4, 0, 0); } } while (0)
#define PG8_TOK_READ() do { _Pragma("unroll") for (int _h = 0; _h < 2; ++_h) _Pragma("unroll") for (int _i = 0; _i < 2; ++_i) { int _R, _C; stage_rc(tid * 16 + _i * 8192, _R, _C); \
        const int _tk = *(const LAS int*)(tokbuf + (_h * 2 + _i) * 256 + lane * 4); vG[_h][_i] = (unsigned)(_tk * K + _C) * 2u; } } while (0)
#define PG8_LDA(dst, b, h) do { _Pragma("unroll") for (int m = 0; m < 4; ++m) _Pragma("unroll") for (int k = 0; k < 2; ++k) dst[m][k] = *(const LAS bf16x8*)(lds + PG8_SA(b, h) + aoff + m * 2048 + k * 1024); } while (0)
#define PG8_LDB(dst, b, h) do { _Pragma("unroll") for (int n = 0; n < 2; ++n) _Pragma("unroll") for (int k = 0; k < 2; ++k) dst[n][k] = *(const LAS bf16x8*)(lds + PG8_SB(b, h) + boff + n * 2048 + k * 1024); } while (0)
#define PG8_MMA(ai, bj, At, Bt) do { __builtin_amdgcn_s_setprio(1); _Pragma("unroll") for (int m = 0; m < 4; ++m) _Pragma("unroll") for (int n = 0; n < 2; ++n) _Pragma("unroll") for (int k = 0; k < 2; ++k) \
        acc[ai][bj][m][n] = __builtin_amdgcn_mfma_f32_16x16x32_bf16(Bt[n][k], At[m][k], acc[ai][bj][m][n], 0, 0, 0); __builtin_amdgcn_s_setprio(0); } while (0)
#define PG8_WAIT_V(n) asm volatile("s_waitcnt vmcnt(" #n ")" ::: "memory")
#define PG8_WAIT_L(n) asm volatile("s_waitcnt lgkmcnt(" #n ")" ::: "memory")
#define PG8_BAR __builtin_amdgcn_s_barrier()
#define PG8_SCHED __builtin_amdgcn_sched_barrier(0)
    Unit cur, nxt; int ui = 0;
    if (!S.next(0, cur)) return;
    unsigned vG[2][2] = {{0u, 0u}, {0u, 0u}};
    if constexpr (GATHER) { PG8_TOK_DMA(cur); PG8_WAIT_V(0); PG8_TOK_READ(); PG8_WAIT_L(0); }
    f32x4 acc[2][2][4][2];
#pragma unroll
    for (int a = 0; a < 2; ++a)
#pragma unroll
        for (int b = 0; b < 2; ++b)
#pragma unroll
            for (int m = 0; m < 4; ++m)
#pragma unroll
                for (int n = 0; n < 2; ++n) acc[a][b][m][n] = (f32x4){0.f, 0.f, 0.f, 0.f};
    bf16x8 At[4][2], B0[2][2], B1[2][2];
    const char* cA = cur.a; const char* cB = cur.b;
    PG8_STAGE(PG8_SB(0, 0), cB, voffB); PG8_STAGE(PG8_SB(0, 1), cB + hstep, voffB); PG8_STAGE_A(PG8_SA(0, 0), cA, 0); PG8_STAGE_A(PG8_SA(0, 1), cA, 1);
    if (wr == 1) PG8_BAR;
    PG8_WAIT_V(2); PG8_BAR;
    PG8_STAGE(PG8_SB(1, 0), cB + kstep, voffB); PG8_STAGE_A(PG8_SA(1, 0), cA + kstep, 0); PG8_STAGE(PG8_SB(1, 1), cB + hstep + kstep, voffB);
    PG8_WAIT_V(6); PG8_BAR;
    for (;;) {
        const bool has_next = S.next(ui + 1, nxt);
        const char* nA = has_next ? nxt.a : cA; const char* nB = has_next ? nxt.b : cB;
        if constexpr (GATHER) { if (has_next) PG8_TOK_DMA(nxt); }
        for (int t = 0; t < nt; t += 2) {
            const bool last = (t == nt - 2);
            const char* a1 = cA + (size_t)(t + 1) * kstep;
            const char* a2 = last ? nA : cA + (size_t)(t + 2) * kstep; const char* b2 = last ? nB : cB + (size_t)(t + 2) * kstep;
            const char* a3 = a2 + kstep; const char* b3 = b2 + kstep;
            PG8_LDB(B0, 0, 0); PG8_LDB(B1, 0, 1); PG8_SCHED; PG8_LDA(At, 0, 0); PG8_STAGE_A(PG8_SA(1, 1), a1, 1);
            if constexpr (GATHER) { if (last && has_next) PG8_TOK_READ(); }
            PG8_WAIT_V(8); PG8_WAIT_L(0); PG8_BAR; PG8_MMA(0, 0, At, B0); PG8_MMA(0, 1, At, B1); PG8_BAR; PG8_SCHED;
            PG8_LDA(At, 0, 1); PG8_STAGE(PG8_SB(0, 0), b2, voffB); PG8_STAGE(PG8_SB(0, 1), b2 + hstep, voffB); PG8_STAGE_A(PG8_SA(0, 0), a2, 0);
            PG8_WAIT_V(8); PG8_WAIT_L(0); PG8_BAR; PG8_MMA(1, 0, At, B0); PG8_MMA(1, 1, At, B1); PG8_BAR; PG8_SCHED;
            PG8_LDB(B0, 1, 0); PG8_LDB(B1, 1, 1); PG8_SCHED; PG8_LDA(At, 1, 0); PG8_STAGE_A(PG8_SA(0, 1), a2, 1);
            PG8_WAIT_V(8); PG8_WAIT_L(0); PG8_BAR; PG8_MMA(0, 0, At, B0); PG8_MMA(0, 1, At, B1); PG8_BAR; PG8_SCHED;
            PG8_LDA(At, 1, 1); PG8_STAGE(PG8_SB(1, 0), b3, voffB); PG8_STAGE(PG8_SB(1, 1), b3 + hstep, voffB); PG8_STAGE_A(PG8_SA(1, 0), a3, 0);
            PG8_WAIT_V(8); PG8_WAIT_L(0); PG8_BAR; PG8_MMA(1, 0, At, B0); PG8_MMA(1, 1, At, B1); PG8_BAR; PG8_SCHED;
        }
        if (wr == 0) PG8_BAR;
        E(acc, cur, wr, wc, fr, fq);
        if (!has_next) break;
#pragma unroll
        for (int a = 0; a < 2; ++a)
#pragma unroll
            for (int b = 0; b < 2; ++b)
#pragma unroll
                for (int m = 0; m < 4; ++m)
#pragma unroll
                    for (int n = 0; n < 2; ++n) acc[a][b][m][n] = (f32x4){0.f, 0.f, 0.f, 0.f};
        cur = nxt; cA = nA; cB = nB; ++ui;
        if (wr == 1) PG8_BAR;
    }
    PG8_WAIT_V(0);
    PG8_BAR;
#undef PG8_SA
#undef PG8_SB
#undef PG8_STAGE
#undef PG8_STAGE_A
#undef PG8_TOK_DMA
#undef PG8_TOK_READ
#undef PG8_LDA
#undef PG8_LDB
#undef PG8_MMA
#undef PG8_WAIT_V
#undef PG8_WAIT_L
#undef PG8_BAR
#undef PG8_SCHED
}
}
struct DenseSched {
    const char* A; const char* Bt; int nM, nN, K, G, c;
    __device__ __forceinline__ bool next(int i, pg8::Unit& u) const {
        const long L = (long)i * G + c; if (L >= (long)nM * nN) return false;
        pg8::tile_of((int)L, nM, nN, u.pm, u.pn); u.aux = 0;
        u.a = A + (size_t)u.pm * 256 * K * 2; u.b = Bt + (size_t)u.pn * 256 * K * 2; return true;
    }
    __device__ __forceinline__ const int* arow_ptr(const pg8::Unit&) const { return nullptr; }
};
struct BranchSched {
    const char* YB; const char* WBR; int nM, nN, G, c;
    __device__ __forceinline__ bool next(int i, pg8::Unit& u) const {
        const int br = i % 3; const long L = (long)(i / 3) * G + c; if (L >= (long)nM * nN) return false;
        pg8::tile_of((int)L, nM, nN, u.pm, u.pn); u.aux = br;
        u.a = YB + (size_t)br * NTOK * 512 * 2 + (size_t)u.pm * 256 * 512 * 2; u.b = WBR + (size_t)br * 1024 * 512 * 2 + (size_t)u.pn * 256 * 512 * 2; return true;
    }
    __device__ __forceinline__ const int* arow_ptr(const pg8::Unit&) const { return nullptr; }
};
struct MoeSched {
    const char* A; const char* Wt; const int* tile_e; const int* slot_tok; int nM, nN, K, G, c; size_t estride;
    __device__ __forceinline__ bool next(int i, pg8::Unit& u) const {
        const long L = (long)i * G + c; if (L >= (long)nM * nN) return false;
        pg8::tile_of((int)L, nM, nN, u.pm, u.pn); u.aux = tile_e[u.pm];
        u.a = A; u.b = Wt + (size_t)u.aux * estride + (size_t)u.pn * 256 * K * 2; return true;
    }
    __device__ __forceinline__ const int* arow_ptr(const pg8::Unit& u) const { return slot_tok + u.pm * 256; }
};
struct MoeSched2 {
    const char* A; const char* Wt; const int* tile_e; int nM, nN, K, G, c; size_t estride;
    __device__ __forceinline__ bool next(int i, pg8::Unit& u) const {
        const long L = (long)i * G + c; if (L >= (long)nM * nN) return false;
        pg8::tile_of((int)L, nM, nN, u.pm, u.pn); u.aux = tile_e[u.pm];
        u.a = A + (size_t)u.pm * 256 * K * 2; u.b = Wt + (size_t)u.aux * estride + (size_t)u.pn * 256 * K * 2; return true;
    }
    __device__ __forceinline__ const int* arow_ptr(const pg8::Unit&) const { return nullptr; }
};

#define EPI_LOOP_ROWS for (int ai = 0; ai < 2; ++ai) _Pragma("unroll") for (int m = 0; m < 4; ++m)
typedef f32x4 acc_t[2][2][4][2];

struct EpiIn {
    bf16_t* P; bf16_t* GATE; const float* b_swa;
    __device__ __forceinline__ void operator()(const acc_t& acc, const pg8::Unit& u, int wr, int wc, int fr, int fq) const {
        const int row0 = u.pm * 256 + wr * 64 + fr; const int colt = u.pn * 256 + wc * 32 + 8 * fq;
        const bool gate = u.pn >= 12; const bool hasb = (u.pn >= 7 && u.pn < 10);
        bf16_t* base = gate ? GATE + (colt - 3072) : P + colt;
        f32x4 bv[2][2];
#pragma unroll
        for (int bj = 0; bj < 2; ++bj)
#pragma unroll
            for (int n = 0; n < 2; ++n) bv[bj][n] = hasb ? *(const f32x4*)(b_swa + (colt - SWA_OFF) + bj * 128 + 4 * n) : (f32x4){0.f, 0.f, 0.f, 0.f};
#pragma unroll
        EPI_LOOP_ROWS { bf16_t* rowp = base + (size_t)(row0 + ai * 128 + m * 16) * 3072;
#pragma unroll
            for (int bj = 0; bj < 2; ++bj) { f32x4 v0 = acc[ai][bj][m][0] + bv[bj][0], v1 = acc[ai][bj][m][1] + bv[bj][1];
                if (gate) {
#pragma unroll
                    for (int j = 0; j < 4; ++j) { v0[j] = fsigmoid(v0[j]); v1[j] = fsigmoid(v1[j]); } }
                u32x4 w; w.x = cvt_pk_bf16(v0[0], v0[1]); w.y = cvt_pk_bf16(v0[2], v0[3]); w.z = cvt_pk_bf16(v1[0], v1[1]); w.w = cvt_pk_bf16(v1[2], v1[3]);
                *(u32x4*)(rowp + bj * 128) = w; } }
    }
};
struct EpiPlain {
    bf16_t* O; int ldc;
    __device__ __forceinline__ void operator()(const acc_t& acc, const pg8::Unit& u, int wr, int wc, int fr, int fq) const {
        const int row0 = u.pm * 256 + wr * 64 + fr; const int colt = u.pn * 256 + wc * 32 + 8 * fq;
#pragma unroll
        EPI_LOOP_ROWS { bf16_t* rowp = O + (size_t)(row0 + ai * 128 + m * 16) * ldc + colt;
#pragma unroll
            for (int bj = 0; bj < 2; ++bj) { const f32x4 v0 = acc[ai][bj][m][0], v1 = acc[ai][bj][m][1];
                u32x4 w; w.x = cvt_pk_bf16(v0[0], v0[1]); w.y = cvt_pk_bf16(v0[2], v0[3]); w.z = cvt_pk_bf16(v1[0], v1[1]); w.w = cvt_pk_bf16(v1[2], v1[3]);
                *(u32x4*)(rowp + bj * 128) = w; } }
    }
};
struct EpiLora {
    unsigned char* ws; const float* w0; const float* a0;
    __device__ __forceinline__ void operator()(const acc_t& acc, const pg8::Unit& u, int wr, int wc, int fr, int fq) const {
        const int row0 = u.pm * 256 + wr * 64 + fr; const int colt = (u.pn & 1) * 256 + wc * 32 + 8 * fq; const int kind = u.pn >> 1;
        f32x4 bv[2][2];
#pragma unroll
        for (int bj = 0; bj < 2; ++bj)
#pragma unroll
            for (int n = 0; n < 2; ++n) bv[bj][n] = kind == 0 ? *(const f32x4*)(w0 + colt + bj * 128 + 4 * n) : (kind == 1 ? *(const f32x4*)(a0 + colt + bj * 128 + 4 * n) : (f32x4){0.f, 0.f, 0.f, 0.f});
#pragma unroll
        EPI_LOOP_ROWS { const size_t ro = (size_t)(row0 + ai * 128 + m * 16) * 512 + colt;
#pragma unroll
            for (int bj = 0; bj < 2; ++bj) { f32x4 v0 = acc[ai][bj][m][0] + bv[bj][0], v1 = acc[ai][bj][m][1] + bv[bj][1];
                if (kind == 0) {
#pragma unroll
                    for (int j = 0; j < 4; ++j) { v0[j] = fexp(-0.60653066f * fsigmoid(v0[j])); v1[j] = fexp(-0.60653066f * fsigmoid(v1[j])); }
                    float* W = (float*)(ws + WS_W); *(f32x4*)(W + ro + bj * 128) = v0; *(f32x4*)(W + ro + bj * 128 + 4) = v1;
                } else {
                    if (kind == 1) {
#pragma unroll
                        for (int j = 0; j < 4; ++j) { v0[j] = fsigmoid(v0[j]); v1[j] = fsigmoid(v1[j]); } }
                    u32x4 w; w.x = cvt_pk_bf16(v0[0], v0[1]); w.y = cvt_pk_bf16(v0[2], v0[3]); w.z = cvt_pk_bf16(v1[0], v1[1]); w.w = cvt_pk_bf16(v1[2], v1[3]);
                    const size_t bo = (kind == 1) ? WS_ASIG : WS_YB; *(u32x4*)((bf16_t*)(ws + bo) + ro + bj * 128) = w; } } }
    }
};
struct EpiBranch {
    bf16_t* MERGED; const bf16_t* GATE;
    __device__ __forceinline__ void operator()(const acc_t& acc, const pg8::Unit& u, int wr, int wc, int fr, int fq) const {
        const int row0 = u.pm * 256 + wr * 64 + fr; const int colt = u.pn * 256 + wc * 32 + 8 * fq; const int br = u.aux;
#pragma unroll
        EPI_LOOP_ROWS { const size_t r = (size_t)(row0 + ai * 128 + m * 16);
#pragma unroll
            for (int bj = 0; bj < 2; ++bj) { const int c = colt + bj * 128;
                const u32x4 g = *(const u32x4*)(GATE + r * 3072 + br * 1024 + c);
                u32x4 old = (u32x4){0u, 0u, 0u, 0u}; if (br != 0) old = *(const u32x4*)(MERGED + r * 1024 + c);
                const f32x4 v0 = acc[ai][bj][m][0], v1 = acc[ai][bj][m][1];
                u32x4 w;
                w.x = cvt_pk_bf16(bf_lo(old.x) + bf_lo(g.x) * v0[0], bf_hi(old.x) + bf_hi(g.x) * v0[1]);
                w.y = cvt_pk_bf16(bf_lo(old.y) + bf_lo(g.y) * v0[2], bf_hi(old.y) + bf_hi(g.y) * v0[3]);
                w.z = cvt_pk_bf16(bf_lo(old.z) + bf_lo(g.z) * v1[0], bf_hi(old.z) + bf_hi(g.z) * v1[1]);
                w.w = cvt_pk_bf16(bf_lo(old.w) + bf_lo(g.w) * v1[2], bf_hi(old.w) + bf_hi(g.w) * v1[3]);
                *(u32x4*)(MERGED + r * 1024 + c) = w; } }
    }
};
struct EpiOut {
    const float* X; float* H1;
    __device__ __forceinline__ void operator()(const acc_t& acc, const pg8::Unit& u, int wr, int wc, int fr, int fq) const {
        const int row0 = u.pm * 256 + wr * 64 + fr; const int colt = u.pn * 256 + wc * 32 + 8 * fq;
#pragma unroll
        EPI_LOOP_ROWS { const size_t ro = (size_t)(row0 + ai * 128 + m * 16) * 1024 + colt;
#pragma unroll
            for (int bj = 0; bj < 2; ++bj) {
                const f32x4 x0 = *(const f32x4*)(X + ro + bj * 128), x1 = *(const f32x4*)(X + ro + bj * 128 + 4);
                *(f32x4*)(H1 + ro + bj * 128) = x0 + acc[ai][bj][m][0]; *(f32x4*)(H1 + ro + bj * 128 + 4) = x1 + acc[ai][bj][m][1]; } }
    }
};
struct EpiUp {
    bf16_t* ACT; const float* b1; const float* slot_rs;
    __device__ __forceinline__ void operator()(const acc_t& acc, const pg8::Unit& u, int wr, int wc, int fr, int fq) const {
        const int row0 = u.pm * 256 + wr * 64 + fr; const int colt = u.pn * 256 + wc * 32 + 8 * fq;
        const float* bb = b1 + (size_t)u.aux * 2048 + colt;
        f32x4 bv[2][2];
#pragma unroll
        for (int bj = 0; bj < 2; ++bj)
#pragma unroll
            for (int n = 0; n < 2; ++n) bv[bj][n] = *(const f32x4*)(bb + bj * 128 + 4 * n);
#pragma unroll
        EPI_LOOP_ROWS { const int r = row0 + ai * 128 + m * 16; const float rs = slot_rs[r];
#pragma unroll
            for (int bj = 0; bj < 2; ++bj) { const f32x4 v0 = acc[ai][bj][m][0] * rs + bv[bj][0], v1 = acc[ai][bj][m][1] * rs + bv[bj][1];
                float o[4];
#pragma unroll
                for (int p = 0; p < 4; ++p) { float gl = p < 2 ? v0[2 * p] : v1[2 * p - 4], ln = p < 2 ? v0[2 * p + 1] : v1[2 * p - 3];
                    gl = fminf(gl, 7.0f); ln = fminf(fmaxf(ln, -7.0f), 7.0f); o[p] = gl * fsigmoid(1.702f * gl) * (ln + 1.0f); }
                u32x2 w; w.x = cvt_pk_bf16(o[0], o[1]); w.y = cvt_pk_bf16(o[2], o[3]);
                *(u32x2*)(ACT + (size_t)r * 1024 + ((colt + bj * 128) >> 1)) = w; } }
    }
};
struct EpiDown {
    bf16_t* YS; const float* b2; const float* slot_g;
    __device__ __forceinline__ void operator()(const acc_t& acc, const pg8::Unit& u, int wr, int wc, int fr, int fq) const {
        const int row0 = u.pm * 256 + wr * 64 + fr; const int colt = u.pn * 256 + wc * 32 + 8 * fq;
        const float* bb = b2 + (size_t)u.aux * 1024 + colt;
        f32x4 bv[2][2];
#pragma unroll
        for (int bj = 0; bj < 2; ++bj)
#pragma unroll
            for (int n = 0; n < 2; ++n) bv[bj][n] = *(const f32x4*)(bb + bj * 128 + 4 * n);
#pragma unroll
        EPI_LOOP_ROWS { const int r = row0 + ai * 128 + m * 16; const float g = slot_g[r];
#pragma unroll
            for (int bj = 0; bj < 2; ++bj) { const f32x4 v0 = (acc[ai][bj][m][0] + bv[bj][0]) * g, v1 = (acc[ai][bj][m][1] + bv[bj][1]) * g;
                u32x4 w; w.x = cvt_pk_bf16(v0[0], v0[1]); w.y = cvt_pk_bf16(v0[2], v0[3]); w.z = cvt_pk_bf16(v1[0], v1[1]); w.w = cvt_pk_bf16(v1[2], v1[3]);
                *(u32x4*)(YS + (size_t)r * 1024 + colt + bj * 128) = w; } }
    }
};
struct Args {
    const float* in[30]; float* out; unsigned char* ws; int ph_lo, ph_hi;
};
typedef __attribute__((address_space(4))) const unsigned char* kptr_t;
__device__ __forceinline__ kptr_t karg_at(int off) { asm volatile("" : "+s"(off)); return (kptr_t)__builtin_amdgcn_kernarg_segment_ptr() + off; }
struct KA {
    __device__ __forceinline__ const float* in(int i) const { return *(const float* const __attribute__((address_space(4)))*)karg_at(8 * i); }
    __device__ __forceinline__ float* out() const { return *(float* const __attribute__((address_space(4)))*)karg_at(240); }
    __device__ __forceinline__ unsigned char* ws() const { return *(unsigned char* const __attribute__((address_space(4)))*)karg_at(248); }
    __device__ __forceinline__ int ph_lo() const { return *(const int __attribute__((address_space(4)))*)karg_at(256); }
    __device__ __forceinline__ int ph_hi() const { return *(const int __attribute__((address_space(4)))*)karg_at(260); }
};
struct Ctx {
    LAS unsigned char* lds; int G, bid;
};
struct Ids { int tid, lane, wave; };
__device__ __forceinline__ Ids get_ids() { int t = threadIdx.x; asm volatile("" : "+v"(t)); Ids I; I.tid = t; I.lane = t & 63; I.wave = __builtin_amdgcn_readfirstlane(t >> 6); return I; }

__device__ __forceinline__ void p0_transpose_item(const float* W, int K, int N, bf16_t* WT, int row_off, const float* ksc, LAS float* scr, int item, int lane) {
    const int nblk = N / 32, kb = item / nblk, nb = item % nblk, k0 = 64 * kb, n0 = 32 * nb;
#pragma unroll 8
    for (int i = 0; i < 32; ++i) { const int kk = 2 * i + (lane >> 5); float v = W[(size_t)(k0 + kk) * N + n0 + (lane & 31)]; if (ksc) v *= ksc[k0 + kk]; scr[kk * 33 + (lane & 31)] = v; }
    LDS_WAIT(); asm volatile("" ::: "memory");
    const int c = lane & 7;
#pragma unroll
    for (int j = 0; j < 4; ++j) { const int n = (lane >> 3) + 8 * j; const LAS float* s = scr + (8 * c) * 33 + n;
        u32x4 o; o.x = pk2(s[0 * 33], s[1 * 33]); o.y = pk2(s[2 * 33], s[3 * 33]); o.z = pk2(s[4 * 33], s[5 * 33]); o.w = pk2(s[6 * 33], s[7 * 33]);
        *(u32x4*)(WT + (size_t)(row_off + n0 + n) * K + k0 + 8 * c) = o; }
    LDS_WAIT(); asm volatile("" ::: "memory");
}
__device__ __forceinline__ void rms_row_to_bf16(const float* xrow, const float* w, bf16_t* orow, int lane) {
    const f32x4* xr = (const f32x4*)xrow + lane; const f32x4* wr = (const f32x4*)w + lane;
    f32x4 v[4]; float s = 0.f;
#pragma unroll
    for (int j = 0; j < 4; ++j) { v[j] = xr[64 * j]; s += (v[j].x * v[j].x + v[j].y * v[j].y) + (v[j].z * v[j].z + v[j].w * v[j].w); }
    const float rstd = 1.f / sqrtf(wave_sum(s) * (1.f / 1024.f) + 1e-5f);
    u32x2* o8 = (u32x2*)orow + lane;
#pragma unroll
    for (int j = 0; j < 4; ++j) { const f32x4 ww = wr[64 * j]; u32x2 o; o.x = pk2(v[j].x * rstd * ww.x, v[j].y * rstd * ww.y); o.y = pk2(v[j].z * rstd * ww.z, v[j].w * rstd * ww.w); o8[64 * j] = o; }
}
__device__ __forceinline__ void phase0(const KA& a, const Ctx& C) {
    const Ids I = get_ids();
    unsigned char* ws = a.ws();
    LAS float* scr = (LAS float*)(C.lds + I.wave * 16384);
    const int gw = C.bid * NWAVES + I.wave, NGW = C.G * NWAVES;
    bf16_t* WBIG = (bf16_t*)(ws + WS_WBIG); bf16_t* WMKV = (bf16_t*)(ws + WS_WMKV); bf16_t* WBR = (bf16_t*)(ws + WS_WBR); bf16_t* WOUT = (bf16_t*)(ws + WS_WOUT);
    bf16_t* W1T = (bf16_t*)(ws + WS_W1T); bf16_t* W2T = (bf16_t*)(ws + WS_W2T);
    constexpr int I_IN = 16 * 96, I_G = 16 * 32, I_MKV = 16 * 32, I_BR = 8 * 32, I_OUT = 16 * 32, I_E1 = 16 * 64, I_E2 = 16 * 32;
    constexpr int NITEMS = I_IN + 3 * I_G + I_MKV + 3 * I_BR + I_OUT + NEXP * I_E1 + NEXP * I_E2;
    for (int it = gw; it < NITEMS; it += NGW) {
        int r = it;
        if (r < I_IN) { p0_transpose_item(a.in(4), 1024, 3072, WBIG, 0, nullptr, scr, r, I.lane); continue; } r -= I_IN;
        if (r < 3 * I_G) { const int g = r / I_G; p0_transpose_item(a.in(19) + (size_t)g * 1024 * 1024, 1024, 1024, WBIG, 3072 + 1024 * g, nullptr, scr, r % I_G, I.lane); continue; } r -= 3 * I_G;
        if (r < I_MKV) { p0_transpose_item(a.in(18), 1024, 1024, WMKV, 0, nullptr, scr, r, I.lane); continue; } r -= I_MKV;
        if (r < 3 * I_BR) { const int g = r / I_BR; p0_transpose_item(a.in(20) + (size_t)g * 512 * 1024, 512, 1024, WBR + (size_t)g * 1024 * 512, 0, nullptr, scr, r % I_BR, I.lane); continue; } r -= 3 * I_BR;
        if (r < I_OUT) { p0_transpose_item(a.in(21), 1024, 1024, WOUT, 0, nullptr, scr, r, I.lane); continue; } r -= I_OUT;
        if (r < NEXP * I_E1) { const int e = r / I_E1; p0_transpose_item(a.in(25) + (size_t)e * 1024 * 2048, 1024, 2048, W1T + (size_t)e * 2048 * 1024, 0, a.in(22), scr, r % I_E1, I.lane); continue; } r -= NEXP * I_E1;
        { const int e = r / I_E2; p0_transpose_item(a.in(27) + (size_t)e * 1024 * 1024, 1024, 1024, W2T + (size_t)e * 1024 * 1024, 0, nullptr, scr, r % I_E2, I.lane); }
    }
    { bf16_t* WRW = (bf16_t*)(ws + WS_WRW); const float* w2 = a.in(8); const float* a2 = a.in(10); const float* g2 = a.in(11);
      for (int i = C.bid * 512 + I.tid; i < 1536 * 256; i += C.G * 512) { const int n = i >> 8, k = i & 255; float v = 0.f;
          if (n < 512) { if (k < 64) v = w2[k * 512 + n]; } else if (n < 1024) { if (k >= 64 && k < 128) v = a2[(k - 64) * 512 + (n - 512)]; } else { if (k >= 128) v = g2[(k - 128) * 512 + (n - 1024)]; }
          WRW[i] = (bf16_t)f2bf(v); } }
    { bf16_t* WRT = (bf16_t*)(ws + MS_WRT); const float* wr = a.in(23); const float* fw = a.in(22);
      for (int i = C.bid * 512 + I.tid; i < 32 * 1024; i += C.G * 512) { const int e = i >> 10, k = i & 1023; const float v = wr[k * 32 + e] * fw[k];
          const unsigned hi = f2bf(v); const float lo = v - __builtin_bit_cast(float, hi << 16); WRT[i] = (bf16_t)hi; WRT[32 * 1024 + i] = (bf16_t)f2bf(lo); } }
    bf16_t* XN = (bf16_t*)(ws + WS_XN); bf16_t* MEMN = (bf16_t*)(ws + WS_MEMN);
    for (int m = gw; m < NTOK; m += NGW) rms_row_to_bf16(a.in(0) + (size_t)m * 1024, a.in(2), XN + (size_t)m * 1024, I.lane);
    for (int m = gw; m < NMEM; m += NGW) rms_row_to_bf16(a.in(1) + (size_t)m * 1024, a.in(3), MEMN + (size_t)m * 1024, I.lane);
}

__device__ __forceinline__ void phase_lerp(const KA& a, const Ctx& C) {
    const Ids I = get_ids();
    unsigned char* ws = a.ws();
    const bf16_t* P = (const bf16_t*)(ws + WS_P); const float* mu = a.in(6);
    bf16_t* R = (bf16_t*)(ws + WS_R); bf16_t* KR = (bf16_t*)(ws + WS_KR); bf16_t* V = (bf16_t*)(ws + WS_V); bf16_t* LIN = (bf16_t*)(ws + WS_LIN);
    const int gw = C.bid * NWAVES + I.wave, NGW = C.G * NWAVES;
    for (int m = gw; m < NTOK; m += NGW) {
        const bool has_prev = (m & (SEQ - 1)) != 0;
        const bf16_t* cur = P + (size_t)m * 3072;
#pragma unroll
        for (int it = 0; it < 4; ++it) { const int c = I.lane + 64 * it;
            if (c < 224) { const int col0 = c * 8;
                const u32x4 pa = *(const u32x4*)(cur + col0); u32x4 pb = (u32x4){0u, 0u, 0u, 0u}; if (has_prev) pb = *(const u32x4*)(cur - 3072 + col0);
                const f32x4 m0 = *(const f32x4*)(mu + col0), m1 = *(const f32x4*)(mu + col0 + 4);
                float v[8];
                v[0] = bf_lo(pa.x) + (bf_lo(pb.x) - bf_lo(pa.x)) * m0[0]; v[1] = bf_hi(pa.x) + (bf_hi(pb.x) - bf_hi(pa.x)) * m0[1];
                v[2] = bf_lo(pa.y) + (bf_lo(pb.y) - bf_lo(pa.y)) * m0[2]; v[3] = bf_hi(pa.y) + (bf_hi(pb.y) - bf_hi(pa.y)) * m0[3];
                v[4] = bf_lo(pa.z) + (bf_lo(pb.z) - bf_lo(pa.z)) * m1[0]; v[5] = bf_hi(pa.z) + (bf_hi(pb.z) - bf_hi(pa.z)) * m1[1];
                v[6] = bf_lo(pa.w) + (bf_lo(pb.w) - bf_lo(pa.w)) * m1[2]; v[7] = bf_hi(pa.w) + (bf_hi(pb.w) - bf_hi(pa.w)) * m1[3];
                bf16_t* dst;
                if (col0 < 512) dst = R + (size_t)m * 512 + col0;
                else if (col0 < 1024) dst = KR + (size_t)m * 512 + (col0 - 512);
                else if (col0 < 1536) dst = V + (size_t)m * 512 + (col0 - 1024);
                else { dst = LIN + (size_t)m * 256 + (col0 - 1536);
                    if (col0 < 1600) {
#pragma unroll
                        for (int j = 0; j < 8; ++j) { const float e2 = fexp(2.0f * v[j]); v[j] = 1.0f - 2.0f * __builtin_amdgcn_rcpf(e2 + 1.0f); }
                    } else if (col0 >= 1664) {
#pragma unroll
                        for (int j = 0; j < 8; ++j) v[j] = fsigmoid(v[j]);
                    } }
                u32x4 o; o.x = pk2(v[0], v[1]); o.y = pk2(v[2], v[3]); o.z = pk2(v[4], v[5]); o.w = pk2(v[6], v[7]);
                *(u32x4*)dst = o; } }
    }
}

__device__ __forceinline__ s16x4 vtr(LAS const unsigned char* p) { typedef short v4i16_t __attribute__((ext_vector_type(4))); return __builtin_bit_cast(s16x4, __builtin_amdgcn_ds_read_tr16_b64_v4i16((LAS v4i16_t*)p)); }
template <int DH, int NKT, int KP, bool SWA>
__device__ __forceinline__ void attn_qtile(const bf16x8 (&qf)[DH / 32], LAS const unsigned char* Kl, LAS const unsigned char* Vl, int lane, float scale,
                                           int t, int s0, int smin, float slope, float sink, f32x4 (&o)[DH / 16]) {
    const int fr = lane & 15, fq = lane >> 4;
    f32x4 s[NKT];
#pragma unroll
    for (int kt = 0; kt < NKT; ++kt) { s[kt] = (f32x4){0.f, 0.f, 0.f, 0.f};
#pragma unroll
        for (int ks = 0; ks < DH / 32; ++ks) { const bf16x8 kf = *(const LAS bf16x8*)(Kl + (kt * 16 + fr) * KP + (ks * 32 + fq * 8) * 2);
            s[kt] = __builtin_amdgcn_mfma_f32_16x16x32_bf16(kf, qf[ks], s[kt], 0, 0, 0); } }
    float mx = -1e30f;
#pragma unroll
    for (int kt = 0; kt < NKT; ++kt)
#pragma unroll
        for (int r = 0; r < 4; ++r) { float v = s[kt][r] * scale;
            if (SWA) { const int sp = s0 + kt * 16 + fq * 4 + r; const int dist = t - sp; const bool valid = (dist >= 0) && (dist < 128) && (sp >= smin); v = valid ? v - slope * (float)dist : -1e30f; }
            s[kt][r] = v; mx = fmaxf(mx, v); }
    mx = fmaxf(mx, __shfl_xor(mx, 16)); mx = fmaxf(mx, __shfl_xor(mx, 32));
    if (SWA) mx = fmaxf(mx, sink);
    float sum = 0.f;
#pragma unroll
    for (int kt = 0; kt < NKT; ++kt)
#pragma unroll
        for (int r = 0; r < 4; ++r) { const float p = fexp(s[kt][r] - mx); s[kt][r] = p; sum += p; }
    sum += __shfl_xor(sum, 16); sum += __shfl_xor(sum, 32);
    if (SWA) sum += fexp(sink - mx);
    const float inv = 1.0f / sum;
#pragma unroll
    for (int dt = 0; dt < DH / 16; ++dt) o[dt] = (f32x4){0.f, 0.f, 0.f, 0.f};
    const int q4 = fr >> 2, p4 = fr & 3;
#pragma unroll
    for (int c = 0; c < NKT / 2; ++c) {
        u32x4 pw; pw.x = cvt_pk_bf16(s[2 * c][0], s[2 * c][1]); pw.y = cvt_pk_bf16(s[2 * c][2], s[2 * c][3]); pw.z = cvt_pk_bf16(s[2 * c + 1][0], s[2 * c + 1][1]); pw.w = cvt_pk_bf16(s[2 * c + 1][2], s[2 * c + 1][3]);
        const bf16x8 pf = __builtin_bit_cast(bf16x8, pw);
#pragma unroll
        for (int dt = 0; dt < DH / 16; ++dt) {
            const s16x4 lo = vtr(Vl + (c * 32 + fq * 4 + q4) * KP + (dt * 16 + p4 * 4) * 2);
            const s16x4 hi = vtr(Vl + (c * 32 + 16 + fq * 4 + q4) * KP + (dt * 16 + p4 * 4) * 2);
            bf16x8 vf; vf[0] = lo[0]; vf[1] = lo[1]; vf[2] = lo[2]; vf[3] = lo[3]; vf[4] = hi[0]; vf[5] = hi[1]; vf[6] = hi[2]; vf[7] = hi[3];
            o[dt] = __builtin_amdgcn_mfma_f32_16x16x32_bf16(vf, pf, o[dt], 0, 0, 0); } }
#pragma unroll
    for (int dt = 0; dt < DH / 16; ++dt) o[dt] = o[dt] * inv;
}

__device__ __forceinline__ void phase_swa(const KA& a, const Ctx& C) {
    const Ids I = get_ids();
    unsigned char* ws = a.ws();
    const bf16_t* P = (const bf16_t*)(ws + WS_P); bf16_t* Y = (bf16_t*)(ws + WS_YB) + (size_t)1 * NTOK * 512; const float* sinks = a.in(17);
    constexpr int KP = 144, ROWS = 272;
    LAS unsigned char* Kl = C.lds; LAS unsigned char* Vl = C.lds + ROWS * KP;
    for (int u = C.bid; u < BATCH * 2 * 32; u += C.G) {
        const int qb = u & 31, hk = (u >> 5) & 1, b = u >> 6;
        const int pos0 = qb * 128 - 128;
        __syncthreads();
        for (int i = I.tid; i < ROWS * 8 * 2; i += 512) { const int which = i >= ROWS * 8; const int j = which ? i - ROWS * 8 : i; const int r = j >> 3, ch = j & 7; const int pos = pos0 + r;
            u32x4 v = (u32x4){0u, 0u, 0u, 0u};
            if (pos >= 0 && r < 256) v = *(const u32x4*)(P + (size_t)(b * SEQ + pos) * 3072 + SWA_OFF + 512 + which * 128 + hk * 64 + ch * 8);
            *(LAS u32x4*)((which ? Vl : Kl) + r * KP + ch * 16) = v; }
        __syncthreads();
        const int g = I.wave >> 1, half = I.wave & 1, h = hk * 4 + g;
        const float slope = __builtin_amdgcn_exp2f(-(float)(h + 1)); const float sink = sinks[h];
        const int fr = I.lane & 15, fq = I.lane >> 4;
#pragma unroll 1
        for (int qt = 0; qt < 4; ++qt) {
            const int trel = half * 64 + qt * 16;
            const int tq = qb * 128 + trel + fr;
            const bf16_t* qrow = P + (size_t)(b * SEQ + tq) * 3072 + SWA_OFF + h * 64;
            bf16x8 qf[2]; qf[0] = *(const bf16x8*)(qrow + fq * 8); qf[1] = *(const bf16x8*)(qrow + 32 + fq * 8);
            f32x4 o[4];
            attn_qtile<64, 10, KP, true>(qf, Kl + trel * KP, Vl + trel * KP, I.lane, 0.125f, tq, pos0 + trel, 0, slope, sink, o);
            bf16_t* yrow = Y + (size_t)(b * SEQ + tq) * 512 + h * 64;
#pragma unroll
            for (int dt = 0; dt < 4; ++dt) { u32x2 w; w.x = cvt_pk_bf16(o[dt][0], o[dt][1]); w.y = cvt_pk_bf16(o[dt][2], o[dt][3]); *(u32x2*)(yrow + dt * 16 + fq * 4) = w; }
        }
    }
    __syncthreads();
}

__device__ __forceinline__ void phase_mem(const KA& a, const Ctx& C) {
    const Ids I = get_ids();
    unsigned char* ws = a.ws();
    const bf16_t* P = (const bf16_t*)(ws + WS_P); const bf16_t* KVM = (const bf16_t*)(ws + WS_KVM); bf16_t* Y = (bf16_t*)(ws + WS_YB) + (size_t)2 * NTOK * 512;
    constexpr int KP = 272, ROWS = 256;
    LAS unsigned char* Kl = C.lds; LAS unsigned char* Vl = C.lds + ROWS * KP;
    for (int u = C.bid; u < BATCH * 4 * 8; u += C.G) {
        const int qb = u & 7, h = (u >> 3) & 3, b = u >> 5;
        __syncthreads();
        for (int i = I.tid; i < ROWS * 16 * 2; i += 512) { const int which = i >= ROWS * 16; const int j = which ? i - ROWS * 16 : i; const int r = j >> 4, ch = j & 15;
            const u32x4 v = *(const u32x4*)(KVM + (size_t)(b * MEM_LEN + r) * 1024 + which * 512 + h * 128 + ch * 8);
            *(LAS u32x4*)((which ? Vl : Kl) + r * KP + ch * 16) = v; }
        __syncthreads();
        const int fr = I.lane & 15, fq = I.lane >> 4;
#pragma unroll 1
        for (int qt = 0; qt < 4; ++qt) {
            const int tq = qb * 512 + I.wave * 64 + qt * 16 + fr;
            const bf16_t* qrow = P + (size_t)(b * SEQ + tq) * 3072 + MEMQ_OFF + h * 128;
            bf16x8 qf[4];
#pragma unroll
            for (int ks = 0; ks < 4; ++ks) qf[ks] = *(const bf16x8*)(qrow + ks * 32 + fq * 8);
            f32x4 o[8];
            attn_qtile<128, 16, KP, false>(qf, Kl, Vl, I.lane, 0.08838834764831845f, 0, 0, 0, 0.f, 0.f, o);
            bf16_t* yrow = Y + (size_t)(b * SEQ + tq) * 512 + h * 128;
#pragma unroll
            for (int dt = 0; dt < 8; ++dt) { u32x2 w; w.x = cvt_pk_bf16(o[dt][0], o[dt][1]); w.y = cvt_pk_bf16(o[dt][2], o[dt][3]); *(u32x2*)(yrow + dt * 16 + fq * 4) = w; }
        }
    }
    __syncthreads();
}
__device__ __forceinline__ float dpp_add16(float x) {
    x += __builtin_bit_cast(float, __builtin_amdgcn_update_dpp(0, __builtin_bit_cast(int, x), 0xB1, 0xF, 0xF, true));
    x += __builtin_bit_cast(float, __builtin_amdgcn_update_dpp(0, __builtin_bit_cast(int, x), 0x4E, 0xF, 0xF, true));
    x += __builtin_bit_cast(float, __builtin_amdgcn_update_dpp(0, __builtin_bit_cast(int, x), 0x124, 0xF, 0xF, true));
    x += __builtin_bit_cast(float, __builtin_amdgcn_update_dpp(0, __builtin_bit_cast(int, x), 0x128, 0xF, 0xF, true));
    return x;
}
__device__ __forceinline__ void phase_rwkv(const KA& a, const Ctx& C) {
    const Ids I = get_ids();
    unsigned char* ws = a.ws();
    const bf16_t* R = (const bf16_t*)(ws + WS_R); const bf16_t* KR = (const bf16_t*)(ws + WS_KR); const bf16_t* V = (const bf16_t*)(ws + WS_V); const bf16_t* ASIG = (const bf16_t*)(ws + WS_ASIG);
    const float* W = (const float*)(ws + WS_W); float* YRAW = (float*)(ws + WS_YRAW); float* BONUS = (float*)(ws + MS_BONUS);
    const float* k_k = a.in(12); const float* k_a = a.in(13); const float* r_k = a.in(14);
    constexpr int TC = 32, NCH = SEQ / TC;
    LAS float* SEQB = (LAS float*)C.lds;
    LAS float* VB = (LAS float*)(C.lds + 2 * TC * 5 * 64 * 4);
    LAS float* YO = VB + 2 * TC * 16;
    for (int item = C.bid; item < BATCH * 8 * 4; item += C.G) {
        const int rg = item & 3, h = (item >> 2) & 7, b = item >> 5;
        const int colh = h * 64; const size_t row0 = (size_t)b * SEQ;
        const bool loader = I.wave >= 4; const int lw = I.wave - 4;
        const int ch = I.lane;
        float kkc = 0.f, kac = 0.f, rkc = 0.f;
        if (loader) { kkc = k_k[colh + ch]; kac = k_a[colh + ch]; rkc = r_k[colh + ch]; }
        float st0 = 0.f, st1 = 0.f, st2 = 0.f, st3 = 0.f;
        const int crow = I.tid >> 4, kq = I.tid & 15;
        __syncthreads();
#pragma unroll 1
        for (int c = -1; c < NCH; ++c) {
            if (loader) {
                if (c + 1 < NCH) {
                    const int buf = (c + 1) & 1;
#pragma unroll 2
                    for (int i = 0; i < 8; ++i) { const int tl = lw * 8 + i; const size_t m = row0 + (size_t)(c + 1) * TC + tl; const size_t o = m * 512 + colh + ch;
                        const float r = bf1(R[o]), kr = bf1(KR[o]), as = bf1(ASIG[o]), w = W[o];
                        const float kkv = kr * kkc; const float n2 = wave_sum(kkv * kkv); const float kkn = kkv / fmaxf(sqrtf(n2), 1e-12f);
                        const float kmod = kr * (1.0f + (as - 1.0f) * kac);
                        const float bs = wave_sum(r * kmod * rkc);
                        LAS float* d = SEQB + ((buf * TC + tl) * 5) * 64 + ch;
                        d[0] = w; d[64] = -kkn; d[128] = kkn * as; d[192] = kmod; d[256] = r;
                        if (ch < 16) VB[(buf * TC + tl) * 16 + ch] = bf1(V[m * 512 + colh + rg * 16 + ch]);
                        if (rg == 0 && ch == 0) BONUS[m * 8 + h] = bs; }
                }
                if (c >= 1) {
                    const int buf = (c - 1) & 1; const int lt = I.tid - 256;
#pragma unroll
                    for (int i = 0; i < 2; ++i) { const int e = lt + 256 * i; const int tl = e >> 4, rr = e & 15;
                        YRAW[(row0 + (size_t)(c - 1) * TC + tl) * 512 + colh + rg * 16 + rr] = YO[(buf * TC + tl) * 16 + rr]; }
                }
            } else if (c >= 0) {
                const int buf = c & 1;
#pragma unroll 4
                for (int tl = 0; tl < TC; ++tl) {
                    const LAS float* d = SEQB + ((buf * TC + tl) * 5) * 64 + kq * 4;
                    const f32x4 w4 = *(const LAS f32x4*)(d), a4 = *(const LAS f32x4*)(d + 64), b4 = *(const LAS f32x4*)(d + 128), k4 = *(const LAS f32x4*)(d + 192), r4 = *(const LAS f32x4*)(d + 256);
                    const float vv = VB[(buf * TC + tl) * 16 + crow];
                    float sa = (st0 * a4[0] + st1 * a4[1]) + (st2 * a4[2] + st3 * a4[3]);
                    const float t0 = st0 * w4[0] + vv * k4[0], t1 = st1 * w4[1] + vv * k4[1], t2 = st2 * w4[2] + vv * k4[2], t3 = st3 * w4[3] + vv * k4[3];
                    sa = dpp_add16(sa);
                    st0 = t0 + sa * b4[0]; st1 = t1 + sa * b4[1]; st2 = t2 + sa * b4[2]; st3 = t3 + sa * b4[3];
                    float y = (st0 * r4[0] + st1 * r4[1]) + (st2 * r4[2] + st3 * r4[3]);
                    y = dpp_add16(y);
                    if (kq == 0) YO[(buf * TC + tl) * 16 + crow] = y;
                }
            }
            __syncthreads();
        }
        if (loader) {
            const int buf = (NCH - 1) & 1; const int lt = I.tid - 256;
#pragma unroll
            for (int i = 0; i < 2; ++i) { const int e = lt + 256 * i; const int tl = e >> 4, rr = e & 15;
                YRAW[(row0 + (size_t)(NCH - 1) * TC + tl) * 512 + colh + rg * 16 + rr] = YO[(buf * TC + tl) * 16 + rr]; }
        }
    }
    __syncthreads();
}

__device__ __forceinline__ void phase_gn(const KA& a, const Ctx& C) {
    const Ids I = get_ids();
    unsigned char* ws = a.ws();
    const float* YRAW = (const float*)(ws + WS_YRAW); const float* BONUS = (const float*)(ws + MS_BONUS); const bf16_t* V = (const bf16_t*)(ws + WS_V);
    bf16_t* Y0 = (bf16_t*)(ws + WS_YB);
    const float* lw = a.in(15); const float* lb = a.in(16);
    const int gw = C.bid * NWAVES + I.wave, NGW = C.G * NWAVES;
    for (int task = gw; task < NTOK * 8; task += NGW) {
        const int m = task >> 3, h = task & 7; const size_t o = (size_t)m * 512 + h * 64 + I.lane;
        const float y = YRAW[o];
        const float mean = wave_sum(y) * (1.0f / 64.0f); const float d = y - mean; const float var = wave_sum(d * d) * (1.0f / 64.0f);
        float yn = d * (1.0f / sqrtf(var + 64e-5f)) * lw[h * 64 + I.lane] + lb[h * 64 + I.lane];
        yn += BONUS[m * 8 + h] * bf1(V[o]);
        Y0[o] = (bf16_t)f2bf(yn * bf1(Y0[o]));
    }
}

__device__ __forceinline__ void phase_router(const KA& a, const Ctx& C) {
    const Ids I = get_ids();
    unsigned char* ws = a.ws();
    const float* H1 = a.out(); bf16_t* HB = (bf16_t*)(ws + WS_HB); const bf16_t* WRT = (const bf16_t*)(ws + MS_WRT); const float* b_router = a.in(24);
    float* RSTD2 = (float*)(ws + MS_RSTD2); int* TOKE = (int*)(ws + MS_TOKE); int* TOKPOS = (int*)(ws + MS_TOKPOS); float* TOKG = (float*)(ws + MS_TOKG);
    unsigned* cnt = (unsigned*)(ws + WS_CTL) + CW_CNT;
    LAS float* LG = (LAS float*)(C.lds + I.wave * 2304);
    const int gw = C.bid * NWAVES + I.wave, NGW = C.G * NWAVES;
    const int fr = I.lane & 15, fq = I.lane >> 4;
    for (int grp = gw; grp < NTOK / 16; grp += NGW) {
        const int m = grp * 16 + fr;
        const float* hrow = H1 + (size_t)m * 1024; bf16_t* hb = HB + (size_t)m * 1024;
        f32x4 acc0 = (f32x4){0.f, 0.f, 0.f, 0.f}, acc1 = acc0; float ss = 0.f;
#pragma unroll 2
        for (int ks = 0; ks < 32; ++ks) { const int k0 = ks * 32 + fq * 8;
            const f32x4 x0 = *(const f32x4*)(hrow + k0), x1 = *(const f32x4*)(hrow + k0 + 4);
            ss += (x0[0] * x0[0] + x0[1] * x0[1]) + (x0[2] * x0[2] + x0[3] * x0[3]) + (x1[0] * x1[0] + x1[1] * x1[1]) + (x1[2] * x1[2] + x1[3] * x1[3]);
            u32x4 hi; hi.x = pk2(x0[0], x0[1]); hi.y = pk2(x0[2], x0[3]); hi.z = pk2(x1[0], x1[1]); hi.w = pk2(x1[2], x1[3]);
            *(u32x4*)(hb + k0) = hi;
            u32x4 lo; lo.x = pk2(x0[0] - bf_lo(hi.x), x0[1] - bf_hi(hi.x)); lo.y = pk2(x0[2] - bf_lo(hi.y), x0[3] - bf_hi(hi.y)); lo.z = pk2(x1[0] - bf_lo(hi.z), x1[1] - bf_hi(hi.z)); lo.w = pk2(x1[2] - bf_lo(hi.w), x1[3] - bf_hi(hi.w));
            const bf16x8 ah = __builtin_bit_cast(bf16x8, hi), al = __builtin_bit_cast(bf16x8, lo);
            const bf16x8 wh0 = *(const bf16x8*)(WRT + (size_t)fr * 1024 + k0), wh1 = *(const bf16x8*)(WRT + (size_t)(fr + 16) * 1024 + k0);
            const bf16x8 wl0 = *(const bf16x8*)(WRT + 32 * 1024 + (size_t)fr * 1024 + k0), wl1 = *(const bf16x8*)(WRT + 32 * 1024 + (size_t)(fr + 16) * 1024 + k0);
            acc0 = __builtin_amdgcn_mfma_f32_16x16x32_bf16(ah, wh0, acc0, 0, 0, 0); acc0 = __builtin_amdgcn_mfma_f32_16x16x32_bf16(ah, wl0, acc0, 0, 0, 0); acc0 = __builtin_amdgcn_mfma_f32_16x16x32_bf16(al, wh0, acc0, 0, 0, 0);
            acc1 = __builtin_amdgcn_mfma_f32_16x16x32_bf16(ah, wh1, acc1, 0, 0, 0); acc1 = __builtin_amdgcn_mfma_f32_16x16x32_bf16(ah, wl1, acc1, 0, 0, 0); acc1 = __builtin_amdgcn_mfma_f32_16x16x32_bf16(al, wh1, acc1, 0, 0, 0);
        }
        ss += __shfl_xor(ss, 16); ss += __shfl_xor(ss, 32);
        const float rstd = 1.0f / sqrtf(ss * (1.0f / 1024.0f) + 1e-5f);
#pragma unroll
        for (int r = 0; r < 4; ++r) { LG[(fq * 4 + r) * 36 + fr] = acc0[r]; LG[(fq * 4 + r) * 36 + 16 + fr] = acc1[r]; }
        LDS_WAIT(); asm volatile("" ::: "memory");
        if (I.lane < 16) {
            float lg[32];
#pragma unroll
            for (int e = 0; e < 32; ++e) lg[e] = LG[fr * 36 + e] * rstd + b_router[e];
            int sel[4]; float sv[4];
#pragma unroll
            for (int j = 0; j < 4; ++j) { float best = -3.0e38f; int bi = 0;
#pragma unroll
                for (int e = 0; e < 32; ++e) { const bool take = lg[e] > best; best = take ? lg[e] : best; bi = take ? e : bi; }
                sel[j] = bi; sv[j] = best;
#pragma unroll
                for (int e = 0; e < 32; ++e) lg[e] = (e == bi) ? -3.0e38f : lg[e]; }
            const float e0 = 1.0f, e1 = fexp(sv[1] - sv[0]), e2 = fexp(sv[2] - sv[0]), e3 = fexp(sv[3] - sv[0]); const float inv = 1.0f / (e0 + e1 + e2 + e3);
            const float gt[4] = {e0 * inv, e1 * inv, e2 * inv, e3 * inv};
            RSTD2[m] = rstd;
#pragma unroll
            for (int j = 0; j < 4; ++j) { const unsigned pos = atomicAdd(cnt + sel[j], 1u); TOKE[m * 4 + j] = sel[j]; TOKPOS[m * 4 + j] = (int)pos; TOKG[m * 4 + j] = gt[j]; }
        }
        LDS_WAIT(); asm volatile("" ::: "memory");
    }
}

__device__ __forceinline__ void phase_slots(const KA& a, const Ctx& C) {
    const Ids I = get_ids();
    unsigned char* ws = a.ws();
    const unsigned* cnt = (const unsigned*)(ws + WS_CTL) + CW_CNT; unsigned* ctl = (unsigned*)(ws + WS_CTL);
    const float* RSTD2 = (const float*)(ws + MS_RSTD2); const int* TOKE = (const int*)(ws + MS_TOKE); const int* TOKPOS = (const int*)(ws + MS_TOKPOS); const float* TOKG = (const float*)(ws + MS_TOKG);
    int* TOKSLOT = (int*)(ws + MS_TOKSLOT); int* SLOTTOK = (int*)(ws + MS_SLOTTOK); float* SLOTG = (float*)(ws + MS_SLOTG); float* SLOTRS = (float*)(ws + MS_SLOTRS); int* TILEE = (int*)(ws + MS_TILEE);
    LAS int* off = (LAS int*)C.lds; LAS int* cn = off + 40;
    __syncthreads();
    if (I.tid == 0) { int o = 0; for (int e = 0; e < NEXP; ++e) { const int c = (int)__hip_atomic_load(cnt + e, __ATOMIC_RELAXED, __HIP_MEMORY_SCOPE_AGENT); off[e] = o; cn[e] = c; o += ((c + 255) >> 8) << 8; } off[NEXP] = o; }
    __syncthreads();
    if (C.bid == 0) {
        if (I.tid == 0) ctl[CW_NTILES] = (unsigned)(off[NEXP] >> 8);
        for (int e = 0; e < NEXP; ++e) for (int t = (off[e] >> 8) + I.tid; t < (off[e + 1] >> 8); t += 512) TILEE[t] = e;
    }
    for (int i = C.bid * 512 + I.tid; i < NTOK * 4; i += C.G * 512) { const int m = i >> 2; const int e = TOKE[i]; const int slot = off[e] + TOKPOS[i];
        TOKSLOT[i] = slot; SLOTTOK[slot] = m; SLOTG[slot] = TOKG[i]; SLOTRS[slot] = RSTD2[m]; }
    for (int e = 0; e < NEXP; ++e) for (int s = off[e] + cn[e] + C.bid * 512 + I.tid; s < off[e + 1]; s += C.G * 512) { SLOTTOK[s] = 0; SLOTG[s] = 0.f; SLOTRS[s] = 0.f; }
    __syncthreads();
}

__device__ __forceinline__ void phase_final(const KA& a, const Ctx& C) {
    const Ids I = get_ids();
    unsigned char* ws = a.ws();
    float* OUT = a.out(); const bf16_t* YS = (const bf16_t*)(ws + WS_YSLOT); const int* TOKSLOT = (const int*)(ws + MS_TOKSLOT); const float* fw = a.in(29);
    const int gw = C.bid * NWAVES + I.wave, NGW = C.G * NWAVES;
    for (int m = gw; m < NTOK; m += NGW) {
        f32x4 v[4]; f32x4* orow = (f32x4*)(OUT + (size_t)m * 1024) + I.lane;
#pragma unroll
        for (int j = 0; j < 4; ++j) v[j] = orow[64 * j];
#pragma unroll
        for (int s = 0; s < 4; ++s) { const int slot = TOKSLOT[m * 4 + s]; const u32x2* yr = (const u32x2*)(YS + (size_t)slot * 1024) + I.lane;
#pragma unroll
            for (int j = 0; j < 4; ++j) { const u32x2 y = yr[64 * j]; v[j][0] += bf_lo(y.x); v[j][1] += bf_hi(y.x); v[j][2] += bf_lo(y.y); v[j][3] += bf_hi(y.y); } }
        float ss = 0.f;
#pragma unroll
        for (int j = 0; j < 4; ++j) ss += (v[j][0] * v[j][0] + v[j][1] * v[j][1]) + (v[j][2] * v[j][2] + v[j][3] * v[j][3]);
        const float rstd = 1.0f / sqrtf(wave_sum(ss) * (1.0f / 1024.0f) + 1e-5f);
#pragma unroll
        for (int j = 0; j < 4; ++j) { const f32x4 w = ((const f32x4*)fw)[I.lane + 64 * j]; orow[64 * j] = v[j] * rstd * w; }
    }
}

constexpr int N_PHASES = 13;
__global__ void __launch_bounds__(512, 2) mega(Args a_unused) {
    const KA a;
    extern __shared__ __attribute__((aligned(16))) unsigned char lds_raw[];
    cg::grid_group grid = cg::this_grid();
    Ctx C; C.lds = (LAS unsigned char*)lds_raw; C.G = gridDim.x; C.bid = blockIdx.x;
    const int lo = a.ph_lo(), hi = a.ph_hi();
#define ws (a.ws())
#define IN(k) (lo <= (k) && (k) < hi)
#define SEAM(k) do { if (IN(k) && IN((k) + 1)) grid.sync(); } while (0)
    if (IN(0)) phase0(a, C);
    SEAM(0);
    if (IN(1)) {
        { DenseSched S{(const char*)(ws + WS_XN), (const char*)(ws + WS_WBIG), NTOK / 256, 6144 / 256, 1024, C.G, C.bid};
          EpiIn E{(bf16_t*)(ws + WS_P), (bf16_t*)(ws + WS_GATE), a.in(5)};
          pg8::gemm_phase<EpiIn, DenseSched, false>(C.lds, 1024, S, E); }
        { DenseSched S{(const char*)(ws + WS_MEMN), (const char*)(ws + WS_WMKV), NMEM / 256, 1024 / 256, 1024, C.G, C.bid};
          EpiPlain E{(bf16_t*)(ws + WS_KVM), 1024};
          pg8::gemm_phase<EpiPlain, DenseSched, false>(C.lds, 1024, S, E); }
    }
    SEAM(1);
    if (IN(2)) phase_lerp(a, C);
    SEAM(2);
    if (IN(3)) {
        { int Kl = 256; asm volatile("" : "+s"(Kl)); DenseSched S{(const char*)(ws + WS_LIN), (const char*)(ws + WS_WRW), NTOK / 256, 1536 / 256, Kl, C.G, C.bid};
          EpiLora E{ws, a.in(7), a.in(9)};
          pg8::gemm_phase<EpiLora, DenseSched, false>(C.lds, Kl, S, E); }
        phase_swa(a, C);
        phase_mem(a, C);
    }
    SEAM(3);
    if (IN(4)) phase_rwkv(a, C);
    SEAM(4);
    if (IN(5)) phase_gn(a, C);
    SEAM(5);
    if (IN(6)) {
        BranchSched S{(const char*)(ws + WS_YB), (const char*)(ws + WS_WBR), NTOK / 256, 4, C.G, C.bid};
        EpiBranch E{(bf16_t*)(ws + WS_MERGED), (const bf16_t*)(ws + WS_GATE)};
        pg8::gemm_phase<EpiBranch, BranchSched, false>(C.lds, 512, S, E);
    }
    SEAM(6);
    if (IN(7)) {
        DenseSched S{(const char*)(ws + WS_MERGED), (const char*)(ws + WS_WOUT), NTOK / 256, 4, 1024, C.G, C.bid};
        EpiOut E{a.in(0), a.out()};
        pg8::gemm_phase<EpiOut, DenseSched, false>(C.lds, 1024, S, E);
    }
    SEAM(7);
    if (IN(8)) phase_router(a, C);
    SEAM(8);
    if (IN(9)) phase_slots(a, C);
    SEAM(9);
    if (IN(10)) {
        const int ntiles = (int)__hip_atomic_load((unsigned*)(ws + WS_CTL) + CW_NTILES, __ATOMIC_RELAXED, __HIP_MEMORY_SCOPE_AGENT);
        MoeSched S{(const char*)(ws + WS_HB), (const char*)(ws + WS_W1T), (const int*)(ws + MS_TILEE), (const int*)(ws + MS_SLOTTOK), ntiles, 8, 1024, C.G, C.bid, (size_t)2048 * 1024 * 2};
        EpiUp E{(bf16_t*)(ws + WS_ACT), a.in(26), (const float*)(ws + MS_SLOTRS)};
        pg8::gemm_phase<EpiUp, MoeSched, true>(C.lds, 1024, S, E);
    }
    SEAM(10);
    if (IN(11)) {
        const int ntiles = (int)__hip_atomic_load((unsigned*)(ws + WS_CTL) + CW_NTILES, __ATOMIC_RELAXED, __HIP_MEMORY_SCOPE_AGENT);
        MoeSched2 S{(const char*)(ws + WS_ACT), (const char*)(ws + WS_W2T), (const int*)(ws + MS_TILEE), ntiles, 4, 1024, C.G, C.bid, (size_t)1024 * 1024 * 2};
        EpiDown E{(bf16_t*)(ws + WS_YSLOT), a.in(28), (const float*)(ws + MS_SLOTG)};
        pg8::gemm_phase<EpiDown, MoeSched2, false>(C.lds, 1024, S, E);
    }
    SEAM(11);
    if (IN(12)) phase_final(a, C);
#undef IN
#undef SEAM
#undef ws
}

#ifndef MK_MULTI
#define MK_MULTI 0
#endif
extern "C" void kernel_launch(void* const* d_in, const int* in_sizes, int n_in, void* d_out, int out_size, void* d_ws, size_t ws_size, hipStream_t stream) {
    static int grid = 0;
    if (grid == 0) {
        int dev = 0, cus = 0, per_cu = 0;
        if (n_in != 30 || ws_size < WS_END) { fprintf(stderr, "kernel_launch: unexpected n_in %d / ws %zu\n", n_in, ws_size); grid = -1; return; }
        (void)hipGetDevice(&dev); (void)hipDeviceGetAttribute(&cus, hipDeviceAttributeMultiprocessorCount, dev);
        (void)hipFuncSetAttribute((const void*)mega, hipFuncAttributeMaxDynamicSharedMemorySize, LDS_BYTES);
        (void)hipOccupancyMaxActiveBlocksPerMultiprocessor(&per_cu, (const void*)mega, 512, LDS_BYTES);
        (void)hipGetLastError();
        if (per_cu < 1) per_cu = 1;
        grid = cus;
        fprintf(stderr, "kernel_launch: cus %d per_cu %d grid %d ws %zu\n", cus, per_cu, grid, ws_size);
    }
    if (grid < 0) return;
    (void)hipMemsetAsync((char*)d_ws + WS_CTL, 0, CTL_BYTES, stream);
    Args a{};
    for (int i = 0; i < 30; ++i) a.in[i] = (const float*)d_in[i];
    a.out = (float*)d_out; a.ws = (unsigned char*)d_ws;
#if MK_MULTI
    for (int p = 0; p < N_PHASES; ++p) { a.ph_lo = p; a.ph_hi = p + 1; hipLaunchKernelGGL(mega, dim3(grid), dim3(512), LDS_BYTES, stream, a); }
#else
    a.ph_lo = 0; a.ph_hi = N_PHASES;
    void* args[] = {&a};
    hipError_t e = hipLaunchCooperativeKernel((const void*)mega, dim3(grid), dim3(512), args, LDS_BYTES, stream);
    if (e != hipSuccess) fprintf(stderr, "cooperative launch failed: %s (grid %d)\n", hipGetErrorString(e), grid);
#endif
}
```

```cpp
#include <hip/hip_runtime.h>
#include <hip/hip_cooperative_groups.h>
#include <cstdio>
#include <cstdint>
namespace cg = cooperative_groups;

#define LAS __attribute__((address_space(3)))
#define GAS __attribute__((address_space(1)))
typedef unsigned short bf16_t;
typedef short bf16x8 __attribute__((ext_vector_type(8)));
typedef short s16x4 __attribute__((ext_vector_type(4)));
typedef float f32x4 __attribute__((ext_vector_type(4)));
typedef float f32x2 __attribute__((ext_vector_type(2)));
typedef unsigned u32x4 __attribute__((ext_vector_type(4)));
typedef unsigned u32x2 __attribute__((ext_vector_type(2)));

constexpr int BATCH = 8, SEQ = 4096, NTOK = BATCH * SEQ, DM = 1024;
constexpr int RW_PROJ = 1792, SWA_OFF = 1792, MEMQ_OFF = 2560, IN_PROJ = 3072;
constexpr int MEM_LEN = 256, NMEM = BATCH * MEM_LEN;
constexpr int NEXP = 32, TOPK = 4, DFF = 1024;
constexpr int MAXSLOT = NTOK * TOPK + NEXP * 256;
constexpr int NWAVES = 8;

constexpr size_t MiB = 1u << 20;
constexpr size_t WS_CTL = 0, CTL_BYTES = 64 * 1024;
constexpr size_t WS_WBIG = 1 * MiB;
constexpr size_t WS_WMKV = 13 * MiB;
constexpr size_t WS_WBR = 15 * MiB;
constexpr size_t WS_WOUT = 18 * MiB;
constexpr size_t WS_WRW = 20 * MiB;
constexpr size_t WS_MISC = 21 * MiB;
constexpr size_t WS_W2T = 32 * MiB;
constexpr size_t WS_W1T = 96 * MiB;
constexpr size_t WS_YSLOT = 96 * MiB;
constexpr size_t WS_PREP = 224 * MiB;
constexpr size_t WS_R = WS_PREP, WS_KR = WS_PREP + 32 * MiB, WS_V = WS_PREP + 64 * MiB, WS_ASIG = WS_PREP + 96 * MiB, WS_W = WS_PREP + 128 * MiB, WS_LIN = WS_PREP + 192 * MiB;
constexpr size_t WS_MERGED = 552 * MiB;
constexpr size_t WS_HB = 288 * MiB;
constexpr size_t WS_XN = 448 * MiB;
constexpr size_t WS_YB0 = 64 * MiB, WS_YB1 = 160 * MiB, WS_YB2 = 192 * MiB;
constexpr size_t WS_XN8 = 512 * MiB;
constexpr size_t WS_WG8 = 7 * MiB;
constexpr size_t WS_MEMN = 544 * MiB;
constexpr size_t WS_KVM = 548 * MiB;
constexpr size_t WS_P = 552 * MiB;
constexpr size_t WS_GATE = 256 * MiB;
constexpr size_t WS_RWT0 = 744 * MiB;
constexpr size_t WS_YRAW = 552 * MiB;
constexpr size_t WS_ACT = 552 * MiB;
constexpr size_t WS_END = 1016 * MiB;
#ifndef RW_CHUNKED
#define RW_CHUNKED 1
#endif
constexpr size_t MS_RSTD2 = WS_MISC;
constexpr size_t MS_TOKE = WS_MISC + 1 * MiB / 2;
constexpr size_t MS_TOKPOS = WS_MISC + 1 * MiB;
constexpr size_t MS_TOKSLOT = WS_MISC + 3 * MiB / 2;
constexpr size_t MS_TOKG = WS_MISC + 2 * MiB;
constexpr size_t MS_SLOTTOK = WS_MISC + 5 * MiB / 2;
constexpr size_t MS_SLOTG = WS_MISC + 7 * MiB / 2;
constexpr size_t MS_SLOTRS = WS_MISC + 9 * MiB / 2;
constexpr size_t MS_TILEE = WS_MISC + 11 * MiB / 2;
constexpr size_t MS_BONUS = WS_MISC + 6 * MiB;
constexpr size_t MS_WRT = WS_MISC + 7 * MiB;
constexpr int CW_CNT = 4096;
constexpr int CW_NTILES = 128;
constexpr int CW_MOEW = 320;
constexpr int CW_KV = 192;
constexpr int CW_BAR = 8192;

constexpr int LDS_BYTES = 155648;

__device__ __forceinline__ unsigned f2bf(float f) { unsigned u = __builtin_bit_cast(unsigned, f); return (u + 0x7fffu + ((u >> 16) & 1u)) >> 16; }
__device__ __forceinline__ unsigned cvt_pk_bf16(float lo, float hi) { unsigned r; asm volatile("v_cvt_pk_bf16_f32 %0, %1, %2" : "=v"(r) : "v"(lo), "v"(hi)); return r; }
typedef float f32x2_t_ __attribute__((ext_vector_type(2)));
typedef __bf16 bf16x2_t_ __attribute__((ext_vector_type(2)));
__device__ __forceinline__ unsigned pk2(float lo, float hi) { const f32x2_t_ v = {lo, hi}; const bf16x2_t_ b = __builtin_convertvector(v, bf16x2_t_); return __builtin_bit_cast(unsigned, b); }
__device__ __forceinline__ float bf_lo(unsigned u) { return __builtin_bit_cast(float, u << 16); }
__device__ __forceinline__ float bf_hi(unsigned u) { return __builtin_bit_cast(float, u & 0xffff0000u); }
__device__ __forceinline__ float bf1(bf16_t u) { return __builtin_bit_cast(float, (unsigned)u << 16); }
__device__ __forceinline__ float fexp(float x) { return __builtin_amdgcn_exp2f(x * 1.44269504f); }
__device__ __forceinline__ float fsigmoid(float x) { return __builtin_amdgcn_rcpf(1.0f + fexp(-x)); }
__device__ __forceinline__ float wave_sum(float v) {
#pragma unroll
    for (int o = 1; o < 64; o <<= 1) v += __shfl_xor(v, o);
    return v;
}
__device__ __forceinline__ unsigned cvt_fp8x4(float a, float b, float c, float d) { int w = 0; w = __builtin_amdgcn_cvt_pk_fp8_f32(a, b, w, false); w = __builtin_amdgcn_cvt_pk_fp8_f32(c, d, w, true); return (unsigned)w; }
typedef int i32x8 __attribute__((ext_vector_type(8)));
#ifndef MOE_FP8
#define MOE_FP8 1
#endif
#ifndef YS_FP8
#define YS_FP8 1
#endif
#ifndef G1_FP8
#define G1_FP8 0
#endif
constexpr float W8_SCALE = 32.0f;
#define LDS_WAIT() asm volatile("s_waitcnt lgkmcnt(0)" ::: "memory")
#define VM_WAIT() asm volatile("s_waitcnt vmcnt(0)" ::: "memory")

namespace pg8 {
constexpr int BM = 256, BK = 64, HALF = 128, HTB = HALF * BK * 2, STAGE_BYTES = 8 * HTB, NXCD = 8, WGM = 8;
__host__ __device__ __forceinline__ int lds_byte(int r, int c) { const int st = (r >> 4) * 2 + (c >> 5), rr = r & 15, cc = c & 31, ob = rr * 64 + cc * 2; return st * 1024 + (ob ^ (((ob >> 9) & 1) << 5)); }
__host__ __device__ __forceinline__ void stage_rc(int b, int& R, int& C) { const int st = b / 1024, sb = b % 1024, swz = sb ^ (((sb >> 9) & 1) << 5); R = (st >> 1) * 16 + swz / 64; C = (st & 1) * 32 + (swz % 64) / 2; }
__host__ __device__ __forceinline__ int perm32(int rho) { const int n = rho >> 4, i = rho & 15; return 8 * (i >> 2) + 4 * n + (i & 3); }

struct Unit { int pm, pn, aux; const char* a; const char* b; };

__device__ __forceinline__ void tile_of(int L, int nM, int nN, int& pm, int& pn) {
    const int nwg = nM * nN; int wgid = L;
    { const int q = nwg / NXCD, r = nwg % NXCD, xcd = wgid % NXCD, off = wgid / NXCD; wgid = (xcd < r ? xcd * (q + 1) : r * (q + 1) + (xcd - r) * q) + off; }
    const int nig = WGM * nN, gid = wgid / nig, fm = gid * WGM, gsz = (nM - fm) < WGM ? (nM - fm) : WGM;
    pm = fm + ((wgid % nig) % gsz); pn = (wgid % nig) / gsz;
}

template <class Epi, class Sched, bool GATHER, bool FP8 = false>
__device__ __forceinline__ void gemm_phase(LAS unsigned char* lds, const int K, const Sched& S, const Epi& E) {
    const int tid = threadIdx.x, wid = __builtin_amdgcn_readfirstlane(tid >> 6), lane = tid & 63, wr = wid >> 2, wc = wid & 3, fr = lane & 15, fq = lane >> 4;
    const int nt = K / BK;
    unsigned voffA[2], voffB[2];
#pragma unroll
    for (int i = 0; i < 2; ++i) { int R, C; stage_rc(tid * 16 + i * 8192, R, C); const int Rb = (R & ~31) + perm32(R & 31); voffA[i] = (unsigned)(R * K + C) * 2u; voffB[i] = (unsigned)(Rb * K + C) * 2u; }
    const size_t kstep = (size_t)(BK * 2);
    const size_t hstep = (size_t)HALF * K * 2;
    const unsigned ldsw = (unsigned)wid * 1024u;
    const int aoff = FP8 ? lds_byte(wr * 64 + fr, fq * 16) : lds_byte(wr * 64 + fr, fq * 8), boff = FP8 ? lds_byte(wc * 32 + fr, fq * 16) : lds_byte(wc * 32 + fr, fq * 8);
    LAS unsigned char* tokbuf = lds + STAGE_BYTES + wid * 1024;
#define PG8_SA(b, h) (((b) * 2 + (h)) * HTB)
#define PG8_SB(b, h) ((4 + (b) * 2 + (h)) * HTB)
#define PG8_STAGE(bufoff, gbase, voff) do { _Pragma("unroll") for (int _i = 0; _i < 2; ++_i) \
        __builtin_amdgcn_global_load_lds((const unsigned*)((const char*)(gbase) + (voff)[_i]), (LAS unsigned*)(lds + (bufoff) + ldsw + _i * 8192), 16, 0, 0); } while (0)
#define PG8_STAGE_A(bufoff, gbase, h) do { if constexpr (GATHER) { PG8_STAGE(bufoff, gbase, vG[h]); } else { PG8_STAGE(bufoff, (gbase) + (h) * hstep, voffA); } } while (0)
#define PG8_TOK_DMA(u) do { const int* _tp = S.arow_ptr(u); _Pragma("unroll") for (int _h = 0; _h < 2; ++_h) _Pragma("unroll") for (int _i = 0; _i < 2; ++_i) { int _R, _C; stage_rc(tid * 16 + _i * 8192, _R, _C); \
        __builtin_amdgcn_global_load_lds((const unsigned*)(_tp + _h * HALF + _R), (LAS unsigned*)(tokbuf + (_h * 2 + _i) * 256), 4, 0, 0); } } while (0)
#define PG8_TOK_READ() do { _Pragma("unroll") for (int _h = 0; _h < 2; ++_h) _Pragma("unroll") for (int _i = 0; _i < 2; ++_i) { int _R, _C; stage_rc(tid * 16 + _i * 8192, _R, _C); \
        const int _tk = *(const LAS int*)(tokbuf + (_h * 2 + _i) * 256 + lane * 4); vG[_h][_i] = (unsigned)(_tk * K + _C) * 2u; } } while (0)
#define PG8_LD32(p) __builtin_bit_cast(i32x8, __builtin_shufflevector(*(const LAS u32x4*)(p), *(const LAS u32x4*)((p) + (FP8 ? 16 : 1024)), 0, 1, 2, 3, 4, 5, 6, 7))
#define PG8_LDA(dst, b, h) do { _Pragma("unroll") for (int m = 0; m < 4; ++m) dst[m] = PG8_LD32(lds + PG8_SA(b, h) + aoff + m * 2048); } while (0)
#define PG8_LDB(dst, b, h) do { _Pragma("unroll") for (int n = 0; n < 2; ++n) dst[n] = PG8_LD32(lds + PG8_SB(b, h) + boff + n * 2048); } while (0)
#define PG8_LO(x) __builtin_bit_cast(bf16x8, __builtin_shufflevector(x, x, 0, 1, 2, 3))
#define PG8_HI(x) __builtin_bit_cast(bf16x8, __builtin_shufflevector(x, x, 4, 5, 6, 7))
#define PG8_MMA(ai, bj, At, Bt) do { __builtin_amdgcn_s_setprio(1); _Pragma("unroll") for (int m = 0; m < 4; ++m) _Pragma("unroll") for (int n = 0; n < 2; ++n) { \
        if constexpr (FP8) asm volatile("v_mfma_scale_f32_16x16x128_f8f6f4 %0, %1, %2, %0, %3, %3 op_sel_hi:[0,0,0]" : "+v"(acc[ai][bj][m][n]) : "v"(Bt[n]), "v"(At[m]), "v"(sc8));     \
        else { acc[ai][bj][m][n] = __builtin_amdgcn_mfma_f32_16x16x32_bf16(PG8_LO(Bt[n]), PG8_LO(At[m]), acc[ai][bj][m][n], 0, 0, 0); \
               acc[ai][bj][m][n] = __builtin_amdgcn_mfma_f32_16x16x32_bf16(PG8_HI(Bt[n]), PG8_HI(At[m]), acc[ai][bj][m][n], 0, 0, 0); } } __builtin_amdgcn_s_setprio(0); } while (0)
#define PG8_WAIT_V(n) asm volatile("s_waitcnt vmcnt(" #n ")" ::: "memory")
#define PG8_WAIT_L(n) asm volatile("s_waitcnt lgkmcnt(" #n ")" ::: "memory")
#define PG8_BAR __builtin_amdgcn_s_barrier()
#define PG8_SCHED __builtin_amdgcn_sched_barrier(0)
    Unit cur, nxt; int ui = 0;
    if (!S.next(0, cur)) return;
    unsigned vG[2][2] = {{0u, 0u}, {0u, 0u}};
    if constexpr (GATHER) { PG8_TOK_DMA(cur); PG8_WAIT_V(0); PG8_TOK_READ(); PG8_WAIT_L(0); }
    f32x4 acc[2][2][4][2];
#pragma unroll
    for (int a = 0; a < 2; ++a)
#pragma unroll
        for (int b = 0; b < 2; ++b)
#pragma unroll
            for (int m = 0; m < 4; ++m)
#pragma unroll
                for (int n = 0; n < 2; ++n) acc[a][b][m][n] = (f32x4){0.f, 0.f, 0.f, 0.f};
    i32x8 At[4], B0[2], B1[2];
    const int sc8 = 0x7f7f7f7f;
    const char* cA = cur.a; const char* cB = cur.b;
    PG8_STAGE(PG8_SB(0, 0), cB, voffB); PG8_STAGE(PG8_SB(0, 1), cB + hstep, voffB); PG8_STAGE_A(PG8_SA(0, 0), cA, 0); PG8_STAGE_A(PG8_SA(0, 1), cA, 1);
    if (wr == 1) PG8_BAR;
    PG8_WAIT_V(2); PG8_BAR;
    PG8_STAGE(PG8_SB(1, 0), cB + kstep, voffB); PG8_STAGE_A(PG8_SA(1, 0), cA + kstep, 0); PG8_STAGE(PG8_SB(1, 1), cB + hstep + kstep, voffB);
    PG8_WAIT_V(6); PG8_BAR;
    for (;;) {
        const bool has_next = S.next(ui + 1, nxt);
        const char* nA = has_next ? nxt.a : cA; const char* nB = has_next ? nxt.b : cB;
        if constexpr (GATHER) { if (has_next) PG8_TOK_DMA(nxt); }
#pragma unroll 1
        for (int t = 0; t < nt; t += 2) {
            const bool last = (t == nt - 2);
            const char* a1 = cA + (size_t)(t + 1) * kstep;
            const char* a2 = last ? nA : cA + (size_t)(t + 2) * kstep; const char* b2 = last ? nB : cB + (size_t)(t + 2) * kstep;
            const char* a3 = a2 + kstep; const char* b3 = b2 + kstep;
            PG8_LDB(B0, 0, 0); PG8_LDB(B1, 0, 1); PG8_SCHED; PG8_LDA(At, 0, 0); PG8_STAGE_A(PG8_SA(1, 1), a1, 1);
            if constexpr (GATHER) { if (last && has_next) PG8_TOK_READ(); }
            PG8_WAIT_V(8); PG8_WAIT_L(0); PG8_BAR; PG8_MMA(0, 0, At, B0); PG8_MMA(0, 1, At, B1); PG8_BAR; PG8_SCHED;
            PG8_LDA(At, 0, 1); PG8_STAGE(PG8_SB(0, 0), b2, voffB); PG8_STAGE(PG8_SB(0, 1), b2 + hstep, voffB); PG8_STAGE_A(PG8_SA(0, 0), a2, 0);
            PG8_WAIT_V(8); PG8_WAIT_L(0); PG8_BAR; PG8_MMA(1, 0, At, B0); PG8_MMA(1, 1, At, B1); PG8_BAR; PG8_SCHED;
            PG8_LDB(B0, 1, 0); PG8_LDB(B1, 1, 1); PG8_SCHED; PG8_LDA(At, 1, 0); PG8_STAGE_A(PG8_SA(0, 1), a2, 1);
            PG8_WAIT_V(8); PG8_WAIT_L(0); PG8_BAR; PG8_MMA(0, 0, At, B0); PG8_MMA(0, 1, At, B1); PG8_BAR; PG8_SCHED;
            PG8_LDA(At, 1, 1); PG8_STAGE(PG8_SB(1, 0), b3, voffB); PG8_STAGE(PG8_SB(1, 1), b3 + hstep, voffB); PG8_STAGE_A(PG8_SA(1, 0), a3, 0);
            PG8_WAIT_V(8); PG8_WAIT_L(0); PG8_BAR; PG8_MMA(1, 0, At, B0); PG8_MMA(1, 1, At, B1); PG8_BAR; PG8_SCHED;
        }
        if (wr == 0) PG8_BAR;
        if constexpr (FP8) asm volatile("s_nop 15\n\ts_nop 15" ::: "memory");
        { int t2 = threadIdx.x; asm volatile("" : "+v"(t2));
          const int wid2 = __builtin_amdgcn_readfirstlane(t2 >> 6), l2 = t2 & 63; E(acc, cur, wid2 >> 2, wid2 & 3, l2 & 15, l2 >> 4); }
        if (!has_next) break;
        if (!E.keep(cur)) {
#pragma unroll
        for (int a = 0; a < 2; ++a)
#pragma unroll
            for (int b = 0; b < 2; ++b)
#pragma unroll
                for (int m = 0; m < 4; ++m)
#pragma unroll
                    for (int n = 0; n < 2; ++n) acc[a][b][m][n] = (f32x4){0.f, 0.f, 0.f, 0.f};
        }
        cur = nxt; cA = nA; cB = nB; ++ui;
        if (wr == 1) PG8_BAR;
    }
    PG8_WAIT_V(0);
    PG8_BAR;
#undef PG8_SA
#undef PG8_SB
#undef PG8_STAGE
#undef PG8_STAGE_A
#undef PG8_TOK_DMA
#undef PG8_TOK_READ
#undef PG8_LDA
#undef PG8_LDB
#undef PG8_MMA
#undef PG8_LD32
#undef PG8_LO
#undef PG8_HI
#undef PG8_WAIT_V
#undef PG8_WAIT_L
#undef PG8_BAR
#undef PG8_SCHED
}
}
struct DenseSched {
    const char* A; const char* Bt; int nM, nN, K, G, c; int pn0 = 0;
    __device__ __forceinline__ bool next(int i, pg8::Unit& u) const {
        const long L = (long)i * G + c; if (L >= (long)nM * nN) return false;
        pg8::tile_of((int)L, nM, nN, u.pm, u.pn); u.aux = 0;
        u.a = A + (size_t)u.pm * 256 * K * 2; u.b = Bt + (size_t)u.pn * 256 * K * 2; u.pn += pn0; return true;
    }
    __device__ __forceinline__ const int* arow_ptr(const pg8::Unit&) const { return nullptr; }
};
struct GateSched {
    const char* A; const char* Bt; int nM, nN, K, G, c; int r0 = 0;
    __device__ __forceinline__ bool next(int i, pg8::Unit& u) const {
        const int br = i % 3; const long L = (long)(i / 3 + r0) * G + c; if (L >= (long)nM * nN) return false;
        int pn; pg8::tile_of((int)L, nM, nN, u.pm, pn); const int gp = 4 * br + pn; u.aux = 0;
        u.a = A + (size_t)u.pm * 256 * K * 2; u.b = Bt + (size_t)gp * 256 * K * 2; u.pn = 12 + gp; return true;
    }
    __device__ __forceinline__ const int* arow_ptr(const pg8::Unit&) const { return nullptr; }
};
struct GateSchedU {
    const char* A; const char* Bt; int nM, nN, K, U0, n;
    __device__ __forceinline__ bool next(int i, pg8::Unit& u) const {
        if (i >= n) return false; const int U = U0 + i, br = U % 3, L = U / 3;
        int pn; pg8::tile_of(L, nM, nN, u.pm, pn); const int gp = 4 * br + pn; u.aux = 0;
        u.a = A + (size_t)u.pm * 256 * K * 2; u.b = Bt + (size_t)gp * 256 * K * 2; u.pn = 12 + gp; return true;
    }
    __device__ __forceinline__ const int* arow_ptr(const pg8::Unit&) const { return nullptr; }
};
struct GateSchedX {
    const char* A; const char* Bt; int nM, nN, K, c, mode;
    __device__ __forceinline__ bool next(int i, pg8::Unit& u) const {
        if (i >= 4) return false;
        const int L = mode ? (i == 0 ? c : 256 + c) : c + 128 * (i >> 1), br = mode ? (i == 0 ? 2 : i - 1) : (i & 1);
        int pn; pg8::tile_of(L, nM, nN, u.pm, pn); const int gp = 4 * br + pn; u.aux = 0;
        u.a = A + (size_t)u.pm * 256 * K * 2; u.b = Bt + (size_t)gp * 256 * K * 2; u.pn = 12 + gp; return true;
    }
    __device__ __forceinline__ const int* arow_ptr(const pg8::Unit&) const { return nullptr; }
};
struct BranchSched {
    const char* ws; const char* WBR; int nM, nN, G, c;
    __device__ __forceinline__ bool next(int i, pg8::Unit& u) const {
        const int br = i % 3; const long L = (long)(i / 3) * G + c; if (L >= (long)nM * nN) return false;
        pg8::tile_of((int)L, nM, nN, u.pm, u.pn); u.aux = br;
        u.a = ws + (br == 0 ? WS_YB0 : (br == 1 ? WS_YB1 : WS_YB2)) + (size_t)u.pm * 256 * 512 * 2; u.b = WBR + (size_t)br * 1024 * 512 * 2 + (size_t)u.pn * 256 * 512 * 2; return true;
    }
    __device__ __forceinline__ const int* arow_ptr(const pg8::Unit&) const { return nullptr; }
};
struct MoeSched {
    const char* A; const char* Wt; const int* tile_e; const int* slot_tok; int nM, nN, K, G, c; size_t estride;
    __device__ __forceinline__ bool next(int i, pg8::Unit& u) const {
        const long L = (long)i * G + c; if (L >= (long)nM * nN) return false;
        pg8::tile_of((int)L, nM, nN, u.pm, u.pn); u.aux = __builtin_amdgcn_readfirstlane(tile_e[u.pm]);
        u.a = A; u.b = Wt + (size_t)u.aux * estride + (size_t)u.pn * 256 * K * 2; return true;
    }
    __device__ __forceinline__ const int* arow_ptr(const pg8::Unit& u) const { return slot_tok + u.pm * 256; }
};
struct MoeSched2 {
    const char* A; const char* Wt; const int* tile_e; int nM, nN, K, G, c; size_t estride;
    __device__ __forceinline__ bool next(int i, pg8::Unit& u) const {
        const long L = (long)i * G + c; if (L >= (long)nM * nN) return false;
        pg8::tile_of((int)L, nM, nN, u.pm, u.pn); u.aux = __builtin_amdgcn_readfirstlane(tile_e[u.pm]);
        u.a = A + (size_t)u.pm * 256 * K * 2; u.b = Wt + (size_t)u.aux * estride + (size_t)u.pn * 256 * K * 2; return true;
    }
    __device__ __forceinline__ const int* arow_ptr(const pg8::Unit&) const { return nullptr; }
};

#define EPI_LOOP_ROWS for (int ai = 0; ai < 2; ++ai) _Pragma("unroll") for (int m = 0; m < 4; ++m)
typedef f32x4 acc_t[2][2][4][2];
#define EPI_NOKEEP __device__ __forceinline__ bool keep(const pg8::Unit&) const { return false; }

template <bool NT> struct EpiInT {
    EPI_NOKEEP
    bf16_t* P; bf16_t* GATE; const float* b_swa; float gscale = 1.0f; float pscale = 1.0f;
    __device__ __forceinline__ void operator()(acc_t& acc, const pg8::Unit& u, int wr, int wc, int fr, int fq) const {
        const int row0 = u.pm * 256 + wr * 64 + fr; const int colt = u.pn * 256 + wc * 32 + 8 * fq;
        const bool gate = u.pn >= 12; const bool hasb = (u.pn >= 7 && u.pn < 10);
        bf16_t* base = P + colt; unsigned char* gbase = (unsigned char*)GATE + (colt - 3072);
        f32x4 bv[2][2];
#pragma unroll
        for (int bj = 0; bj < 2; ++bj)
#pragma unroll
            for (int n = 0; n < 2; ++n) bv[bj][n] = hasb ? *(const f32x4*)(b_swa + (colt - SWA_OFF) + bj * 128 + 4 * n) : (f32x4){0.f, 0.f, 0.f, 0.f};
#pragma unroll
        EPI_LOOP_ROWS { bf16_t* rowp = base + (size_t)(row0 + ai * 128 + m * 16) * 3072;
#pragma unroll
            for (int bj = 0; bj < 2; ++bj) { f32x4 v0 = acc[ai][bj][m][0] * pscale + bv[bj][0], v1 = acc[ai][bj][m][1] * pscale + bv[bj][1];
                if (gate) {
                    unsigned q[8];
#pragma unroll
                    for (int j = 0; j < 4; ++j) { q[j] = (unsigned)(fsigmoid(v0[j] * gscale) * 255.0f + 0.5f); q[4 + j] = (unsigned)(fsigmoid(v1[j] * gscale) * 255.0f + 0.5f); }
#pragma unroll
                    for (int j = 0; j < 8; ++j) q[j] = q[j] < 1u ? 1u : q[j];
                    u32x2 w8; w8.x = q[0] | (q[1] << 8) | (q[2] << 16) | (q[3] << 24); w8.y = q[4] | (q[5] << 8) | (q[6] << 16) | (q[7] << 24);
                    unsigned char* gp = gbase + (size_t)(row0 + ai * 128 + m * 16) * 3072 + bj * 128;
                    if constexpr (NT) __builtin_nontemporal_store(w8, (u32x2*)gp); else *(u32x2*)gp = w8;
                    continue; }
                u32x4 w; w.x = cvt_pk_bf16(v0[0], v0[1]); w.y = cvt_pk_bf16(v0[2], v0[3]); w.z = cvt_pk_bf16(v1[0], v1[1]); w.w = cvt_pk_bf16(v1[2], v1[3]);
                if constexpr (NT) __builtin_nontemporal_store(w, (u32x4*)(rowp + bj * 128)); else *(u32x4*)(rowp + bj * 128) = w; } }
    }
};
#ifndef G1_NT
#define G1_NT 1
#endif
#ifndef GATE_NT
#define GATE_NT 1
#endif
typedef EpiInT<G1_NT != 0> EpiIn; typedef EpiInT<GATE_NT != 0> EpiGateNT;
struct EpiPlain {
    EPI_NOKEEP
    bf16_t* O; int ldc;
    __device__ __forceinline__ void operator()(acc_t& acc, const pg8::Unit& u, int wr, int wc, int fr, int fq) const {
        const int row0 = u.pm * 256 + wr * 64 + fr; const int colt = u.pn * 256 + wc * 32 + 8 * fq;
#pragma unroll
        EPI_LOOP_ROWS { bf16_t* rowp = O + (size_t)(row0 + ai * 128 + m * 16) * ldc + colt;
#pragma unroll
            for (int bj = 0; bj < 2; ++bj) { const f32x4 v0 = acc[ai][bj][m][0], v1 = acc[ai][bj][m][1];
                u32x4 w; w.x = pk2(v0[0], v0[1]); w.y = pk2(v0[2], v0[3]); w.z = pk2(v1[0], v1[1]); w.w = pk2(v1[2], v1[3]);
                *(u32x4*)(rowp + bj * 128) = w; } }
    }
};
struct EpiLora {
    EPI_NOKEEP
    unsigned char* ws; const float* w0; const float* a0;
    __device__ __forceinline__ void operator()(acc_t& acc, const pg8::Unit& u, int wr, int wc, int fr, int fq) const {
        const int row0 = u.pm * 256 + wr * 64 + fr; const int colt = (u.pn & 1) * 256 + wc * 32 + 8 * fq; const int kind = u.pn >> 1;
        f32x4 bv[2][2];
#pragma unroll
        for (int bj = 0; bj < 2; ++bj)
#pragma unroll
            for (int n = 0; n < 2; ++n) bv[bj][n] = kind == 0 ? *(const f32x4*)(w0 + colt + bj * 128 + 4 * n) : (kind == 1 ? *(const f32x4*)(a0 + colt + bj * 128 + 4 * n) : (f32x4){0.f, 0.f, 0.f, 0.f});
#pragma unroll
        EPI_LOOP_ROWS { const size_t ro = (size_t)(row0 + ai * 128 + m * 16) * 512 + colt;
#pragma unroll
            for (int bj = 0; bj < 2; ++bj) { f32x4 v0 = acc[ai][bj][m][0] + bv[bj][0], v1 = acc[ai][bj][m][1] + bv[bj][1];
                if (kind == 0) {
#pragma unroll
                    for (int j = 0; j < 4; ++j) { v0[j] = -0.60653066f * fsigmoid(v0[j]); v1[j] = -0.60653066f * fsigmoid(v1[j]); if (!RW_CHUNKED) { v0[j] = fexp(v0[j]); v1[j] = fexp(v1[j]); } }
                    float* W = (float*)(ws + WS_W); *(f32x4*)(W + ro + bj * 128) = v0; *(f32x4*)(W + ro + bj * 128 + 4) = v1;
                } else {
                    if (kind == 1) {
#pragma unroll
                        for (int j = 0; j < 4; ++j) { v0[j] = fsigmoid(v0[j]); v1[j] = fsigmoid(v1[j]); } }
                    u32x4 w; w.x = cvt_pk_bf16(v0[0], v0[1]); w.y = cvt_pk_bf16(v0[2], v0[3]); w.z = cvt_pk_bf16(v1[0], v1[1]); w.w = cvt_pk_bf16(v1[2], v1[3]);
                    const size_t bo = (kind == 1) ? WS_ASIG : WS_YB0; *(u32x4*)((bf16_t*)(ws + bo) + ro + bj * 128) = w; } } }
    }
};
struct EpiBranch {
    bf16_t* MERGED; const bf16_t* GATE;
    __device__ __forceinline__ bool keep(const pg8::Unit& u) const { return u.aux != 2; }
    __device__ __forceinline__ void operator()(acc_t& acc, const pg8::Unit& u, int wr, int wc, int fr, int fq) const {
        const int row0 = u.pm * 256 + wr * 64 + fr; const int colt = u.pn * 256 + wc * 32 + 8 * fq; const int br = u.aux;
#pragma unroll
        for (int ai = 0; ai < 2; ++ai) {
            u32x2 g[4][2], gn[4][2]; const unsigned char* G8 = (const unsigned char*)GATE;
#pragma unroll
            for (int m = 0; m < 4; ++m)
#pragma unroll
                for (int bj = 0; bj < 2; ++bj) { const size_t r = (size_t)(row0 + ai * 128 + m * 16); const int c = colt + bj * 128;
                    g[m][bj] = *(const u32x2*)(G8 + r * 3072 + br * 1024 + c);
                    gn[m][bj] = g[m][bj]; if (br != 2) gn[m][bj] = *(const u32x2*)(G8 + r * 3072 + (br + 1) * 1024 + c); }
#pragma unroll
            for (int m = 0; m < 4; ++m)
#pragma unroll
                for (int bj = 0; bj < 2; ++bj) { const u32x2 gg = g[m][bj], nn = gn[m][bj];
                    float s[8];
                    { float a[8], b[8];
#pragma unroll
                      for (int j = 0; j < 4; ++j) { a[j] = (float)((gg.x >> (8 * j)) & 0xffu); a[4 + j] = (float)((gg.y >> (8 * j)) & 0xffu); b[j] = (float)((nn.x >> (8 * j)) & 0xffu); b[4 + j] = (float)((nn.y >> (8 * j)) & 0xffu); }
#pragma unroll
                      for (int j = 0; j < 8; ++j) s[j] = (br != 2) ? a[j] * __builtin_amdgcn_rcpf(b[j]) : a[j] * (1.0f / 255.0f); }
                    f32x4 v0 = acc[ai][bj][m][0], v1 = acc[ai][bj][m][1];
                    v0[0] *= s[0]; v0[1] *= s[1]; v0[2] *= s[2]; v0[3] *= s[3]; v1[0] *= s[4]; v1[1] *= s[5]; v1[2] *= s[6]; v1[3] *= s[7];
                    acc[ai][bj][m][0] = v0; acc[ai][bj][m][1] = v1;
                    if (br == 2) { const size_t r = (size_t)(row0 + ai * 128 + m * 16); const int c = colt + bj * 128;
                        u32x4 w; w.x = cvt_pk_bf16(v0[0], v0[1]); w.y = cvt_pk_bf16(v0[2], v0[3]); w.z = cvt_pk_bf16(v1[0], v1[1]); w.w = cvt_pk_bf16(v1[2], v1[3]);
                        *(u32x4*)(MERGED + r * 1024 + c) = w; } }
        }
    }
};
struct EpiOut {
    EPI_NOKEEP
    const float* X; float* H1;
    __device__ __forceinline__ void operator()(acc_t& acc, const pg8::Unit& u, int wr, int wc, int fr, int fq) const {
        const int row0 = u.pm * 256 + wr * 64 + fr; const int colt = u.pn * 256 + wc * 32 + 8 * fq;
#pragma unroll
        for (int ai = 0; ai < 2; ++ai) {
            f32x4 x0[4][2], x1[4][2];
#pragma unroll
            for (int m = 0; m < 4; ++m)
#pragma unroll
                for (int bj = 0; bj < 2; ++bj) { const size_t ro = (size_t)(row0 + ai * 128 + m * 16) * 1024 + colt + bj * 128; x0[m][bj] = *(const f32x4*)(X + ro); x1[m][bj] = *(const f32x4*)(X + ro + 4); }
#pragma unroll
            for (int m = 0; m < 4; ++m)
#pragma unroll
                for (int bj = 0; bj < 2; ++bj) { const size_t ro = (size_t)(row0 + ai * 128 + m * 16) * 1024 + colt + bj * 128;
                    *(f32x4*)(H1 + ro) = x0[m][bj] + acc[ai][bj][m][0]; *(f32x4*)(H1 + ro + 4) = x1[m][bj] + acc[ai][bj][m][1]; }
        }
    }
};
struct EpiUp {
    EPI_NOKEEP
    bf16_t* ACT; const float* b1; const float* slot_rs;
    __device__ __forceinline__ void operator()(acc_t& acc, const pg8::Unit& u, int wr, int wc, int fr, int fq) const {
        const int row0 = u.pm * 256 + wr * 64 + fr; const int colt = u.pn * 256 + wc * 32 + 8 * fq;
        const float* bb = b1 + (size_t)u.aux * 2048 + colt;
        f32x4 bv[2][2];
#pragma unroll
        for (int bj = 0; bj < 2; ++bj)
#pragma unroll
            for (int n = 0; n < 2; ++n) bv[bj][n] = *(const f32x4*)(bb + bj * 128 + 4 * n);
#pragma unroll
        EPI_LOOP_ROWS { const int r = row0 + ai * 128 + m * 16; const float rs = slot_rs[r] * (MOE_FP8 ? 1.0f / W8_SCALE : 1.0f);
#pragma unroll
            for (int bj = 0; bj < 2; ++bj) { const f32x4 v0 = acc[ai][bj][m][0] * rs + bv[bj][0], v1 = acc[ai][bj][m][1] * rs + bv[bj][1];
                float o[4];
#pragma unroll
                for (int p = 0; p < 4; ++p) { float gl = p < 2 ? v0[2 * p] : v1[2 * p - 4], ln = p < 2 ? v0[2 * p + 1] : v1[2 * p - 3];
                    gl = fminf(gl, 7.0f); ln = fminf(fmaxf(ln, -7.0f), 7.0f); o[p] = gl * fsigmoid(1.702f * gl) * (ln + 1.0f); }
                if (MOE_FP8) *(unsigned*)((unsigned char*)ACT + (size_t)r * 1024 + ((colt + bj * 128) >> 1)) = cvt_fp8x4(o[0], o[1], o[2], o[3]);
                else { u32x2 w; w.x = cvt_pk_bf16(o[0], o[1]); w.y = cvt_pk_bf16(o[2], o[3]);
                *(u32x2*)(ACT + (size_t)r * 1024 + ((colt + bj * 128) >> 1)) = w; } } }
    }
};
struct EpiDown {
    EPI_NOKEEP
    bf16_t* YS; const float* b2; const float* slot_g;
    __device__ __forceinline__ void operator()(acc_t& acc, const pg8::Unit& u, int wr, int wc, int fr, int fq) const {
        const int row0 = u.pm * 256 + wr * 64 + fr; const int colt = u.pn * 256 + wc * 32 + 8 * fq;
        const float* bb = b2 + (size_t)u.aux * 1024 + colt;
        const float ws_ = MOE_FP8 ? 1.0f / W8_SCALE : 1.0f;
#pragma unroll
        for (int bj = 0; bj < 2; ++bj) { const f32x4 b0 = *(const f32x4*)(bb + bj * 128), b1 = *(const f32x4*)(bb + bj * 128 + 4);
#pragma unroll
            EPI_LOOP_ROWS { const int r = row0 + ai * 128 + m * 16; const float g = slot_g[r];
                const f32x4 v0 = (acc[ai][bj][m][0] * ws_ + b0) * g, v1 = (acc[ai][bj][m][1] * ws_ + b1) * g;
                if (YS_FP8) { u32x2 w8; w8.x = cvt_fp8x4(v0[0], v0[1], v0[2], v0[3]); w8.y = cvt_fp8x4(v1[0], v1[1], v1[2], v1[3]); *(u32x2*)((unsigned char*)YS + (size_t)r * 1024 + colt + bj * 128) = w8; }
                else { u32x4 w; w.x = cvt_pk_bf16(v0[0], v0[1]); w.y = cvt_pk_bf16(v0[2], v0[3]); w.z = cvt_pk_bf16(v1[0], v1[1]); w.w = cvt_pk_bf16(v1[2], v1[3]);
                *(u32x4*)(YS + (size_t)r * 1024 + colt + bj * 128) = w; } } }
    }
};
struct Args {
    const float* in[30]; float* out; unsigned char* ws; int ph_lo, ph_hi;
};
typedef __attribute__((address_space(4))) const unsigned char* kptr_t;
__device__ __forceinline__ kptr_t karg_at(int off) { asm volatile("" : "+s"(off)); return (kptr_t)__builtin_amdgcn_kernarg_segment_ptr() + off; }
struct KA {
    __device__ __forceinline__ const float* in(int i) const { return *(const float* const __attribute__((address_space(4)))*)karg_at(8 * i); }
    __device__ __forceinline__ float* out() const { return *(float* const __attribute__((address_space(4)))*)karg_at(240); }
    __device__ __forceinline__ unsigned char* ws() const { return *(unsigned char* const __attribute__((address_space(4)))*)karg_at(248); }
    __device__ __forceinline__ int ph_lo() const { return *(const int __attribute__((address_space(4)))*)karg_at(256); }
    __device__ __forceinline__ int ph_hi() const { return *(const int __attribute__((address_space(4)))*)karg_at(260); }
};
struct Ctx {
    LAS unsigned char* lds; int G, bid;
};
struct Ids { int tid, lane, wave; };
__device__ __forceinline__ Ids get_ids() { int t = threadIdx.x; asm volatile("" : "+v"(t)); Ids I; I.tid = t; I.lane = t & 63; I.wave = __builtin_amdgcn_readfirstlane(t >> 6); return I; }

#define XB_TMO      128
#define XB_XCNT(j)  (256  + 64 * (j))
#define XB_XSUB(j)  (1280 + 64 * (j))
#define XB_XGEN(j)  (2304 + 64 * (j))
#define XB_TOP      3328
#define XB_TOPGEN   3392
#define XCD_BAR_WORDS 3456
#define XB_SPIN_CAP (1u << 22)
__device__ __forceinline__ unsigned xb_ld(unsigned* p)              { return __hip_atomic_load(p, __ATOMIC_RELAXED, __HIP_MEMORY_SCOPE_AGENT); }
__device__ __forceinline__ unsigned xb_add(unsigned* p, unsigned v) { return __hip_atomic_fetch_add(p, v, __ATOMIC_RELAXED, __HIP_MEMORY_SCOPE_AGENT); }
__device__ __forceinline__ unsigned xb_xcc_id() { return (unsigned)__builtin_amdgcn_s_getreg((3 << 11) | 20) & 0xFu; }
#define XB_SPIN(cond, bar) do { unsigned _sp = 0; while (cond) { __builtin_amdgcn_s_sleep(1); \
    if ((++_sp & 255u) == 0u) { if (xb_ld(&(bar)[XB_TMO])) break; if (_sp > XB_SPIN_CAP) { atomicAdd(&(bar)[XB_TMO], 1u); break; } } } } while (0)
struct XcdBarrier { unsigned* bar; unsigned x; volatile LAS unsigned* st; };
__device__ __forceinline__ XcdBarrier xcd_barrier_post(unsigned* bar, volatile LAS unsigned* st) {
    XcdBarrier b; b.bar = bar; b.x = xb_xcc_id(); b.st = st;
    if (threadIdx.x == 0) (void)xb_add(&bar[XB_XCNT(b.x)], 1u);
    return b;
}
__device__ __forceinline__ void xcd_barrier_complete(unsigned* bar, unsigned x, unsigned& nloc, unsigned& nx) {
    const unsigned G = gridDim.x * gridDim.y * gridDim.z;
    unsigned sum, cnt, mine, sp = 0u;
    for (;;) {
        sum = 0u; cnt = 0u; mine = 0u;
#pragma unroll
        for (unsigned j = 0; j < 16; ++j) { const unsigned c = xb_ld(&bar[XB_XCNT(j)]); sum += c; cnt += (c > 0u) ? 1u : 0u; mine = (j == x) ? c : mine; }
        if (sum == G) break;
        __builtin_amdgcn_s_sleep(1);
        if ((++sp & 255u) == 0u) { if (xb_ld(&bar[XB_TMO])) break; if (sp > XB_SPIN_CAP) { atomicAdd(&bar[XB_TMO], 1u); break; } }
    }
    nloc = mine > 0u ? mine : 1u; nx = cnt > 0u ? cnt : 1u;
}
__device__ __forceinline__ void xcd_barrier(const XcdBarrier& b) {
    asm volatile("s_waitcnt vmcnt(0)" ::: "memory");
    __syncthreads();
    if (threadIdx.x == 0) {
        unsigned* bar = b.bar;
        __builtin_amdgcn_s_waitcnt(0);
        unsigned nloc = b.st[0], nx = b.st[1];
        if (nloc == 0u) { xcd_barrier_complete(bar, b.x, nloc, nx); b.st[0] = nloc; b.st[1] = nx; }
        const unsigned old = xb_add(&bar[XB_XSUB(b.x)], 1u);
        const unsigned gen = old / nloc;
        if (old + 1u == (gen + 1u) * nloc) {
            __builtin_amdgcn_fence(__ATOMIC_RELEASE, "agent");
            asm volatile("s_waitcnt vmcnt(0)" ::: "memory");
            const unsigned og = xb_add(&bar[XB_TOP], 1u);
            const unsigned tg = og / nx;
            if (og + 1u == (tg + 1u) * nx) xb_add(&bar[XB_TOPGEN], 1u);
            else XB_SPIN(xb_ld(&bar[XB_TOPGEN]) == tg, bar);
            __builtin_amdgcn_fence(__ATOMIC_ACQUIRE, "agent");
            xb_add(&bar[XB_XGEN(b.x)], 1u);
            asm volatile("s_waitcnt vmcnt(0)" ::: "memory");
        } else {
            XB_SPIN(xb_ld(&bar[XB_XGEN(b.x)]) == gen, bar);
            __builtin_amdgcn_fence(__ATOMIC_ACQUIRE, "agent");
            asm volatile("s_waitcnt vmcnt(0)" ::: "memory");
        }
    }
    __syncthreads();
}

struct TItem { const float* W; bf16_t* WT; const float* ksc; int K, N, row_off, item; int f8; };
__device__ __forceinline__ void t_load(const TItem& t, float (&v)[32], int lane) {
    const int nblk = t.N / 32, kb = t.item / nblk, nb = t.item % nblk, k0 = 64 * kb, n0 = 32 * nb;
    const float* p = t.W + (size_t)(k0 + (lane >> 5)) * t.N + n0 + (lane & 31);
#pragma unroll
    for (int i = 0; i < 32; ++i) v[i] = p[(size_t)(2 * i) * t.N];
}
__device__ __forceinline__ void t_store(const TItem& t, const float (&v)[32], LAS float* scr, int lane) {
    const int nblk = t.N / 32, kb = t.item / nblk, nb = t.item % nblk, k0 = 64 * kb, n0 = 32 * nb;
#pragma unroll
    for (int i = 0; i < 32; ++i) { const int kk = 2 * i + (lane >> 5); float x = v[i]; if (t.ksc) x *= t.ksc[k0 + kk]; scr[kk * 33 + (lane & 31)] = x; }
    LDS_WAIT(); asm volatile("" ::: "memory");
    const int c = lane & 7;
#pragma unroll
    for (int j = 0; j < 4; ++j) { const int n = (lane >> 3) + 8 * j; const LAS float* s = scr + (8 * c) * 33 + n;
        if (t.f8) { u32x2 o; o.x = cvt_fp8x4(s[0 * 33] * W8_SCALE, s[1 * 33] * W8_SCALE, s[2 * 33] * W8_SCALE, s[3 * 33] * W8_SCALE); o.y = cvt_fp8x4(s[4 * 33] * W8_SCALE, s[5 * 33] * W8_SCALE, s[6 * 33] * W8_SCALE, s[7 * 33] * W8_SCALE);
            *(u32x2*)((unsigned char*)t.WT + (size_t)(t.row_off + n0 + n) * t.K + k0 + 8 * c) = o; }
        else { u32x4 o; o.x = pk2(s[0 * 33], s[1 * 33]); o.y = pk2(s[2 * 33], s[3 * 33]); o.z = pk2(s[4 * 33], s[5 * 33]); o.w = pk2(s[6 * 33], s[7 * 33]);
        *(u32x4*)(t.WT + (size_t)(t.row_off + n0 + n) * t.K + k0 + 8 * c) = o; } }
    LDS_WAIT(); asm volatile("" ::: "memory");
}
__device__ __forceinline__ void rms_row_to_bf16(const float* xrow, const float* w, bf16_t* orow, int lane, unsigned char* o8row) {
    const f32x4* xr = (const f32x4*)xrow + lane; const f32x4* wr = (const f32x4*)w + lane;
    f32x4 v[4]; float s = 0.f;
#pragma unroll
    for (int j = 0; j < 4; ++j) { v[j] = xr[64 * j]; s += (v[j].x * v[j].x + v[j].y * v[j].y) + (v[j].z * v[j].z + v[j].w * v[j].w); }
    const float rstd = 1.f / sqrtf(wave_sum(s) * (1.f / 1024.f) + 1e-5f);
    u32x2* o8 = (u32x2*)orow + lane;
#pragma unroll
    for (int j = 0; j < 4; ++j) { const f32x4 ww = wr[64 * j]; const float y0 = v[j].x * rstd * ww.x, y1 = v[j].y * rstd * ww.y, y2 = v[j].z * rstd * ww.z, y3 = v[j].w * rstd * ww.w;
        u32x2 o; o.x = pk2(y0, y1); o.y = pk2(y2, y3); if (orow) o8[64 * j] = o; if (o8row) ((unsigned*)o8row)[lane + 64 * j] = cvt_fp8x4(y0, y1, y2, y3); }
}
__device__ __forceinline__ void phase0(const KA& a, const Ctx& C) {
    const Ids I = get_ids();
    unsigned char* ws = a.ws();
    LAS float* scr = (LAS float*)(C.lds + I.wave * 16384);
    const int gw = C.bid * NWAVES + I.wave, NGW = C.G * NWAVES;
    bf16_t* WBIG = (bf16_t*)(ws + WS_WBIG); bf16_t* WMKV = (bf16_t*)(ws + WS_WMKV); bf16_t* WBR = (bf16_t*)(ws + WS_WBR); bf16_t* WOUT = (bf16_t*)(ws + WS_WOUT);
    bf16_t* W1T = (bf16_t*)(ws + WS_W1T); bf16_t* W2T = (bf16_t*)(ws + WS_W2T);
    constexpr int I_IN = 16 * 96, I_G = 16 * 32, I_MKV = 16 * 32, I_BR = 8 * 32, I_OUT = 16 * 32, I_E1 = 16 * 64, I_E2 = 16 * 32;
    constexpr int NITEMS = I_IN + 3 * I_G + I_MKV + 3 * I_BR + I_OUT;
    auto decode = [&](int it) -> TItem {
        TItem t; int r = it; t.ksc = nullptr; t.row_off = 0; t.K = 1024; t.N = 1024; t.f8 = 0;
        if (r < I_IN) { t.W = a.in(4); t.N = 3072; t.WT = WBIG; t.item = r; t.f8 = G1_FP8; return t; } r -= I_IN;
        if (r < 3 * I_G) { const int g = r / I_G; t.W = a.in(19) + (size_t)g * 1024 * 1024; t.WT = (bf16_t*)(ws + WS_WG8); t.row_off = 1024 * g; t.item = r % I_G; t.f8 = 1; return t; } r -= 3 * I_G;
        if (r < I_MKV) { t.W = a.in(18); t.WT = WMKV; t.item = r; return t; } r -= I_MKV;
        if (r < 3 * I_BR) { const int g = r / I_BR; t.W = a.in(20) + (size_t)g * 512 * 1024; t.K = 512; t.WT = WBR + (size_t)g * 1024 * 512; t.item = r % I_BR; return t; } r -= 3 * I_BR;
        if (r < I_OUT) { t.W = a.in(21); t.WT = WOUT; t.item = r; return t; } r -= I_OUT;
        if (r < NEXP * I_E1) { const int e = r / I_E1; t.W = a.in(25) + (size_t)e * 1024 * 2048; t.N = 2048; t.WT = (bf16_t*)((unsigned char*)W1T + (size_t)e * 2048 * 1024 * (MOE_FP8 ? 1 : 2)); t.ksc = a.in(22); t.item = r % I_E1; t.f8 = MOE_FP8; return t; } r -= NEXP * I_E1;
        { const int e = r / I_E2; t.W = a.in(27) + (size_t)e * 1024 * 1024; t.WT = (bf16_t*)((unsigned char*)W2T + (size_t)e * 1024 * 1024 * (MOE_FP8 ? 1 : 2)); t.item = r % I_E2; t.f8 = MOE_FP8; return t; }
    };
    {
        float va[32], vb[32];
        int it = gw;
        TItem ta, tb;
        if (it < NITEMS) { ta = decode(it); t_load(ta, va, I.lane); }
        while (it < NITEMS) {
            const int it2 = it + NGW;
            if (it2 < NITEMS) { tb = decode(it2); t_load(tb, vb, I.lane); }
            t_store(ta, va, scr, I.lane);
            it = it2;
            if (it < NITEMS) {
                const int it3 = it + NGW;
                if (it3 < NITEMS) { ta = decode(it3); t_load(ta, va, I.lane); }
                t_store(tb, vb, scr, I.lane);
                it = it3;
            }
        }
    }
    { bf16_t* WRW = (bf16_t*)(ws + WS_WRW); const float* w2 = a.in(8); const float* a2 = a.in(10); const float* g2 = a.in(11);
      for (int i = C.bid * 512 + I.tid; i < 1536 * 256; i += C.G * 512) { const int n = i >> 8, k = i & 255; float v = 0.f;
          if (n < 512) { if (k < 64) v = w2[k * 512 + n]; } else if (n < 1024) { if (k >= 64 && k < 128) v = a2[(k - 64) * 512 + (n - 512)]; } else { if (k >= 128) v = g2[(k - 128) * 512 + (n - 1024)]; }
          WRW[i] = (bf16_t)f2bf(v); } }
    { bf16_t* WRT = (bf16_t*)(ws + MS_WRT); const float* wr = a.in(23); const float* fw = a.in(22);
      for (int i = C.bid * 512 + I.tid; i < 32 * 1024; i += C.G * 512) { const int e = i >> 10, k = i & 1023; const float v = wr[k * 32 + e] * fw[k];
          const unsigned hi = f2bf(v); const float lo = v - __builtin_bit_cast(float, hi << 16); WRT[i] = (bf16_t)hi; WRT[32 * 1024 + i] = (bf16_t)f2bf(lo); } }
    bf16_t* XN = (bf16_t*)(ws + WS_XN); bf16_t* MEMN = (bf16_t*)(ws + WS_MEMN);
    { const float* X = a.in(0); const f32x4* wr = (const f32x4*)a.in(2) + I.lane; f32x4 ww[4];
#pragma unroll
      for (int j = 0; j < 4; ++j) ww[j] = wr[64 * j];
      f32x4 v[4], vn[4];
      if (gw < NTOK) {
#pragma unroll
          for (int j = 0; j < 4; ++j) v[j] = ((const f32x4*)(X + (size_t)gw * 1024) + I.lane)[64 * j]; }
      for (int m = gw; m < NTOK; m += NGW) {
          const int mn = m + NGW;
          if (mn < NTOK) {
#pragma unroll
              for (int j = 0; j < 4; ++j) vn[j] = ((const f32x4*)(X + (size_t)mn * 1024) + I.lane)[64 * j]; }
          float s = 0.f;
#pragma unroll
          for (int j = 0; j < 4; ++j) s += (v[j].x * v[j].x + v[j].y * v[j].y) + (v[j].z * v[j].z + v[j].w * v[j].w);
          const float rstd = 1.f / sqrtf(wave_sum(s) * (1.f / 1024.f) + 1e-5f);
#pragma unroll
          for (int j = 0; j < 4; ++j) { const float y0 = v[j].x * rstd * ww[j].x, y1 = v[j].y * rstd * ww[j].y, y2 = v[j].z * rstd * ww[j].z, y3 = v[j].w * rstd * ww[j].w;
              if (!G1_FP8) { u32x2 o; o.x = pk2(y0, y1); o.y = pk2(y2, y3); ((u32x2*)(XN + (size_t)m * 1024) + I.lane)[64 * j] = o; }
              ((unsigned*)(ws + WS_XN8 + (size_t)m * 1024))[I.lane + 64 * j] = cvt_fp8x4(y0, y1, y2, y3); }
#pragma unroll
          for (int j = 0; j < 4; ++j) v[j] = vn[j];
      } }
    for (int m = gw; m < NMEM; m += NGW) rms_row_to_bf16(a.in(1) + (size_t)m * 1024, a.in(3), MEMN + (size_t)m * 1024, I.lane, nullptr);
}
__device__ __forceinline__ void t_load4(const TItem& t, f32x4 (&v)[8], int lane) {
    const int nblk = t.N / 32, kb = t.item / nblk, nb = t.item % nblk, k0 = 64 * kb, n0 = 32 * nb;
    const float* p = t.W + (size_t)(k0 + (lane >> 3)) * t.N + n0 + 4 * (lane & 7);
#pragma unroll
    for (int i = 0; i < 8; ++i) v[i] = *(const f32x4*)(p + (size_t)(8 * i) * t.N);
}
__device__ __forceinline__ void t_store4(const TItem& t, const f32x4 (&v)[8], LAS float* scr, int lane) {
    const int nblk = t.N / 32, kb = t.item / nblk, nb = t.item % nblk, k0 = 64 * kb, n0 = 32 * nb;
#pragma unroll
    for (int i = 0; i < 8; ++i) { const int kk = 8 * i + (lane >> 3); f32x4 x = v[i]; if (t.ksc) x = x * t.ksc[k0 + kk];
        LAS float* d = scr + kk * 33 + 4 * (lane & 7); d[0] = x[0]; d[1] = x[1]; d[2] = x[2]; d[3] = x[3]; }
    LDS_WAIT(); asm volatile("" ::: "memory");
    const int c = lane & 7;
#pragma unroll
    for (int j = 0; j < 4; ++j) { const int n = (lane >> 3) + 8 * j; const LAS float* s = scr + (8 * c) * 33 + n;
        if (t.f8) { u32x2 o; o.x = cvt_fp8x4(s[0 * 33] * W8_SCALE, s[1 * 33] * W8_SCALE, s[2 * 33] * W8_SCALE, s[3 * 33] * W8_SCALE); o.y = cvt_fp8x4(s[4 * 33] * W8_SCALE, s[5 * 33] * W8_SCALE, s[6 * 33] * W8_SCALE, s[7 * 33] * W8_SCALE);
            *(u32x2*)((unsigned char*)t.WT + (size_t)(t.row_off + n0 + n) * t.K + k0 + 8 * c) = o; }
        else { u32x4 o; o.x = pk2(s[0 * 33], s[1 * 33]); o.y = pk2(s[2 * 33], s[3 * 33]); o.z = pk2(s[4 * 33], s[5 * 33]); o.w = pk2(s[6 * 33], s[7 * 33]);
        *(u32x4*)(t.WT + (size_t)(t.row_off + n0 + n) * t.K + k0 + 8 * c) = o; } }
    LDS_WAIT(); asm volatile("" ::: "memory");
}
__device__ __forceinline__ void phase0_moe(const KA& a, const Ctx& C) {
    const Ids I = get_ids();
    unsigned char* ws = a.ws();
    LAS float* scr = (LAS float*)(C.lds + I.wave * 16384);
    bf16_t* W1T = (bf16_t*)(ws + WS_W1T); bf16_t* W2T = (bf16_t*)(ws + WS_W2T);
    constexpr int I_E1 = 16 * 64, I_E2 = 16 * 32, NM = NEXP * (I_E1 + I_E2), NCH = 16;
    unsigned* ctr = (unsigned*)(ws + WS_CTL) + CW_MOEW;
    auto decode = [&](int r) -> TItem {
        TItem t; t.ksc = nullptr; t.row_off = 0; t.K = 1024; t.N = 1024; t.f8 = MOE_FP8;
        if (r < NEXP * I_E1) { const int e = r / I_E1; t.W = a.in(25) + (size_t)e * 1024 * 2048; t.N = 2048; t.WT = (bf16_t*)((unsigned char*)W1T + (size_t)e * 2048 * 1024 * (MOE_FP8 ? 1 : 2)); t.ksc = a.in(22); t.item = r % I_E1; return t; } r -= NEXP * I_E1;
        { const int e = r / I_E2; t.W = a.in(27) + (size_t)e * 1024 * 1024; t.WT = (bf16_t*)((unsigned char*)W2T + (size_t)e * 1024 * 1024 * (MOE_FP8 ? 1 : 2)); t.item = r % I_E2; return t; }
    };
    __syncthreads();
    for (;;) {
        unsigned c0 = 0u; if (I.lane == 0) c0 = __hip_atomic_fetch_add(ctr, (unsigned)NCH, __ATOMIC_RELAXED, __HIP_MEMORY_SCOPE_AGENT);
        const int c = __builtin_amdgcn_readfirstlane((int)c0);
        if (c >= NM) break;
        f32x4 v0[8], v1[8], v2[8], v3[8];
        t_load4(decode(c), v0, I.lane); t_load4(decode(c + 1), v1, I.lane); t_load4(decode(c + 2), v2, I.lane);
#pragma unroll 1
        for (int j = 0; j < NCH; j += 4) {
            t_load4(decode(c + j + 3), v3, I.lane); t_store4(decode(c + j), v0, scr, I.lane);
            if (j + 4 < NCH) t_load4(decode(c + j + 4), v0, I.lane); t_store4(decode(c + j + 1), v1, scr, I.lane);
            if (j + 5 < NCH) t_load4(decode(c + j + 5), v1, I.lane); t_store4(decode(c + j + 2), v2, scr, I.lane);
            if (j + 6 < NCH) t_load4(decode(c + j + 6), v2, I.lane); t_store4(decode(c + j + 3), v3, scr, I.lane); }
    }
    __syncthreads();
}

__device__ __forceinline__ void phase_lerp(const KA& a, const Ctx& C) {
    const Ids I = get_ids();
    unsigned char* ws = a.ws();
    const bf16_t* P = (const bf16_t*)(ws + WS_P); const float* mu = a.in(6);
    bf16_t* R = (bf16_t*)(ws + WS_R); bf16_t* KR = (bf16_t*)(ws + WS_KR); bf16_t* V = (bf16_t*)(ws + WS_V); bf16_t* LIN = (bf16_t*)(ws + WS_LIN);
    const int gw = C.bid * NWAVES + I.wave, NGW = C.G * NWAVES;
    f32x4 m0[4], m1[4];
#pragma unroll
    for (int it = 0; it < 4; ++it) { const int c = I.lane + 64 * it; m0[it] = (f32x4){0.f, 0.f, 0.f, 0.f}; m1[it] = m0[it]; if (c < 224) { m0[it] = *(const f32x4*)(mu + c * 8); m1[it] = *(const f32x4*)(mu + c * 8 + 4); } }
    u32x4 pa[4], pb[4], na[4], nb[4];
#define LERP_LOAD(mm, A, B) do { const bool _hp = ((mm) & (SEQ - 1)) != 0; const bf16_t* _cur = P + (size_t)(mm) * 3072; _Pragma("unroll") for (int it = 0; it < 4; ++it) { const int c = I.lane + 64 * it; \
        A[it] = (u32x4){0u, 0u, 0u, 0u}; B[it] = A[it]; if (c < 224) { A[it] = *(const u32x4*)(_cur + c * 8); if (_hp) B[it] = *(const u32x4*)(_cur - 3072 + c * 8); } } } while (0)
    if (gw < NTOK) LERP_LOAD(gw, pa, pb);
    for (int m = gw; m < NTOK; m += NGW) {
        if (m + NGW < NTOK) LERP_LOAD(m + NGW, na, nb);
#pragma unroll
        for (int it = 0; it < 4; ++it) { const int c = I.lane + 64 * it;
            if (c < 224) { const int col0 = c * 8; const u32x4 qa = pa[it], qb = pb[it];
                float v[8];
                v[0] = bf_lo(qa.x) + (bf_lo(qb.x) - bf_lo(qa.x)) * m0[it][0]; v[1] = bf_hi(qa.x) + (bf_hi(qb.x) - bf_hi(qa.x)) * m0[it][1];
                v[2] = bf_lo(qa.y) + (bf_lo(qb.y) - bf_lo(qa.y)) * m0[it][2]; v[3] = bf_hi(qa.y) + (bf_hi(qb.y) - bf_hi(qa.y)) * m0[it][3];
                v[4] = bf_lo(qa.z) + (bf_lo(qb.z) - bf_lo(qa.z)) * m1[it][0]; v[5] = bf_hi(qa.z) + (bf_hi(qb.z) - bf_hi(qa.z)) * m1[it][1];
                v[6] = bf_lo(qa.w) + (bf_lo(qb.w) - bf_lo(qa.w)) * m1[it][2]; v[7] = bf_hi(qa.w) + (bf_hi(qb.w) - bf_hi(qa.w)) * m1[it][3];
                bf16_t* dst;
                if (col0 < 512) dst = R + (size_t)m * 512 + col0;
                else if (col0 < 1024) dst = KR + (size_t)m * 512 + (col0 - 512);
                else if (col0 < 1536) dst = V + (size_t)m * 512 + (col0 - 1024);
                else { dst = LIN + (size_t)m * 256 + (col0 - 1536);
                    if (col0 < 1600) {
#pragma unroll
                        for (int j = 0; j < 8; ++j) { const float e2 = fexp(2.0f * v[j]); v[j] = 1.0f - 2.0f * __builtin_amdgcn_rcpf(e2 + 1.0f); }
                    } else if (col0 >= 1664) {
#pragma unroll
                        for (int j = 0; j < 8; ++j) v[j] = fsigmoid(v[j]);
                    } }
                u32x4 o; o.x = pk2(v[0], v[1]); o.y = pk2(v[2], v[3]); o.z = pk2(v[4], v[5]); o.w = pk2(v[6], v[7]);
                *(u32x4*)dst = o; } }
#pragma unroll
        for (int it = 0; it < 4; ++it) { pa[it] = na[it]; pb[it] = nb[it]; }
    }
#undef LERP_LOAD
}

__device__ __forceinline__ s16x4 vtr(LAS const unsigned char* p) { typedef short v4i16_t __attribute__((ext_vector_type(4))); return __builtin_bit_cast(s16x4, __builtin_amdgcn_ds_read_tr16_b64_v4i16((LAS v4i16_t*)p)); }
template <int DH, int NKT, int KP, bool SWA>
__device__ __forceinline__ void attn_qtile(const bf16x8 (&qf)[DH / 32], LAS const unsigned char* Kl, LAS const unsigned char* Vl, int lane, float scale,
                                           int t, int s0, int smin, float slope, float sink, f32x4 (&o)[DH / 16]) {
    const int fr = lane & 15, fq = lane >> 4;
    f32x4 s[NKT];
#pragma unroll
    for (int kt = 0; kt < NKT; ++kt) { s[kt] = (f32x4){0.f, 0.f, 0.f, 0.f};
#pragma unroll
        for (int ks = 0; ks < DH / 32; ++ks) { const bf16x8 kf = *(const LAS bf16x8*)(Kl + (kt * 16 + fr) * KP + (ks * 32 + fq * 8) * 2);
            s[kt] = __builtin_amdgcn_mfma_f32_16x16x32_bf16(kf, qf[ks], s[kt], 0, 0, 0); } }
    float mx = -1e30f;
#pragma unroll
    for (int kt = 0; kt < NKT; ++kt)
#pragma unroll
        for (int r = 0; r < 4; ++r) { float v = s[kt][r] * scale;
            if (SWA) { const int sp = s0 + kt * 16 + fq * 4 + r; const int dist = t - sp; const bool valid = (dist >= 0) && (dist < 128) && (sp >= smin); v = valid ? v - slope * (float)dist : -1e30f; }
            s[kt][r] = v; mx = fmaxf(mx, v); }
    mx = fmaxf(mx, __shfl_xor(mx, 16)); mx = fmaxf(mx, __shfl_xor(mx, 32));
    if (SWA) mx = fmaxf(mx, sink);
    float sum = 0.f;
#pragma unroll
    for (int kt = 0; kt < NKT; ++kt)
#pragma unroll
        for (int r = 0; r < 4; ++r) { const float p = fexp(s[kt][r] - mx); s[kt][r] = p; sum += p; }
    sum += __shfl_xor(sum, 16); sum += __shfl_xor(sum, 32);
    if (SWA) sum += fexp(sink - mx);
    const float inv = 1.0f / sum;
#pragma unroll
    for (int dt = 0; dt < DH / 16; ++dt) o[dt] = (f32x4){0.f, 0.f, 0.f, 0.f};
    const int q4 = fr >> 2, p4 = fr & 3;
#pragma unroll
    for (int c = 0; c < NKT / 2; ++c) {
        u32x4 pw; pw.x = cvt_pk_bf16(s[2 * c][0], s[2 * c][1]); pw.y = cvt_pk_bf16(s[2 * c][2], s[2 * c][3]); pw.z = cvt_pk_bf16(s[2 * c + 1][0], s[2 * c + 1][1]); pw.w = cvt_pk_bf16(s[2 * c + 1][2], s[2 * c + 1][3]);
        const bf16x8 pf = __builtin_bit_cast(bf16x8, pw);
#pragma unroll
        for (int dt = 0; dt < DH / 16; ++dt) {
            const s16x4 lo = vtr(Vl + (c * 32 + fq * 4 + q4) * KP + (dt * 16 + p4 * 4) * 2);
            const s16x4 hi = vtr(Vl + (c * 32 + 16 + fq * 4 + q4) * KP + (dt * 16 + p4 * 4) * 2);
            bf16x8 vf; vf[0] = lo[0]; vf[1] = lo[1]; vf[2] = lo[2]; vf[3] = lo[3]; vf[4] = hi[0]; vf[5] = hi[1]; vf[6] = hi[2]; vf[7] = hi[3];
            o[dt] = __builtin_amdgcn_mfma_f32_16x16x32_bf16(vf, pf, o[dt], 0, 0, 0); } }
#pragma unroll
    for (int dt = 0; dt < DH / 16; ++dt) o[dt] = o[dt] * inv;
}

__device__ __forceinline__ void phase_swa(const KA& a, const Ctx& C) {
    const Ids I = get_ids();
    unsigned char* ws = a.ws();
    const bf16_t* P = (const bf16_t*)(ws + WS_P); bf16_t* Y = (bf16_t*)(ws + WS_YB1); const float* sinks = a.in(17);
    constexpr int KP = 144, ROWS = 272;
    LAS unsigned char* Kl = C.lds; LAS unsigned char* Vl = C.lds + ROWS * KP;
    for (int u = C.bid; u < BATCH * 2 * 32; u += C.G) {
        const int qb = u & 31, hk = (u >> 5) & 1, b = u >> 6;
        const int pos0 = qb * 128 - 128;
        __syncthreads();
        for (int i = I.tid; i < ROWS * 8 * 2; i += 512) { const int which = i >= ROWS * 8; const int j = which ? i - ROWS * 8 : i; const int r = j >> 3, ch = j & 7; const int pos = pos0 + r;
            u32x4 v = (u32x4){0u, 0u, 0u, 0u};
            if (pos >= 0 && r < 256) v = *(const u32x4*)(P + (size_t)(b * SEQ + pos) * 3072 + SWA_OFF + 512 + which * 128 + hk * 64 + ch * 8);
            *(LAS u32x4*)((which ? Vl : Kl) + r * KP + ch * 16) = v; }
        __syncthreads();
        const int g = I.wave >> 1, half = I.wave & 1, h = hk * 4 + g;
        const float slope = __builtin_amdgcn_exp2f(-(float)(h + 1)); const float sink = sinks[h];
        const int fr = I.lane & 15, fq = I.lane >> 4;
#pragma unroll 1
        for (int qt = 0; qt < 4; ++qt) {
            const int trel = half * 64 + qt * 16;
            const int tq = qb * 128 + trel + fr;
            const bf16_t* qrow = P + (size_t)(b * SEQ + tq) * 3072 + SWA_OFF + h * 64;
            bf16x8 qf[2]; qf[0] = *(const bf16x8*)(qrow + fq * 8); qf[1] = *(const bf16x8*)(qrow + 32 + fq * 8);
            f32x4 o[4];
            attn_qtile<64, 10, KP, true>(qf, Kl + trel * KP, Vl + trel * KP, I.lane, 0.125f, tq, pos0 + trel, 0, slope, sink, o);
            bf16_t* yrow = Y + (size_t)(b * SEQ + tq) * 512 + h * 64;
#pragma unroll
            for (int dt = 0; dt < 4; ++dt) { u32x2 w; w.x = cvt_pk_bf16(o[dt][0], o[dt][1]); w.y = cvt_pk_bf16(o[dt][2], o[dt][3]); *(u32x2*)(yrow + dt * 16 + fq * 4) = w; }
        }
    }
    __syncthreads();
}

__device__ __forceinline__ void phase_mem(const KA& a, const Ctx& C) {
    const Ids I = get_ids();
    unsigned char* ws = a.ws();
    const bf16_t* P = (const bf16_t*)(ws + WS_P); const bf16_t* KVM = (const bf16_t*)(ws + WS_KVM); bf16_t* Y = (bf16_t*)(ws + WS_YB2);
    constexpr int KP = 272, ROWS = 256;
    LAS unsigned char* Kl = C.lds; LAS unsigned char* Vl = C.lds + ROWS * KP;
    for (int u = C.bid; u < BATCH * 4 * 8; u += C.G) {
        const int qb = u & 7, h = (u >> 3) & 3, b = u >> 5;
        __syncthreads();
        for (int i = I.tid; i < ROWS * 16 * 2; i += 512) { const int which = i >= ROWS * 16; const int j = which ? i - ROWS * 16 : i; const int r = j >> 4, ch = j & 15;
            const u32x4 v = *(const u32x4*)(KVM + (size_t)(b * MEM_LEN + r) * 1024 + which * 512 + h * 128 + ch * 8);
            *(LAS u32x4*)((which ? Vl : Kl) + r * KP + ch * 16) = v; }
        __syncthreads();
        const int fr = I.lane & 15, fq = I.lane >> 4;
#pragma unroll 1
        for (int qt = 0; qt < 4; ++qt) {
            const int tq = qb * 512 + I.wave * 64 + qt * 16 + fr;
            const bf16_t* qrow = P + (size_t)(b * SEQ + tq) * 3072 + MEMQ_OFF + h * 128;
            bf16x8 qf[4];
#pragma unroll
            for (int ks = 0; ks < 4; ++ks) qf[ks] = *(const bf16x8*)(qrow + ks * 32 + fq * 8);
            f32x4 o[8];
            attn_qtile<128, 16, KP, false>(qf, Kl, Vl, I.lane, 0.08838834764831845f, 0, 0, 0, 0.f, 0.f, o);
            bf16_t* yrow = Y + (size_t)(b * SEQ + tq) * 512 + h * 128;
#pragma unroll
            for (int dt = 0; dt < 8; ++dt) { u32x2 w; w.x = cvt_pk_bf16(o[dt][0], o[dt][1]); w.y = cvt_pk_bf16(o[dt][2], o[dt][3]); *(u32x2*)(yrow + dt * 16 + fq * 4) = w; }
        }
    }
    __syncthreads();
}
__device__ __forceinline__ float dpp_add16(float x) {
    x += __builtin_bit_cast(float, __builtin_amdgcn_update_dpp(0, __builtin_bit_cast(int, x), 0xB1, 0xF, 0xF, true));
    x += __builtin_bit_cast(float, __builtin_amdgcn_update_dpp(0, __builtin_bit_cast(int, x), 0x4E, 0xF, 0xF, true));
    x += __builtin_bit_cast(float, __builtin_amdgcn_update_dpp(0, __builtin_bit_cast(int, x), 0x124, 0xF, 0xF, true));
    x += __builtin_bit_cast(float, __builtin_amdgcn_update_dpp(0, __builtin_bit_cast(int, x), 0x128, 0xF, 0xF, true));
    return x;
}
struct RwRaw { u32x2 r, kr, as, v; f32x4 w; };
struct RwOps { f32x4 w4, a4, b4, k4, r4; float vv; };
__device__ __forceinline__ void phase_rwkv(const KA& a, const Ctx& C) {
    const Ids I = get_ids();
    unsigned char* ws = a.ws();
    const bf16_t* R = (const bf16_t*)(ws + WS_R); const bf16_t* KR = (const bf16_t*)(ws + WS_KR); const bf16_t* V = (const bf16_t*)(ws + WS_V); const bf16_t* ASIG = (const bf16_t*)(ws + WS_ASIG);
    const float* W = (const float*)(ws + WS_W); float* YRAW = (float*)(ws + WS_YRAW); float* BONUS = (float*)(ws + MS_BONUS);
    const float* k_k = a.in(12); const float* k_a = a.in(13); const float* r_k = a.in(14);
    constexpr int TC = 32, NCH = SEQ / TC;
    LAS float* SEQB = (LAS float*)C.lds;
    LAS float* VB = (LAS float*)(C.lds + 2 * TC * 5 * 64 * 4);
    LAS float* YO = VB + 2 * TC * 16;
    LAS float* DUMMY = YO + 2 * TC * 16;
    for (int item = C.bid; item < BATCH * 8 * 4; item += C.G) {
        const int rg = item & 3, h = (item >> 2) & 7, b = item >> 5;
        const int colh = h * 64; const size_t row0 = (size_t)b * SEQ;
        const bool loader = I.wave >= 4; const int lw = I.wave - 4;
        const int g4 = I.lane >> 4, q = I.lane & 15;
        f32x4 kkc = (f32x4){0.f, 0.f, 0.f, 0.f}, kac = kkc, rkc = kkc;
        if (loader) { kkc = *(const f32x4*)(k_k + colh + 4 * q); kac = *(const f32x4*)(k_a + colh + 4 * q); rkc = *(const f32x4*)(r_k + colh + 4 * q); }
        f32x2 s01 = (f32x2){0.f, 0.f}, s23 = s01;
        const int crow = I.tid >> 4, kq = I.tid & 15;
        RwRaw cur[2], nxt[2];
#define RW_LOAD(cn, raw) do { _Pragma("unroll") for (int j = 0; j < 2; ++j) { const size_t m = row0 + (size_t)(cn) * TC + lw * 8 + j * 4 + g4; const size_t o = m * 512 + colh + 4 * q; \
            raw[j].r = *(const u32x2*)(R + o); raw[j].kr = *(const u32x2*)(KR + o); raw[j].as = *(const u32x2*)(ASIG + o); raw[j].w = *(const f32x4*)(W + o); \
            raw[j].v = *(const u32x2*)(V + m * 512 + colh + rg * 16 + 4 * (q & 3)); } } while (0)
        if (loader) RW_LOAD(0, cur);
        __syncthreads();
#pragma unroll 1
        for (int c = -1; c < NCH; ++c) {
            if (loader) {
                if (c + 2 < NCH) RW_LOAD(c + 2, nxt);
                if (c + 1 < NCH) {
                    const int buf = (c + 1) & 1;
#pragma unroll
                    for (int j = 0; j < 2; ++j) { const int tl = lw * 8 + j * 4 + g4;
                        const f32x4 r = (f32x4){bf_lo(cur[j].r.x), bf_hi(cur[j].r.x), bf_lo(cur[j].r.y), bf_hi(cur[j].r.y)};
                        const f32x4 kr = (f32x4){bf_lo(cur[j].kr.x), bf_hi(cur[j].kr.x), bf_lo(cur[j].kr.y), bf_hi(cur[j].kr.y)};
                        const f32x4 as = (f32x4){bf_lo(cur[j].as.x), bf_hi(cur[j].as.x), bf_lo(cur[j].as.y), bf_hi(cur[j].as.y)};
                        const f32x4 kkv = kr * kkc;
                        const float n2 = dpp_add16((kkv[0] * kkv[0] + kkv[1] * kkv[1]) + (kkv[2] * kkv[2] + kkv[3] * kkv[3]));
                        const f32x4 kkn = kkv * (1.0f / fmaxf(sqrtf(n2), 1e-12f));
                        const f32x4 kmod = kr * ((as - 1.0f) * kac + 1.0f);
                        LAS float* d = SEQB + ((buf * TC + tl) * 5) * 64 + 4 * q;
                        *(LAS f32x4*)(d) = cur[j].w; *(LAS f32x4*)(d + 64) = -kkn; *(LAS f32x4*)(d + 128) = kkn * as; *(LAS f32x4*)(d + 192) = kmod; *(LAS f32x4*)(d + 256) = r;
                        if (q < 4) *(LAS f32x4*)(VB + (buf * TC + tl) * 16 + 4 * q) = (f32x4){bf_lo(cur[j].v.x), bf_hi(cur[j].v.x), bf_lo(cur[j].v.y), bf_hi(cur[j].v.y)};
                        if (rg == 0) { const f32x4 t = r * kmod * rkc; const float bs = dpp_add16((t[0] + t[1]) + (t[2] + t[3])); if (q == 0) BONUS[(row0 + (size_t)(c + 1) * TC + tl) * 8 + h] = bs; } }
                }
                if (c >= 1) {
                    const int buf = (c - 1) & 1; const int lt = I.tid - 256;
#pragma unroll
                    for (int i = 0; i < 2; ++i) { const int e = lt + 256 * i; const int tl = e >> 4, rr = e & 15;
                        YRAW[(row0 + (size_t)(c - 1) * TC + tl) * 512 + colh + rg * 16 + rr] = YO[(buf * TC + tl) * 16 + rr]; }
                }
                cur[0] = nxt[0]; cur[1] = nxt[1];
            } else if (c >= 0) {
                const int buf = c & 1;
                const LAS float* dbase = SEQB + (buf * TC * 5) * 64 + kq * 4; const LAS float* vbase = VB + buf * TC * 16 + crow;
                LAS float* ybase = (kq == 0) ? (YO + buf * TC * 16 + crow) : (DUMMY + I.tid);
#define RW_OPS(o, tl) do { const LAS float* d = dbase + (tl) * 320; o.w4 = *(const LAS f32x4*)(d); o.a4 = *(const LAS f32x4*)(d + 64); o.b4 = *(const LAS f32x4*)(d + 128); o.k4 = *(const LAS f32x4*)(d + 192); o.r4 = *(const LAS f32x4*)(d + 256); o.vv = vbase[(tl) * 16]; } while (0)
                RwOps oc, on; RW_OPS(oc, 0);
#pragma unroll
                for (int tl = 0; tl < TC; ++tl) {
                    if (tl + 1 < TC) RW_OPS(on, tl + 1);
                    const f32x2 vv2 = (f32x2){oc.vv, oc.vv};
                    f32x2 pa = s01 * (f32x2){oc.a4[0], oc.a4[1]}; pa = s23 * (f32x2){oc.a4[2], oc.a4[3]} + pa;
                    float sa = pa[0] + pa[1];
                    const f32x2 t01 = s01 * (f32x2){oc.w4[0], oc.w4[1]} + vv2 * (f32x2){oc.k4[0], oc.k4[1]}, t23 = s23 * (f32x2){oc.w4[2], oc.w4[3]} + vv2 * (f32x2){oc.k4[2], oc.k4[3]};
                    sa = dpp_add16(sa);
                    const f32x2 sa2 = (f32x2){sa, sa};
                    s01 = sa2 * (f32x2){oc.b4[0], oc.b4[1]} + t01; s23 = sa2 * (f32x2){oc.b4[2], oc.b4[3]} + t23;
                    f32x2 py = s01 * (f32x2){oc.r4[0], oc.r4[1]}; py = s23 * (f32x2){oc.r4[2], oc.r4[3]} + py;
                    float y = py[0] + py[1];
                    y = dpp_add16(y);
                    ybase[tl * 16] = y;
                    oc = on;
                }
#undef RW_OPS
            }
            __syncthreads();
        }
#undef RW_LOAD
        if (loader) {
            const int buf = (NCH - 1) & 1; const int lt = I.tid - 256;
#pragma unroll
            for (int i = 0; i < 2; ++i) { const int e = lt + 256 * i; const int tl = e >> 4, rr = e & 15;
                YRAW[(row0 + (size_t)(NCH - 1) * TC + tl) * 512 + colh + rg * 16 + rr] = YO[(buf * TC + tl) * 16 + rr]; }
        }
    }
    __syncthreads();
}

__device__ __forceinline__ void phase_gn(const KA& a, const Ctx& C) {
    const Ids I = get_ids();
    unsigned char* ws = a.ws();
    const float* YRAW = (const float*)(ws + WS_YRAW); const float* BONUS = (const float*)(ws + MS_BONUS); const bf16_t* V = (const bf16_t*)(ws + WS_V);
    bf16_t* Y0 = (bf16_t*)(ws + WS_YB0);
    const float* lw = a.in(15); const float* lb = a.in(16);
    const int gw = C.bid * NWAVES + I.wave, NGW = C.G * NWAVES;
    float lwv[8], lbv[8];
#pragma unroll
    for (int h = 0; h < 8; ++h) { lwv[h] = lw[h * 64 + I.lane]; lbv[h] = lb[h * 64 + I.lane]; }
    for (int m = gw; m < NTOK; m += NGW) {
        const size_t o = (size_t)m * 512 + I.lane;
        float y[8], s1[8], vv[8], gg[8], bn[8];
#pragma unroll
        for (int h = 0; h < 8; ++h) { y[h] = YRAW[o + h * 64]; vv[h] = bf1(V[o + h * 64]); gg[h] = bf1(Y0[o + h * 64]); bn[h] = BONUS[m * 8 + h]; s1[h] = y[h]; }
#pragma unroll
        for (int of = 1; of < 64; of <<= 1) {
#pragma unroll
            for (int h = 0; h < 8; ++h) s1[h] += __shfl_xor(s1[h], of); }
        float d[8], s2[8];
#pragma unroll
        for (int h = 0; h < 8; ++h) { d[h] = y[h] - s1[h] * (1.0f / 64.0f); s2[h] = d[h] * d[h]; }
#pragma unroll
        for (int of = 1; of < 64; of <<= 1) {
#pragma unroll
            for (int h = 0; h < 8; ++h) s2[h] += __shfl_xor(s2[h], of); }
#pragma unroll
        for (int h = 0; h < 8; ++h) { float yn = d[h] * (1.0f / sqrtf(s2[h] * (1.0f / 64.0f) + 64e-5f)) * lwv[h] + lbv[h]; yn += bn[h] * vv[h]; Y0[o + h * 64] = (bf16_t)f2bf(yn * gg[h]); }
    }
}

__device__ __forceinline__ void phase_router(const KA& a, const Ctx& C) {
    const Ids I = get_ids();
    unsigned char* ws = a.ws();
    const float* H1 = a.out(); bf16_t* HB = (bf16_t*)(ws + WS_HB); const bf16_t* WRT = (const bf16_t*)(ws + MS_WRT); const float* b_router = a.in(24);
    float* RSTD2 = (float*)(ws + MS_RSTD2); int* TOKE = (int*)(ws + MS_TOKE); int* TOKPOS = (int*)(ws + MS_TOKPOS); float* TOKG = (float*)(ws + MS_TOKG);
    unsigned* cnt = (unsigned*)(ws + WS_CTL) + CW_CNT;
    constexpr int WP = 2080;
    LAS unsigned char* WL = C.lds;
    LAS float* LG = (LAS float*)(C.lds + 64 * WP + I.wave * 2304);
    LAS unsigned* lcnt = (LAS unsigned*)(C.lds + 64 * WP + 8 * 2304);
    const int gw = C.bid * NWAVES + I.wave, NGW = C.G * NWAVES;
    const int fr = I.lane & 15, fq = I.lane >> 4;
    for (int i = I.tid; i < 64 * 128; i += 512) { const int row = i >> 7, ch = i & 127; *(LAS u32x4*)(WL + row * WP + ch * 16) = *(const u32x4*)(WRT + (size_t)row * 1024 + ch * 8); }
    for (int grp0 = C.bid * NWAVES; grp0 < NTOK / 16; grp0 += NGW) {
        const int grp = grp0 + I.wave; const bool live = grp < NTOK / 16;
        if (I.tid < 64) lcnt[I.tid] = 0u;
        __syncthreads();
        const int m = (live ? grp : 0) * 16 + fr;
        const float* hrow = H1 + (size_t)m * 1024;
        f32x4 acc0 = (f32x4){0.f, 0.f, 0.f, 0.f}, acc1 = acc0; float ss = 0.f;
        f32x4 xa[8], xb[8];
#define RT_LOADX(X, g) do { _Pragma("unroll") for (int s = 0; s < 4; ++s) { const float* _p = hrow + ((g) * 4 + s) * 32 + fq * 8; X[2 * s] = *(const f32x4*)_p; X[2 * s + 1] = *(const f32x4*)(_p + 4); } } while (0)
#define RT_COMP(X, g) do { _Pragma("unroll") for (int s = 0; s < 4; ++s) { const int k0 = ((g) * 4 + s) * 32 + fq * 8; const f32x4 x0 = X[2 * s], x1 = X[2 * s + 1]; \
            ss += (x0[0] * x0[0] + x0[1] * x0[1]) + (x0[2] * x0[2] + x0[3] * x0[3]) + (x1[0] * x1[0] + x1[1] * x1[1]) + (x1[2] * x1[2] + x1[3] * x1[3]); \
            u32x4 hi; hi.x = pk2(x0[0], x0[1]); hi.y = pk2(x0[2], x0[3]); hi.z = pk2(x1[0], x1[1]); hi.w = pk2(x1[2], x1[3]); \
            { u32x2 q8; q8.x = cvt_fp8x4(x0[0], x0[1], x0[2], x0[3]); q8.y = cvt_fp8x4(x1[0], x1[1], x1[2], x1[3]); *(u32x2*)((unsigned char*)HB + (size_t)m * 1024 + k0) = q8; } \
            u32x4 lo; lo.x = pk2(x0[0] - bf_lo(hi.x), x0[1] - bf_hi(hi.x)); lo.y = pk2(x0[2] - bf_lo(hi.y), x0[3] - bf_hi(hi.y)); lo.z = pk2(x1[0] - bf_lo(hi.z), x1[1] - bf_hi(hi.z)); lo.w = pk2(x1[2] - bf_lo(hi.w), x1[3] - bf_hi(hi.w)); \
            const bf16x8 ah = __builtin_bit_cast(bf16x8, hi), al = __builtin_bit_cast(bf16x8, lo); \
            LAS const unsigned char* _w = WL + fr * WP + k0 * 2; \
            const bf16x8 wh0 = *(const LAS bf16x8*)_w, wh1 = *(const LAS bf16x8*)(_w + 16 * WP), wl0 = *(const LAS bf16x8*)(_w + 32 * WP), wl1 = *(const LAS bf16x8*)(_w + 48 * WP); \
            acc0 = __builtin_amdgcn_mfma_f32_16x16x32_bf16(ah, wh0, acc0, 0, 0, 0); acc0 = __builtin_amdgcn_mfma_f32_16x16x32_bf16(ah, wl0, acc0, 0, 0, 0); acc0 = __builtin_amdgcn_mfma_f32_16x16x32_bf16(al, wh0, acc0, 0, 0, 0); \
            acc1 = __builtin_amdgcn_mfma_f32_16x16x32_bf16(ah, wh1, acc1, 0, 0, 0); acc1 = __builtin_amdgcn_mfma_f32_16x16x32_bf16(ah, wl1, acc1, 0, 0, 0); acc1 = __builtin_amdgcn_mfma_f32_16x16x32_bf16(al, wh1, acc1, 0, 0, 0); } } while (0)
        RT_LOADX(xa, 0);
#pragma unroll 1
        for (int g = 0; g < 8; g += 2) { RT_LOADX(xb, g + 1); RT_COMP(xa, g); if (g + 2 < 8) RT_LOADX(xa, g + 2); RT_COMP(xb, g + 1); }
#undef RT_LOADX
#undef RT_COMP
        ss += __shfl_xor(ss, 16); ss += __shfl_xor(ss, 32);
        const float rstd = 1.0f / sqrtf(ss * (1.0f / 1024.0f) + 1e-5f);
#pragma unroll
        for (int r = 0; r < 4; ++r) { LG[(fq * 4 + r) * 36 + fr] = acc0[r]; LG[(fq * 4 + r) * 36 + 16 + fr] = acc1[r]; }
        LDS_WAIT(); asm volatile("" ::: "memory");
        int sel[4] = {0, 0, 0, 0}; unsigned lpos[4] = {0u, 0u, 0u, 0u};
        if (I.lane < 16 && live) {
            float lg[32];
#pragma unroll
            for (int e = 0; e < 32; ++e) lg[e] = LG[fr * 36 + e] * rstd + b_router[e];
            float sv[4];
#pragma unroll
            for (int j = 0; j < 4; ++j) { float best = -3.0e38f; int bi = 0;
#pragma unroll
                for (int e = 0; e < 32; ++e) { const bool take = lg[e] > best; best = take ? lg[e] : best; bi = take ? e : bi; }
                sel[j] = bi; sv[j] = best;
#pragma unroll
                for (int e = 0; e < 32; ++e) lg[e] = (e == bi) ? -3.0e38f : lg[e]; }
            const float e0 = 1.0f, e1 = fexp(sv[1] - sv[0]), e2 = fexp(sv[2] - sv[0]), e3 = fexp(sv[3] - sv[0]); const float inv = 1.0f / (e0 + e1 + e2 + e3);
            const float gt[4] = {e0 * inv, e1 * inv, e2 * inv, e3 * inv};
            RSTD2[m] = rstd;
#pragma unroll
            for (int j = 0; j < 4; ++j) { lpos[j] = __hip_atomic_fetch_add(lcnt + sel[j], 1u, __ATOMIC_RELAXED, __HIP_MEMORY_SCOPE_WORKGROUP); TOKE[m * 4 + j] = sel[j]; TOKG[m * 4 + j] = gt[j]; }
        }
        __syncthreads();
        if (I.tid < 32) { const unsigned n = lcnt[I.tid]; lcnt[32 + I.tid] = n ? atomicAdd(cnt + I.tid * 64, n) : 0u; }
        __syncthreads();
        if (I.lane < 16 && live) {
#pragma unroll
            for (int j = 0; j < 4; ++j) TOKPOS[m * 4 + j] = (int)(lcnt[32 + sel[j]] + lpos[j]);
        }
        __syncthreads();
    }
}

__device__ __forceinline__ void phase_slots(const KA& a, const Ctx& C) {
    const Ids I = get_ids();
    unsigned char* ws = a.ws();
    const unsigned* cnt = (const unsigned*)(ws + WS_CTL) + CW_CNT; unsigned* ctl = (unsigned*)(ws + WS_CTL);
    const float* RSTD2 = (const float*)(ws + MS_RSTD2); const int* TOKE = (const int*)(ws + MS_TOKE); const int* TOKPOS = (const int*)(ws + MS_TOKPOS); const float* TOKG = (const float*)(ws + MS_TOKG);
    int* TOKSLOT = (int*)(ws + MS_TOKSLOT); int* SLOTTOK = (int*)(ws + MS_SLOTTOK); float* SLOTG = (float*)(ws + MS_SLOTG); float* SLOTRS = (float*)(ws + MS_SLOTRS); int* TILEE = (int*)(ws + MS_TILEE);
    LAS int* off = (LAS int*)C.lds; LAS int* cn = off + 40;
    __syncthreads();
    if (I.tid == 0) { int o = 0; for (int e = 0; e < NEXP; ++e) { const int c = (int)__hip_atomic_load(cnt + e * 64, __ATOMIC_RELAXED, __HIP_MEMORY_SCOPE_AGENT); off[e] = o; cn[e] = c; o += ((c + 255) >> 8) << 8; } off[NEXP] = o; }
    __syncthreads();
    if (C.bid == 0) {
        if (I.tid == 0) ctl[CW_NTILES] = (unsigned)(off[NEXP] >> 8);
        for (int e = 0; e < NEXP; ++e) for (int t = (off[e] >> 8) + I.tid; t < (off[e + 1] >> 8); t += 512) TILEE[t] = e;
    }
    for (int i = C.bid * 512 + I.tid; i < NTOK * 4; i += C.G * 512) { const int m = i >> 2; const int e = TOKE[i]; const int slot = off[e] + TOKPOS[i];
        TOKSLOT[i] = slot; SLOTTOK[slot] = m; SLOTG[slot] = TOKG[i]; SLOTRS[slot] = RSTD2[m]; }
    for (int e = 0; e < NEXP; ++e) for (int s = off[e] + cn[e] + C.bid * 512 + I.tid; s < off[e + 1]; s += C.G * 512) { SLOTTOK[s] = 0; SLOTG[s] = 0.f; SLOTRS[s] = 0.f; }
    __syncthreads();
}

__device__ __forceinline__ void phase_final(const KA& a, const Ctx& C) {
    const Ids I = get_ids();
    unsigned char* ws = a.ws();
    float* OUT = a.out(); const bf16_t* YS = (const bf16_t*)(ws + WS_YSLOT); const int* TOKSLOT = (const int*)(ws + MS_TOKSLOT); const float* fw = a.in(29);
    const int gw = C.bid * NWAVES + I.wave, NGW = C.G * NWAVES;
    const f32x4* fwp = (const f32x4*)fw + I.lane; f32x4 fwv[4];
#pragma unroll
    for (int j = 0; j < 4; ++j) fwv[j] = fwp[64 * j];
    f32x4 v[4], vn[4]; unsigned ys[4][4], ysn[4][4]; int sl[4], sln[4];
#define FIN_LOAD_A(mm, V, S) do { const f32x4* _o = (const f32x4*)(OUT + (size_t)(mm) * 1024) + I.lane; _Pragma("unroll") for (int j = 0; j < 4; ++j) { V[j] = _o[64 * j]; S[j] = TOKSLOT[(mm) * 4 + j]; } } while (0)
#define FIN_LOAD_B(S, Y) do { _Pragma("unroll") for (int s = 0; s < 4; ++s) { const unsigned* _y = (const unsigned*)((const unsigned char*)YS + (size_t)S[s] * 1024) + I.lane; _Pragma("unroll") for (int j = 0; j < 4; ++j) Y[s][j] = _y[64 * j]; } } while (0)
    if (gw < NTOK) { FIN_LOAD_A(gw, v, sl); FIN_LOAD_B(sl, ys); }
    if (gw + NGW < NTOK) FIN_LOAD_A(gw + NGW, vn, sln);
    for (int m = gw; m < NTOK; m += NGW) {
        f32x4* orow = (f32x4*)(OUT + (size_t)m * 1024) + I.lane;
        const bool has1 = m + NGW < NTOK, has2 = m + 2 * NGW < NTOK;
        if (has1) FIN_LOAD_B(sln, ysn);
#pragma unroll
        for (int s = 0; s < 4; ++s)
#pragma unroll
            for (int j = 0; j < 4; ++j) { const int y = (int)ys[s][j]; v[j][0] += __builtin_amdgcn_cvt_f32_fp8(y, 0); v[j][1] += __builtin_amdgcn_cvt_f32_fp8(y, 1); v[j][2] += __builtin_amdgcn_cvt_f32_fp8(y, 2); v[j][3] += __builtin_amdgcn_cvt_f32_fp8(y, 3); }
        float ss = 0.f;
#pragma unroll
        for (int j = 0; j < 4; ++j) ss += (v[j][0] * v[j][0] + v[j][1] * v[j][1]) + (v[j][2] * v[j][2] + v[j][3] * v[j][3]);
        const float rstd = 1.0f / sqrtf(wave_sum(ss) * (1.0f / 1024.0f) + 1e-5f);
#pragma unroll
        for (int j = 0; j < 4; ++j) __builtin_nontemporal_store(v[j] * rstd * fwv[j], orow + 64 * j);
#pragma unroll
        for (int j = 0; j < 4; ++j) { v[j] = vn[j]; sl[j] = sln[j];
#pragma unroll
            for (int s = 0; s < 4; ++s) ys[s][j] = ysn[s][j]; }
        if (has2) FIN_LOAD_A(m + 2 * NGW, vn, sln);
    }
#undef FIN_LOAD_A
#undef FIN_LOAD_B
}

constexpr size_t WS_RWT = WS_RWT0;
constexpr size_t WS_RWS = 936 * MiB;
constexpr size_t WS_GC = WS_MISC + 8 * MiB;
constexpr int RT_TA = 0, RT_TL = 1, RT_BT = 2, RT_KT = 3, RT_RT = 4, RT_VT = 5;
__device__ __forceinline__ int toff(int r, int c16) { return r * 128 + ((c16 ^ ((r >> 1) & 7)) << 4); }
__device__ __forceinline__ bf16x8 frag_row(LAS const unsigned char* t, int row, int ks, int fq) { return *(const LAS bf16x8*)(t + toff(row, 4 * ks + fq)); }
__device__ __forceinline__ bf16x8 frag_row_slots(LAS const unsigned char* t, int row, int js, int fq) {
    const u32x2 lo = *(const LAS u32x2*)(t + toff(row, 4 * js + (fq >> 1)) + (fq & 1) * 8), hi = *(const LAS u32x2*)(t + toff(row, 4 * js + 2 + (fq >> 1)) + (fq & 1) * 8);
    u32x4 w; w.x = lo.x; w.y = lo.y; w.z = hi.x; w.w = hi.y; return __builtin_bit_cast(bf16x8, w);
}
__device__ __forceinline__ bf16x8 frag_tr(LAS const unsigned char* t, int ct, int js, int lane) {
    const int fq = lane >> 4, i = lane & 15, q = i >> 2, p = i & 3;
    const int r0 = 32 * js + 4 * fq + q, r1 = r0 + 16; const int c16 = 2 * ct + (p >> 1), bo = (p & 1) * 8;
    const s16x4 lo = vtr(t + toff(r0, c16) + bo), hi = vtr(t + toff(r1, c16) + bo);
    bf16x8 f; f[0] = lo[0]; f[1] = lo[1]; f[2] = lo[2]; f[3] = lo[3]; f[4] = hi[0]; f[5] = hi[1]; f[6] = hi[2]; f[7] = hi[3]; return f;
}
__device__ __forceinline__ float dpp_add8(float x) {
    x += __builtin_bit_cast(float, __builtin_amdgcn_update_dpp(0, __builtin_bit_cast(int, x), 0xB1, 0xF, 0xF, true));
    x += __builtin_bit_cast(float, __builtin_amdgcn_update_dpp(0, __builtin_bit_cast(int, x), 0x4E, 0xF, 0xF, true));
    x += __builtin_bit_cast(float, __builtin_amdgcn_update_dpp(0, __builtin_bit_cast(int, x), 0x141, 0xF, 0xF, true));
    return x;
}
#define MFMA16(a, b, c) __builtin_amdgcn_mfma_f32_16x16x32_bf16(a, b, c, 0, 0, 0)

struct RcRaw { u32x4 kr, as, r, v; f32x4 lw0, lw1, kk0, kk1, ka0, ka1, rk0, rk1; };
#define RC_LBAR() do { asm volatile("s_waitcnt lgkmcnt(0)" ::: "memory"); __builtin_amdgcn_s_barrier(); asm volatile("" ::: "memory"); } while (0)
__device__ __forceinline__ void phase_rwkv_pre(const KA& a, const Ctx& C) {
    const Ids I = get_ids();
    unsigned char* ws = a.ws();
    const bf16_t* R = (const bf16_t*)(ws + WS_R); const bf16_t* KR = (const bf16_t*)(ws + WS_KR); const bf16_t* V = (const bf16_t*)(ws + WS_V); const bf16_t* ASIG = (const bf16_t*)(ws + WS_ASIG);
    const float* LW = (const float*)(ws + WS_W); float* BONUS = (float*)(ws + MS_BONUS); float* GC = (float*)(ws + WS_GC);
    unsigned char* RWT = ws + WS_RWT; unsigned char* SCR = ws + WS_RWS + (size_t)C.bid * (8 * 40960);
    const float* k_k = a.in(12); const float* k_a = a.in(13); const float* r_k = a.in(14);
    LAS unsigned char* lds = C.lds;
    const int tid = I.tid, lane = I.lane, wave = I.wave, fr = lane & 15, fq = lane >> 4;
    const int ri = tid >> 3, cg = tid & 7;
    for (int grp = C.bid; grp < 512; grp += C.G) {
        RcRaw cur, nxt;
#define RC_LOAD(task, raw) do { const int _bh = (task) >> 6, _ch = (task) & 63; const size_t _m = (size_t)(_bh >> 3) * SEQ + _ch * 64 + ri; const size_t _o = _m * 512 + (_bh & 7) * 64 + 8 * cg; \
        raw.kr = *(const u32x4*)(KR + _o); raw.as = *(const u32x4*)(ASIG + _o); raw.r = *(const u32x4*)(R + _o); raw.v = *(const u32x4*)(V + _o); raw.lw0 = *(const f32x4*)(LW + _o); raw.lw1 = *(const f32x4*)(LW + _o + 4); const int _hc = (_bh & 7) * 64 + 8 * cg; \
        raw.kk0 = *(const f32x4*)(k_k + _hc); raw.kk1 = *(const f32x4*)(k_k + _hc + 4); raw.ka0 = *(const f32x4*)(k_a + _hc); raw.ka1 = *(const f32x4*)(k_a + _hc + 4); raw.rk0 = *(const f32x4*)(r_k + _hc); raw.rk1 = *(const f32x4*)(r_k + _hc + 4); } while (0)
        RC_LOAD(grp * 8, cur);
#pragma unroll 1
        for (int tk = 0; tk < 8; ++tk) {
            const int task = grp * 8 + tk; const int bh = task >> 6, ch = task & 63, h = bh & 7; const size_t m = (size_t)(bh >> 3) * SEQ + ch * 64 + ri;
            if (tk + 1 < 8) RC_LOAD(task + 1, nxt);
            LAS float* LWB = (LAS float*)lds;
            LAS float* SCAN = (LAS float*)(lds + 40960);
            LAS unsigned char* AT = lds + 16384; LAS unsigned char* BT = lds + 24576; LAS unsigned char* KT = lds + 32768;
            unsigned char* gt = RWT + (size_t)task * (6 * 8192); unsigned char* sc = SCR + tk * 40960;
            float kr[8], as[8], rr[8], lw[8];
            { const u32x4 x = cur.kr, y = cur.as, z = cur.r;
              kr[0] = bf_lo(x.x); kr[1] = bf_hi(x.x); kr[2] = bf_lo(x.y); kr[3] = bf_hi(x.y); kr[4] = bf_lo(x.z); kr[5] = bf_hi(x.z); kr[6] = bf_lo(x.w); kr[7] = bf_hi(x.w);
              as[0] = bf_lo(y.x); as[1] = bf_hi(y.x); as[2] = bf_lo(y.y); as[3] = bf_hi(y.y); as[4] = bf_lo(y.z); as[5] = bf_hi(y.z); as[6] = bf_lo(y.w); as[7] = bf_hi(y.w);
              rr[0] = bf_lo(z.x); rr[1] = bf_hi(z.x); rr[2] = bf_lo(z.y); rr[3] = bf_hi(z.y); rr[4] = bf_lo(z.z); rr[5] = bf_hi(z.z); rr[6] = bf_lo(z.w); rr[7] = bf_hi(z.w);
              lw[0] = cur.lw0[0]; lw[1] = cur.lw0[1]; lw[2] = cur.lw0[2]; lw[3] = cur.lw0[3]; lw[4] = cur.lw1[0]; lw[5] = cur.lw1[1]; lw[6] = cur.lw1[2]; lw[7] = cur.lw1[3]; }
            const f32x4 kk0 = cur.kk0, kk1 = cur.kk1, ka0 = cur.ka0, ka1 = cur.ka1, rk0 = cur.rk0, rk1 = cur.rk1;
            float kkn[8], km[8]; float n2 = 0.f, bs = 0.f;
#pragma unroll
            for (int j = 0; j < 8; ++j) { const float kkc = j < 4 ? kk0[j & 3] : kk1[j & 3], kac = j < 4 ? ka0[j & 3] : ka1[j & 3], rkc = j < 4 ? rk0[j & 3] : rk1[j & 3];
                kkn[j] = kr[j] * kkc; n2 += kkn[j] * kkn[j]; km[j] = kr[j] * (1.0f + (as[j] - 1.0f) * kac); bs += rr[j] * km[j] * rkc; }
            n2 = dpp_add8(n2); bs = dpp_add8(bs);
            const float inv = 1.0f / fmaxf(sqrtf(n2), 1e-12f);
            if (cg == 0) BONUS[m * 8 + h] = bs;
            *(LAS f32x4*)(LWB + ri * 64 + 8 * cg) = cur.lw0; *(LAS f32x4*)(LWB + ri * 64 + 8 * cg + 4) = cur.lw1;
            RC_LBAR();
            { const int c = tid & 63, rb = tid >> 6; float p[8]; float run = 0.f;
#pragma unroll
              for (int j = 0; j < 8; ++j) { run += LWB[(8 * rb + j) * 64 + c]; p[j] = run; }
              SCAN[rb * 64 + c] = run;
              RC_LBAR();
              float off = 0.f;
#pragma unroll
              for (int q = 0; q < 8; ++q) off += (q < rb) ? SCAN[q * 64 + c] : 0.f;
#pragma unroll
              for (int j = 0; j < 8; ++j) LWB[(8 * rb + j) * 64 + c] = p[j] + off; }
            RC_LBAR();
            { const f32x4 g0 = *(const LAS f32x4*)(LWB + ri * 64 + 8 * cg), g1 = *(const LAS f32x4*)(LWB + ri * 64 + 8 * cg + 4);
              float at[8], bt[8], kt[8], rt[8];
#pragma unroll
              for (int j = 0; j < 8; ++j) { const float g = j < 4 ? g0[j & 3] : g1[j & 3]; const float eg = fexp(g), egi = fexp(-g), egp = fexp(g - lw[j]); const float kn = kkn[j] * inv;
                  at[j] = -kn * egp; bt[j] = kn * as[j] * egi; kt[j] = km[j] * egi; rt[j] = rr[j] * eg;
                  if (ri == 63) GC[(size_t)task * 64 + 8 * cg + j] = eg; }
              const int so = toff(ri, cg);
              u32x4 pa, pb, pk, pr; pa.x = pk2(at[0], at[1]); pa.y = pk2(at[2], at[3]); pa.z = pk2(at[4], at[5]); pa.w = pk2(at[6], at[7]);
              pb.x = pk2(bt[0], bt[1]); pb.y = pk2(bt[2], bt[3]); pb.z = pk2(bt[4], bt[5]); pb.w = pk2(bt[6], bt[7]);
              pk.x = pk2(kt[0], kt[1]); pk.y = pk2(kt[2], kt[3]); pk.z = pk2(kt[4], kt[5]); pk.w = pk2(kt[6], kt[7]);
              pr.x = pk2(rt[0], rt[1]); pr.y = pk2(rt[2], rt[3]); pr.z = pk2(rt[4], rt[5]); pr.w = pk2(rt[6], rt[7]);
              *(LAS u32x4*)(AT + so) = pa; *(LAS u32x4*)(BT + so) = pb; *(LAS u32x4*)(KT + so) = pk;
              *(u32x4*)(sc + 24576 + so) = pa; *(u32x4*)(gt + RT_BT * 8192 + so) = pb; *(u32x4*)(gt + RT_KT * 8192 + so) = pk; *(u32x4*)(gt + RT_RT * 8192 + so) = pr; *(u32x4*)(gt + RT_VT * 8192 + so) = cur.v; }
            RC_LBAR();
            {
              const int which = wave >> 2, it = wave & 3; LAS const unsigned char* XT = which ? KT : BT;
              const bf16x8 b0 = frag_row(AT, 16 * it + fr, 0, fq), b1 = frag_row(AT, 16 * it + fr, 1, fq);
#pragma unroll
              for (int jt = 0; jt < 4; ++jt) { f32x4 d = (f32x4){0.f, 0.f, 0.f, 0.f};
                  if (jt <= it) { d = MFMA16(frag_row(XT, 16 * jt + fr, 0, fq), b0, d); d = MFMA16(frag_row(XT, 16 * jt + fr, 1, fq), b1, d); }
                  const int i = 16 * it + fr, j0 = 16 * jt + 4 * fq;
#pragma unroll
                  for (int r = 0; r < 4; ++r) d[r] = (j0 + r < i) ? d[r] : 0.f;
                  if (which == 0) { u32x2 w; w.x = pk2(d[0], d[1]); w.y = pk2(d[2], d[3]); *(LAS u32x2*)(lds + 43008 + tk * 8192 + (i * 64 + j0) * 2) = w; }
                  else { u32x2 w; w.x = pk2(d[0], d[1]); w.y = pk2(d[2], d[3]); *(u32x2*)(sc + 16384 + toff(i, 2 * jt + (fq >> 1)) + (fq & 1) * 8) = w; } } }
            RC_LBAR();
            cur = nxt;
        }
#undef RC_LOAD
        __syncthreads();
        { int ln = lane; asm volatile("" : "+v"(ln));
          LAS unsigned char* L = lds + 43008 + wave * 8192;
          float t[64];
#pragma unroll
          for (int i = 0; i < 64; ++i) { float a0 = (ln == i) ? 1.0f : 0.f, a1 = 0.f, a2 = 0.f, a3 = 0.f;
#pragma unroll
              for (int jb = 0; jb < (i + 3) / 4; ++jb) { const u32x2 l4 = *(const LAS u32x2*)(L + (i * 64 + 4 * jb) * 2);
                  a0 += bf_lo(l4.x) * t[4 * jb]; if (4 * jb + 1 < i) a1 += bf_hi(l4.x) * t[4 * jb + 1]; if (4 * jb + 2 < i) a2 += bf_lo(l4.y) * t[4 * jb + 2]; if (4 * jb + 3 < i) a3 += bf_hi(l4.y) * t[4 * jb + 3]; }
              t[i] = (a0 + a1) + (a2 + a3); }
          LDS_WAIT(); asm volatile("" ::: "memory");
#pragma unroll
          for (int i = 0; i < 64; ++i) *(LAS bf16_t*)(L + toff(i, ln >> 3) + (ln & 7) * 2) = (bf16_t)f2bf(t[i]);
        }
        __syncthreads();
        { u32x4 nA, nK;
          { const unsigned char* sc = SCR; nA = *(const u32x4*)(sc + 24576 + tid * 16); nK = *(const u32x4*)(sc + 16384 + tid * 16); }
#pragma unroll 1
          for (int tk = 0; tk < 8; ++tk) {
            const int task = grp * 8 + tk; unsigned char* gt = RWT + (size_t)task * (6 * 8192);
            LAS unsigned char* TT = lds + 43008 + tk * 8192; LAS unsigned char* AT = lds + 8192; LAS unsigned char* LK = lds + 16384;
            *(LAS u32x4*)(AT + tid * 16) = nA; *(LAS u32x4*)(LK + tid * 16) = nK;
            if (tk + 1 < 8) { const unsigned char* sc = SCR + (tk + 1) * 40960; nA = *(const u32x4*)(sc + 24576 + tid * 16); nK = *(const u32x4*)(sc + 16384 + tid * 16); }
            RC_LBAR();
            { const int which = wave >> 2, it = wave & 3; LAS const unsigned char* X = which ? LK : AT;
              const bf16x8 b0 = frag_row_slots(TT, 16 * it + fr, 0, fq), b1 = frag_row_slots(TT, 16 * it + fr, 1, fq);
#pragma unroll
              for (int ct = 0; ct < 4; ++ct) { f32x4 d = (f32x4){0.f, 0.f, 0.f, 0.f};
                  d = MFMA16(frag_tr(X, ct, 0, lane), b0, d); d = MFMA16(frag_tr(X, ct, 1, lane), b1, d);
                  u32x2 w; w.x = pk2(d[0], d[1]); w.y = pk2(d[2], d[3]);
                  *(u32x2*)(gt + (which ? RT_TL : RT_TA) * 8192 + toff(16 * it + fr, 2 * ct + (fq >> 1)) + (fq & 1) * 8) = w; } }
            RC_LBAR();
          } }
        __syncthreads();
    }
}

struct RsStage { u32x4 t[6]; };
__device__ __forceinline__ void phase_rwkv_seq(const KA& a, const Ctx& C) {
    const Ids I = get_ids();
    unsigned char* ws = a.ws();
    const unsigned char* RWT = ws + WS_RWT; const float* GC = (const float*)(ws + WS_GC); const float* BONUS = (const float*)(ws + MS_BONUS);
    bf16_t* Y0 = (bf16_t*)(ws + WS_YB0);
    const float* lnw = a.in(15); const float* lnb = a.in(16);
    LAS unsigned char* lds = C.lds;
    const int tid0 = I.tid, lane0 = I.lane, wave = I.wave;
    const int tid = tid0, lane = lane0, fr = lane & 15, fq = lane >> 4;
#define RS_OPAQUE_IDS() int lane = lane0; asm volatile("" : "+v"(lane)); const int fr = lane & 15, fq = lane >> 4, tid = wave * 64 + lane; (void)tid; (void)fr; (void)fq
    LAS unsigned char* L_TA = lds; LAS unsigned char* L_TL = lds + 8192; LAS unsigned char* L_Z = lds + 12 * 8192;
    LAS float* L_GC = (LAS float*)(lds + 13 * 8192); LAS float* L_LN = (LAS float*)(lds + 13 * 8192 + 16384);
#define L_BT(bf) (lds + (2 + (bf)) * 8192)
#define L_KT(bf) (lds + (4 + (bf)) * 8192)
#define L_RT(bf) (lds + (6 + (bf)) * 8192)
#define L_VT(bf) (lds + (8 + (bf)) * 8192)
#define L_S(bf)  (lds + (10 + (bf)) * 8192)
#define RS_LOAD(st, chn) do { const unsigned char* _g = gt0 + (size_t)(chn) * (6 * 8192) + tid * 16; _Pragma("unroll") for (int _q = 0; _q < 6; ++_q) st.t[_q] = *(const u32x4*)(_g + _q * 8192); } while (0)
#define RS_WRITE4(st, bfn) do { *(LAS u32x4*)(L_BT(bfn) + tid * 16) = st.t[RT_BT]; *(LAS u32x4*)(L_KT(bfn) + tid * 16) = st.t[RT_KT]; *(LAS u32x4*)(L_RT(bfn) + tid * 16) = st.t[RT_RT]; *(LAS u32x4*)(L_VT(bfn) + tid * 16) = st.t[RT_VT]; } while (0)
#define RS_WRITE2(st) do { *(LAS u32x4*)(L_TA + tid * 16) = st.t[RT_TA]; *(LAS u32x4*)(L_TL + tid * 16) = st.t[RT_TL]; } while (0)
#define RS_BAR() do { asm volatile("s_waitcnt lgkmcnt(0)" ::: "memory"); __builtin_amdgcn_s_barrier(); asm volatile("" ::: "memory"); } while (0)
    for (int bh = C.bid; bh < BATCH * 8; bh += C.G) {
        const int h = bh & 7; const size_t row0 = (size_t)(bh >> 3) * SEQ;
        const unsigned char* gt0 = RWT + (size_t)bh * 64 * (6 * 8192);
        const float* gc0 = GC + (size_t)bh * 64 * 64;
        __syncthreads();
        RsStage sA, sB;
        RS_LOAD(sA, 0);
        *(LAS u32x4*)(L_S(0) + tid * 16) = (u32x4){0u, 0u, 0u, 0u};
        RS_WRITE4(sA, 0); RS_WRITE2(sA);
        RS_LOAD(sA, 1); RS_LOAD(sB, 2);
#pragma unroll
        for (int q = 0; q < 2; ++q) *(LAS f32x4*)(L_GC + (q * 512 + tid) * 4) = *(const f32x4*)(gc0 + (size_t)(q * 512 + tid) * 4);
        if (tid < 64) { L_LN[tid] = lnw[h * 64 + tid]; L_LN[64 + tid] = lnb[h * 64 + tid]; }
        if (wave < 4) {
            const int vt = wave;
            f32x4 sm[4];
#pragma unroll
            for (int kt = 0; kt < 4; ++kt) sm[kt] = (f32x4){0.f, 0.f, 0.f, 0.f};
            __syncthreads();
#define RS_SCHUNK(ch, SX) do { const int bf = (ch) & 1; RS_OPAQUE_IDS(); \
                RS_WRITE4(SX, bf ^ 1); \
                  \
                { const bf16x8 s0 = frag_row(L_S(bf), 16 * vt + fr, 0, fq), s1 = frag_row(L_S(bf), 16 * vt + fr, 1, fq); \
                  const bf16x8 v0 = frag_tr(L_VT(bf), vt, 0, lane), v1 = frag_tr(L_VT(bf), vt, 1, lane); \
                  _Pragma("unroll") for (int it = 0; it < 4; ++it) { f32x4 d = (f32x4){0.f, 0.f, 0.f, 0.f}; \
                      d = MFMA16(s0, frag_row(L_TA, 16 * it + fr, 0, fq), d); d = MFMA16(s1, frag_row(L_TA, 16 * it + fr, 1, fq), d); \
                      d = MFMA16(v0, frag_row_slots(L_TL, 16 * it + fr, 0, fq), d); d = MFMA16(v1, frag_row_slots(L_TL, 16 * it + fr, 1, fq), d); \
                      u32x2 w; w.x = pk2(d[0], d[1]); w.y = pk2(d[2], d[3]); \
                      *(LAS u32x2*)(L_Z + toff(16 * it + fr, 2 * vt + (fq >> 1)) + (fq & 1) * 8) = w; } } \
                RS_BAR();                                          \
                RS_WRITE2(SX); RS_LOAD(SX, (ch) + 3); \
                  \
                { const bf16x8 z0 = frag_tr(L_Z, vt, 0, lane), z1 = frag_tr(L_Z, vt, 1, lane), v0 = frag_tr(L_VT(bf), vt, 0, lane), v1 = frag_tr(L_VT(bf), vt, 1, lane); \
                  _Pragma("unroll") for (int kt = 0; kt < 4; ++kt) { f32x4 d = sm[kt]; \
                      d = MFMA16(frag_tr(L_BT(bf), kt, 0, lane), z0, d); d = MFMA16(frag_tr(L_BT(bf), kt, 1, lane), z1, d); \
                      d = MFMA16(frag_tr(L_KT(bf), kt, 0, lane), v0, d); d = MFMA16(frag_tr(L_KT(bf), kt, 1, lane), v1, d); \
                      d = d * *(const LAS f32x4*)(L_GC + (ch) * 64 + 16 * kt + 4 * fq); sm[kt] = d; \
                      u32x2 w; w.x = pk2(d[0], d[1]); w.y = pk2(d[2], d[3]); \
                      *(LAS u32x2*)(L_S(bf ^ 1) + toff(16 * vt + fr, 2 * kt + (fq >> 1)) + (fq & 1) * 8) = w; } } \
                RS_BAR();                                          \
            } while (0)
#pragma unroll 1
            for (int c2 = 0; c2 < 64; c2 += 2) { RS_SCHUNK(c2, sA); RS_SCHUNK(c2 + 1, sB); }
#undef RS_SCHUNK
        } else {
            const int it = wave - 4;
            u32x2 g8A[4], g8B[4]; float bonA, bonB;
#define RS_SMALL(chn, G8, BON) do { const size_t _m = row0 + (size_t)(chn) * 64 + 16 * it + fr; _Pragma("unroll") for (int _v = 0; _v < 4; ++_v) G8[_v] = *(const u32x2*)(Y0 + _m * 512 + h * 64 + 16 * _v + 4 * fq); BON = BONUS[_m * 8 + h]; } while (0)
            RS_SMALL(0, g8A, bonA);
            __syncthreads();
#define RS_YCHUNK(ch, SX, G8C, BONC, G8N, BONN) do { const int bf = (ch) & 1; RS_OPAQUE_IDS(); \
                RS_WRITE4(SX, bf ^ 1); RS_SMALL((ch) + 1, G8N, BONN); \
                  \
                const bf16x8 r0 = frag_row(L_RT(bf), 16 * it + fr, 0, fq), r1 = frag_row(L_RT(bf), 16 * it + fr, 1, fq); \
                u32x4 mbw[2], mkw[2]; \
                _Pragma("unroll") for (int jt = 0; jt < 4; ++jt) { f32x4 db = (f32x4){0.f, 0.f, 0.f, 0.f}, dk = db; \
                    if (jt <= it) { db = MFMA16(frag_row(L_BT(bf), 16 * jt + fr, 0, fq), r0, db); db = MFMA16(frag_row(L_BT(bf), 16 * jt + fr, 1, fq), r1, db); \
                                    dk = MFMA16(frag_row(L_KT(bf), 16 * jt + fr, 0, fq), r0, dk); dk = MFMA16(frag_row(L_KT(bf), 16 * jt + fr, 1, fq), r1, dk); } \
                    const int i = 16 * it + fr, j0 = 16 * jt + 4 * fq; \
                    _Pragma("unroll") for (int r = 0; r < 4; ++r) { const bool keep = (j0 + r <= i); db[r] = keep ? db[r] : 0.f; dk[r] = keep ? dk[r] : 0.f; } \
                    if (jt & 1) { mbw[jt >> 1].z = pk2(db[0], db[1]); mbw[jt >> 1].w = pk2(db[2], db[3]); mkw[jt >> 1].z = pk2(dk[0], dk[1]); mkw[jt >> 1].w = pk2(dk[2], dk[3]); } \
                    else        { mbw[jt >> 1].x = pk2(db[0], db[1]); mbw[jt >> 1].y = pk2(db[2], db[3]); mkw[jt >> 1].x = pk2(dk[0], dk[1]); mkw[jt >> 1].y = pk2(dk[2], dk[3]); } } \
                const bf16x8 mb0 = __builtin_bit_cast(bf16x8, mbw[0]), mb1 = __builtin_bit_cast(bf16x8, mbw[1]), mk0 = __builtin_bit_cast(bf16x8, mkw[0]), mk1 = __builtin_bit_cast(bf16x8, mkw[1]); \
                RS_BAR();                                          \
                RS_WRITE2(SX); RS_LOAD(SX, (ch) + 3); \
                  \
                { const size_t m = row0 + (size_t)(ch) * 64 + 16 * it + fr; bf16_t* yrow = Y0 + m * 512 + h * 64; \
                  f32x4 y[4]; float s1 = 0.f, s2 = 0.f; \
                  _Pragma("unroll") for (int vt = 0; vt < 4; ++vt) { f32x4 d = (f32x4){0.f, 0.f, 0.f, 0.f}; \
                      d = MFMA16(frag_row(L_S(bf), 16 * vt + fr, 0, fq), r0, d); d = MFMA16(frag_row(L_S(bf), 16 * vt + fr, 1, fq), r1, d); \
                      d = MFMA16(frag_tr(L_Z, vt, 0, lane), mb0, d); d = MFMA16(frag_tr(L_Z, vt, 1, lane), mb1, d); \
                      d = MFMA16(frag_tr(L_VT(bf), vt, 0, lane), mk0, d); d = MFMA16(frag_tr(L_VT(bf), vt, 1, lane), mk1, d); \
                      y[vt] = d; s1 += (d[0] + d[1]) + (d[2] + d[3]); s2 += (d[0] * d[0] + d[1] * d[1]) + (d[2] * d[2] + d[3] * d[3]); } \
                  s1 += __shfl_xor(s1, 16); s1 += __shfl_xor(s1, 32); s2 += __shfl_xor(s2, 16); s2 += __shfl_xor(s2, 32); \
                  const float mean = s1 * (1.0f / 64.0f); const float var = fmaxf(s2 * (1.0f / 64.0f) - mean * mean, 0.f); const float rstd = 1.0f / sqrtf(var + 64e-5f); \
                  _Pragma("unroll") for (int vt = 0; vt < 4; ++vt) { const u32x2 vv = *(const LAS u32x2*)(L_VT(bf) + toff(16 * it + fr, 2 * vt + (fq >> 1)) + (fq & 1) * 8); \
                      const float vf[4] = {bf_lo(vv.x), bf_hi(vv.x), bf_lo(vv.y), bf_hi(vv.y)}; const float gf[4] = {bf_lo(G8C[vt].x), bf_hi(G8C[vt].x), bf_lo(G8C[vt].y), bf_hi(G8C[vt].y)}; \
                      const f32x4 lw4 = *(const LAS f32x4*)(L_LN + 16 * vt + 4 * fq), lb4 = *(const LAS f32x4*)(L_LN + 64 + 16 * vt + 4 * fq); \
                      float o[4]; \
                      _Pragma("unroll") for (int r = 0; r < 4; ++r) o[r] = ((y[vt][r] - mean) * rstd * lw4[r] + lb4[r] + BONC * vf[r]) * gf[r]; \
                      u32x2 w; w.x = pk2(o[0], o[1]); w.y = pk2(o[2], o[3]); *(u32x2*)(yrow + 16 * vt + 4 * fq) = w; } } \
                RS_BAR();                                          \
            } while (0)
#pragma unroll 1
            for (int c2 = 0; c2 < 64; c2 += 2) { RS_YCHUNK(c2, sA, g8A, bonA, g8B, bonB); RS_YCHUNK(c2 + 1, sB, g8B, bonB, g8A, bonA); }
#undef RS_YCHUNK
#undef RS_SMALL
        }
    }
#undef RS_BAR
#undef RS_OPAQUE_IDS
#undef RS_LOAD
#undef RS_WRITE4
#undef RS_WRITE2
#undef L_BT
#undef L_KT
#undef L_RT
#undef L_VT
#undef L_S
    __syncthreads();
}

constexpr int N_PHASES = 14;
__global__ void __launch_bounds__(512, 2) mega(Args a_unused) {
    const KA a;
    extern __shared__ __attribute__((aligned(16))) unsigned char lds_raw[];
    cg::grid_group grid = cg::this_grid();
    Ctx C; C.lds = (LAS unsigned char*)lds_raw; C.G = gridDim.x; C.bid = blockIdx.x;
    const int lo = a.ph_lo(), hi = a.ph_hi();
#define ws (a.ws())
    volatile LAS unsigned* xst = (volatile LAS unsigned*)(C.lds + LDS_BYTES - 16);
    if (threadIdx.x < 4) xst[threadIdx.x] = 0u;
    __syncthreads();
    const XcdBarrier xbar = xcd_barrier_post((unsigned*)(ws + WS_CTL) + CW_BAR, xst);
#define IN(k) (lo <= (k) && (k) < hi)
#ifdef PROBE_A
#define STAMP(k) do { if (blockIdx.x == 0 && threadIdx.x == 0) ((unsigned long long*)(ws + WS_CTL + 4096))[k] = __builtin_amdgcn_s_memrealtime(); } while (0)
#else
#define STAMP(k) do { } while (0)
#endif
#define SEAM(k) do { if (IN(k) && IN((k) + 1)) { if (lo < 0) grid.sync(); else xcd_barrier(xbar); } STAMP((k) + 1); } while (0)
    STAMP(0);
    if (IN(0)) phase0(a, C);
    SEAM(0);
    if (IN(1)) {
#if G1_FP8
        { int KE = 512; asm volatile("" : "+s"(KE));
          DenseSched S{(const char*)(ws + WS_XN8), (const char*)(ws + WS_WBIG), NTOK / 256, 3072 / 256, KE, C.G, C.bid};
          EpiIn E{(bf16_t*)(ws + WS_P), (bf16_t*)(ws + WS_GATE), a.in(5), 1.0f, 1.0f / W8_SCALE};
          pg8::gemm_phase<EpiIn, DenseSched, false, true>(C.lds, KE, S, E); }
#else
        { DenseSched S{(const char*)(ws + WS_XN), (const char*)(ws + WS_WBIG), NTOK / 256, 3072 / 256, 1024, C.G, C.bid};
          EpiIn E{(bf16_t*)(ws + WS_P), (bf16_t*)(ws + WS_GATE), a.in(5)};
          pg8::gemm_phase<EpiIn, DenseSched, false>(C.lds, 1024, S, E); }
#endif
        if (C.G <= 96) {
          DenseSched S{(const char*)(ws + WS_MEMN), (const char*)(ws + WS_WMKV), NMEM / 256, 1024 / 256, 1024, C.G, C.bid};
          EpiPlain E{(bf16_t*)(ws + WS_KVM), 1024};
          pg8::gemm_phase<EpiPlain, DenseSched, false>(C.lds, 1024, S, E); }
    }
    SEAM(1);
    if (IN(2)) phase_lerp(a, C);
    SEAM(2);
    if (IN(3)) {
        int Kl = 256; asm volatile("" : "+s"(Kl)); DenseSched S{(const char*)(ws + WS_LIN), (const char*)(ws + WS_WRW), NTOK / 256, 1536 / 256, Kl, C.G, C.bid};
        EpiLora E{ws, a.in(7), a.in(9)};
        pg8::gemm_phase<EpiLora, DenseSched, false>(C.lds, Kl, S, E);
    }
    SEAM(3);
    if (IN(4)) phase_rwkv_pre(a, C);
    SEAM(4);
    if (IN(5)) {
        if (C.G > 96) { if (C.bid < 64) { Ctx C2 = C; C2.G = 64; phase_rwkv_seq(a, C2); phase0_moe(a, C2); } else { Ctx C2 = C; C2.bid = C.bid - 64; C2.G = C.G - 64;
              unsigned* kvc = (unsigned*)(ws + WS_CTL) + CW_KV;
              if (C2.bid < 32) {
                  DenseSched S{(const char*)(ws + WS_MEMN), (const char*)(ws + WS_WMKV), NMEM / 256, 1024 / 256, 1024, 32, C2.bid};
                  EpiPlain E{(bf16_t*)(ws + WS_KVM), 1024};
                  pg8::gemm_phase<EpiPlain, DenseSched, false>(C.lds, 1024, S, E);
                  asm volatile("s_waitcnt vmcnt(0)" ::: "memory"); __syncthreads();
                  if (threadIdx.x == 0) { __builtin_amdgcn_fence(__ATOMIC_RELEASE, "agent"); asm volatile("s_waitcnt vmcnt(0)" ::: "memory"); (void)__hip_atomic_fetch_add(kvc, 1u, __ATOMIC_RELAXED, __HIP_MEMORY_SCOPE_AGENT); }
              }
              phase_swa(a, C2);
              if (threadIdx.x == 0) { unsigned sp = 0; while (__hip_atomic_load(kvc, __ATOMIC_RELAXED, __HIP_MEMORY_SCOPE_AGENT) < 32u && ++sp < (1u << 24)) __builtin_amdgcn_s_sleep(2);
                  __builtin_amdgcn_fence(__ATOMIC_ACQUIRE, "agent"); asm volatile("s_waitcnt vmcnt(0)" ::: "memory"); }
              __syncthreads();
              phase_mem(a, C2);
              if (C.G == 256 && C2.bid >= 64) {
                  int KE = 512; asm volatile("" : "+s"(KE));
                  GateSchedX S{(const char*)(ws + WS_XN8), (const char*)(ws + WS_WG8), NTOK / 256, 4, KE, C2.bid - 64, 0};
                  EpiGateNT E{(bf16_t*)(ws + WS_P), (bf16_t*)(ws + WS_GATE), a.in(5), 1.0f / W8_SCALE};
                  pg8::gemm_phase<EpiGateNT, GateSchedX, false, true>(C.lds, KE, S, E); }
              phase0_moe(a, C2); } }
        else { phase_rwkv_seq(a, C); phase_swa(a, C); phase_mem(a, C); phase0_moe(a, C); }
    }
    SEAM(5);
    if (IN(6)) {
        int KE = 512; asm volatile("" : "+s"(KE));
        EpiGateNT E{(bf16_t*)(ws + WS_P), (bf16_t*)(ws + WS_GATE), a.in(5), 1.0f / W8_SCALE};
        if (C.G == 256) { GateSchedX S{(const char*)(ws + WS_XN8), (const char*)(ws + WS_WG8), NTOK / 256, 4, KE, C.bid, 1};
                          pg8::gemm_phase<EpiGateNT, GateSchedX, false, true>(C.lds, KE, S, E); }
        else { GateSched S{(const char*)(ws + WS_XN8), (const char*)(ws + WS_WG8), NTOK / 256, 4, KE, C.G, C.bid};
               pg8::gemm_phase<EpiGateNT, GateSched, false, true>(C.lds, KE, S, E); }
    }
    if (C.G == 256) SEAM(6); else STAMP(7);
    if (IN(7)) {
        BranchSched S{(const char*)ws, (const char*)(ws + WS_WBR), NTOK / 256, 4, C.G, C.bid};
        EpiBranch E{(bf16_t*)(ws + WS_MERGED), (const bf16_t*)(ws + WS_GATE)};
        pg8::gemm_phase<EpiBranch, BranchSched, false>(C.lds, 512, S, E);
    }
    SEAM(7);
    if (IN(8)) {
        DenseSched S{(const char*)(ws + WS_MERGED), (const char*)(ws + WS_WOUT), NTOK / 256, 4, 1024, C.G, C.bid};
        EpiOut E{a.in(0), a.out()};
        pg8::gemm_phase<EpiOut, DenseSched, false>(C.lds, 1024, S, E);
    }
    SEAM(8);
    if (IN(9)) phase_router(a, C);
    SEAM(9);
    if (IN(10)) phase_slots(a, C);
    SEAM(10);
    if (IN(11)) {
        const int ntiles = __builtin_amdgcn_readfirstlane((int)__hip_atomic_load((unsigned*)(ws + WS_CTL) + CW_NTILES, __ATOMIC_RELAXED, __HIP_MEMORY_SCOPE_AGENT));
        int KE = MOE_FP8 ? 512 : 1024; asm volatile("" : "+s"(KE));
        MoeSched S{(const char*)(ws + WS_HB), (const char*)(ws + WS_W1T), (const int*)(ws + MS_TILEE), (const int*)(ws + MS_SLOTTOK), ntiles, 8, KE, C.G, C.bid, (size_t)2048 * KE * 2};
        EpiUp E{(bf16_t*)(ws + WS_ACT), a.in(26), (const float*)(ws + MS_SLOTRS)};
        pg8::gemm_phase<EpiUp, MoeSched, true, MOE_FP8 != 0>(C.lds, KE, S, E);
    }
    SEAM(11);
    if (IN(12)) {
        const int ntiles = __builtin_amdgcn_readfirstlane((int)__hip_atomic_load((unsigned*)(ws + WS_CTL) + CW_NTILES, __ATOMIC_RELAXED, __HIP_MEMORY_SCOPE_AGENT));
        int KE = MOE_FP8 ? 512 : 1024; asm volatile("" : "+s"(KE));
        MoeSched2 S{(const char*)(ws + WS_ACT), (const char*)(ws + WS_W2T), (const int*)(ws + MS_TILEE), ntiles, 4, KE, C.G, C.bid, (size_t)1024 * KE * 2};
        EpiDown E{(bf16_t*)(ws + WS_YSLOT), a.in(28), (const float*)(ws + MS_SLOTG)};
        pg8::gemm_phase<EpiDown, MoeSched2, false, MOE_FP8 != 0>(C.lds, KE, S, E);
    }
    SEAM(12);
    if (IN(13)) phase_final(a, C);
#ifdef PROBE_A
    STAMP(14);
    __syncthreads();
    if (blockIdx.x == 0 && threadIdx.x == 0) {
        asm volatile("s_waitcnt vmcnt(0)" ::: "memory");
        const unsigned long long* ts = (const unsigned long long*)(ws + WS_CTL + 4096);
        const float da = (float)(ts[PROBE_A + 1] - ts[PROBE_A]) * 0.001f;
        a.out()[0] += da;
        const unsigned long long db = (ts[PROBE_B + 1] - ts[PROBE_B]) * 4ull;
        const unsigned long long t0 = __builtin_amdgcn_s_memrealtime();
        while (__builtin_amdgcn_s_memrealtime() - t0 < db) __builtin_amdgcn_s_sleep(8);
    }
#endif
#undef IN
#undef SEAM
#undef ws
}

#ifndef MK_MULTI
#define MK_MULTI 0
#endif
extern "C" void kernel_launch(void* const* d_in, const int* in_sizes, int n_in, void* d_out, int out_size, void* d_ws, size_t ws_size, hipStream_t stream) {
    static int grid = 0;
    if (grid == 0) {
        int dev = 0, cus = 0, per_cu = 0;
        if (n_in != 30 || ws_size < WS_END) { fprintf(stderr, "kernel_launch: unexpected n_in %d / ws %zu\n", n_in, ws_size); grid = -1; return; }
        (void)hipGetDevice(&dev); (void)hipDeviceGetAttribute(&cus, hipDeviceAttributeMultiprocessorCount, dev);
        (void)hipFuncSetAttribute((const void*)mega, hipFuncAttributeMaxDynamicSharedMemorySize, LDS_BYTES);
        (void)hipOccupancyMaxActiveBlocksPerMultiprocessor(&per_cu, (const void*)mega, 512, LDS_BYTES);
        (void)hipGetLastError();
        if (per_cu < 1) per_cu = 1;
        grid = cus;
        fprintf(stderr, "kernel_launch: cus %d per_cu %d grid %d ws %zu\n", cus, per_cu, grid, ws_size);
    }
    if (grid < 0) return;
    (void)hipMemsetAsync((char*)d_ws + WS_CTL, 0, CTL_BYTES, stream);
    Args a{};
    for (int i = 0; i < 30; ++i) a.in[i] = (const float*)d_in[i];
    a.out = (float*)d_out; a.ws = (unsigned char*)d_ws;
#if MK_MULTI
    for (int p = 0; p < N_PHASES; ++p) { a.ph_lo = p; a.ph_hi = p + 1; hipLaunchKernelGGL(mega, dim3(grid), dim3(512), LDS_BYTES, stream, a); }
#else
    a.ph_lo = 0; a.ph_hi = N_PHASES;
    void* args[] = {&a};
    hipError_t e = hipLaunchCooperativeKernel((const void*)mega, dim3(grid), dim3(512), args, LDS_BYTES, stream);
    if (e != hipSuccess) fprintf(stderr, "cooperative launch failed: %s (grid %d)\n", hipGetErrorString(e), grid);
#endif
}
```

```cpp
#include <hip/hip_runtime.h>
#include <hip/hip_cooperative_groups.h>
#include <cstdio>
#include <cstdint>
namespace cg = cooperative_groups;

#define LAS __attribute__((address_space(3)))
#define GAS __attribute__((address_space(1)))
typedef unsigned short bf16_t;
typedef short bf16x8 __attribute__((ext_vector_type(8)));
typedef short s16x4 __attribute__((ext_vector_type(4)));
typedef float f32x4 __attribute__((ext_vector_type(4)));
typedef float f32x2 __attribute__((ext_vector_type(2)));
typedef unsigned u32x4 __attribute__((ext_vector_type(4)));
typedef unsigned u32x2 __attribute__((ext_vector_type(2)));

constexpr int BATCH = 8, SEQ = 4096, NTOK = BATCH * SEQ, DM = 1024;
constexpr int RW_PROJ = 1792, SWA_OFF = 1792, MEMQ_OFF = 2560, IN_PROJ = 3072;
constexpr int MEM_LEN = 256, NMEM = BATCH * MEM_LEN;
constexpr int NEXP = 32, TOPK = 4, DFF = 1024;
constexpr int MAXSLOT = NTOK * TOPK + NEXP * 256;
constexpr int NWAVES = 8;

constexpr size_t MiB = 1u << 20;
constexpr size_t WS_CTL = 0, CTL_BYTES = 64 * 1024;
constexpr size_t WS_WBIG = 1 * MiB;
constexpr size_t WS_WMKV = 13 * MiB;
constexpr size_t WS_WBR = 15 * MiB;
constexpr size_t WS_WOUT = 18 * MiB;
constexpr size_t WS_WRW = 20 * MiB;
constexpr size_t WS_MISC = 21 * MiB;
constexpr size_t WS_W2T = 32 * MiB;
constexpr size_t WS_W1T = 96 * MiB;
constexpr size_t WS_YSLOT = 96 * MiB;
constexpr size_t WS_PREP = 224 * MiB;
constexpr size_t WS_R = WS_PREP, WS_KR = WS_PREP + 32 * MiB, WS_V = WS_PREP + 64 * MiB, WS_ASIG = WS_PREP + 96 * MiB, WS_W = WS_PREP + 128 * MiB, WS_LIN = WS_PREP + 192 * MiB;
constexpr size_t WS_MERGED = 552 * MiB;
constexpr size_t WS_HB = 288 * MiB;
constexpr size_t WS_XN = 448 * MiB;
constexpr size_t WS_YB0 = 64 * MiB, WS_YB1 = 160 * MiB, WS_YB2 = 192 * MiB;
constexpr size_t WS_XN8 = 512 * MiB;
constexpr size_t WS_WG8 = 7 * MiB;
constexpr size_t WS_MEMN = 544 * MiB;
constexpr size_t WS_KVM = 548 * MiB;
constexpr size_t WS_P = 552 * MiB;
constexpr size_t WS_GATE = 256 * MiB;
constexpr size_t WS_RWT0 = 744 * MiB;
constexpr size_t WS_YRAW = 552 * MiB;
constexpr size_t WS_ACT = 552 * MiB;
constexpr size_t WS_END = 1016 * MiB;
#ifndef RW_CHUNKED
#define RW_CHUNKED 1
#endif
constexpr size_t MS_RSTD2 = WS_MISC;
constexpr size_t MS_TOKE = WS_MISC + 1 * MiB / 2;
constexpr size_t MS_TOKPOS = WS_MISC + 1 * MiB;
constexpr size_t MS_TOKSLOT = WS_MISC + 3 * MiB / 2;
constexpr size_t MS_TOKG = WS_MISC + 2 * MiB;
constexpr size_t MS_SLOTTOK = WS_MISC + 5 * MiB / 2;
constexpr size_t MS_SLOTG = WS_MISC + 7 * MiB / 2;
constexpr size_t MS_SLOTRS = WS_MISC + 9 * MiB / 2;
constexpr size_t MS_TILEE = WS_MISC + 11 * MiB / 2;
constexpr size_t MS_BONUS = WS_MISC + 6 * MiB;
constexpr size_t MS_WRT = WS_MISC + 7 * MiB;
constexpr int CW_CNT = 4096;
constexpr int CW_NTILES = 128;
constexpr int CW_MOEW = 320;
constexpr int CW_KV = 192;
constexpr int CW_BAR = 8192;

constexpr int LDS_BYTES = 155648;

__device__ __forceinline__ unsigned f2bf(float f) { unsigned u = __builtin_bit_cast(unsigned, f); return (u + 0x7fffu + ((u >> 16) & 1u)) >> 16; }
__device__ __forceinline__ unsigned cvt_pk_bf16(float lo, float hi) { unsigned r; asm volatile("v_cvt_pk_bf16_f32 %0, %1, %2" : "=v"(r) : "v"(lo), "v"(hi)); return r; }
typedef float f32x2_t_ __attribute__((ext_vector_type(2)));
typedef __bf16 bf16x2_t_ __attribute__((ext_vector_type(2)));
__device__ __forceinline__ unsigned pk2(float lo, float hi) { const f32x2_t_ v = {lo, hi}; const bf16x2_t_ b = __builtin_convertvector(v, bf16x2_t_); return __builtin_bit_cast(unsigned, b); }
__device__ __forceinline__ float bf_lo(unsigned u) { return __builtin_bit_cast(float, u << 16); }
__device__ __forceinline__ float bf_hi(unsigned u) { return __builtin_bit_cast(float, u & 0xffff0000u); }
__device__ __forceinline__ float bf1(bf16_t u) { return __builtin_bit_cast(float, (unsigned)u << 16); }
__device__ __forceinline__ float fexp(float x) { return __builtin_amdgcn_exp2f(x * 1.44269504f); }
__device__ __forceinline__ float fsigmoid(float x) { return __builtin_amdgcn_rcpf(1.0f + fexp(-x)); }
__device__ __forceinline__ float wave_sum(float v) {
#pragma unroll
    for (int o = 1; o < 64; o <<= 1) v += __shfl_xor(v, o);
    return v;
}
__device__ __forceinline__ unsigned cvt_fp8x4(float a, float b, float c, float d) { int w = 0; w = __builtin_amdgcn_cvt_pk_fp8_f32(a, b, w, false); w = __builtin_amdgcn_cvt_pk_fp8_f32(c, d, w, true); return (unsigned)w; }
typedef int i32x8 __attribute__((ext_vector_type(8)));
#ifndef MOE_FP8
#define MOE_FP8 1
#endif
#ifndef YS_FP8
#define YS_FP8 1
#endif
#ifndef G1_FP8
#define G1_FP8 0
#endif
constexpr float W8_SCALE = 32.0f;
#define LDS_WAIT() asm volatile("s_waitcnt lgkmcnt(0)" ::: "memory")
#define VM_WAIT() asm volatile("s_waitcnt vmcnt(0)" ::: "memory")

namespace pg8 {
constexpr int BM = 256, BK = 64, HALF = 128, HTB = HALF * BK * 2, STAGE_BYTES = 8 * HTB, NXCD = 8, WGM = 8;
__host__ __device__ __forceinline__ int lds_byte(int r, int c) { const int st = (r >> 4) * 2 + (c >> 5), rr = r & 15, cc = c & 31, ob = rr * 64 + cc * 2; return st * 1024 + (ob ^ (((ob >> 9) & 1) << 5)); }
__host__ __device__ __forceinline__ void stage_rc(int b, int& R, int& C) { const int st = b / 1024, sb = b % 1024, swz = sb ^ (((sb >> 9) & 1) << 5); R = (st >> 1) * 16 + swz / 64; C = (st & 1) * 32 + (swz % 64) / 2; }
__host__ __device__ __forceinline__ int perm32(int rho) { const int n = rho >> 4, i = rho & 15; return 8 * (i >> 2) + 4 * n + (i & 3); }

struct Unit { int pm, pn, aux; const char* a; const char* b; };

__device__ __forceinline__ void tile_of(int L, int nM, int nN, int& pm, int& pn) {
    const int nwg = nM * nN; int wgid = L;
    { const int q = nwg / NXCD, r = nwg % NXCD, xcd = wgid % NXCD, off = wgid / NXCD; wgid = (xcd < r ? xcd * (q + 1) : r * (q + 1) + (xcd - r) * q) + off; }
    const int nig = WGM * nN, gid = wgid / nig, fm = gid * WGM, gsz = (nM - fm) < WGM ? (nM - fm) : WGM;
    pm = fm + ((wgid % nig) % gsz); pn = (wgid % nig) / gsz;
}

template <class Epi, class Sched, bool GATHER, bool FP8 = false>
__device__ __forceinline__ void gemm_phase(LAS unsigned char* lds, const int K, const Sched& S, const Epi& E) {
    const int tid = threadIdx.x, wid = __builtin_amdgcn_readfirstlane(tid >> 6), lane = tid & 63, wr = wid >> 2, wc = wid & 3, fr = lane & 15, fq = lane >> 4;
    const int nt = K / BK;
    unsigned voffA[2], voffB[2];
#pragma unroll
    for (int i = 0; i < 2; ++i) { int R, C; stage_rc(tid * 16 + i * 8192, R, C); const int Rb = (R & ~31) + perm32(R & 31); voffA[i] = (unsigned)(R * K + C) * 2u; voffB[i] = (unsigned)(Rb * K + C) * 2u; }
    const size_t kstep = (size_t)(BK * 2);
    const size_t hstep = (size_t)HALF * K * 2;
    const unsigned ldsw = (unsigned)wid * 1024u;
    const int aoff = FP8 ? lds_byte(wr * 64 + fr, fq * 16) : lds_byte(wr * 64 + fr, fq * 8), boff = FP8 ? lds_byte(wc * 32 + fr, fq * 16) : lds_byte(wc * 32 + fr, fq * 8);
    LAS unsigned char* tokbuf = lds + STAGE_BYTES + wid * 1024;
#define PG8_SA(b, h) (((b) * 2 + (h)) * HTB)
#define PG8_SB(b, h) ((4 + (b) * 2 + (h)) * HTB)
#define PG8_STAGE(bufoff, gbase, voff) do { _Pragma("unroll") for (int _i = 0; _i < 2; ++_i) \
        __builtin_amdgcn_global_load_lds((const unsigned*)((const char*)(gbase) + (voff)[_i]), (LAS unsigned*)(lds + (bufoff) + ldsw + _i * 8192), 16, 0, 0); } while (0)
#define PG8_STAGE_A(bufoff, gbase, h) do { if constexpr (GATHER) { PG8_STAGE(bufoff, gbase, vG[h]); } else { PG8_STAGE(bufoff, (gbase) + (h) * hstep, voffA); } } while (0)
#define PG8_TOK_DMA(u) do { const int* _tp = S.arow_ptr(u); _Pragma("unroll") for (int _h = 0; _h < 2; ++_h) _Pragma("unroll") for (int _i = 0; _i < 2; ++_i) { int _R, _C; stage_rc(tid * 16 + _i * 8192, _R, _C); \
        __builtin_amdgcn_global_load_lds((const unsigned*)(_tp + _h * HALF + _R), (LAS unsigned*)(tokbuf + (_h * 2 + _i) * 256), 4, 0, 0); } } while (0)
#define PG8_TOK_READ() do { _Pragma("unroll") for (int _h = 0; _h < 2; ++_h) _Pragma("unroll") for (int _i = 0; _i < 2; ++_i) { int _R, _C; stage_rc(tid * 16 + _i * 8192, _R, _C); \
        const int _tk = *(const LAS int*)(tokbuf + (_h * 2 + _i) * 256 + lane * 4); vG[_h][_i] = (unsigned)(_tk * K + _C) * 2u; } } while (0)
#define PG8_LD32(p) __builtin_bit_cast(i32x8, __builtin_shufflevector(*(const LAS u32x4*)(p), *(const LAS u32x4*)((p) + (FP8 ? 16 : 1024)), 0, 1, 2, 3, 4, 5, 6, 7))
#define PG8_LDA(dst, b, h) do { _Pragma("unroll") for (int m = 0; m < 4; ++m) dst[m] = PG8_LD32(lds + PG8_SA(b, h) + aoff + m * 2048); } while (0)
#define PG8_LDB(dst, b, h) do { _Pragma("unroll") for (int n = 0; n < 2; ++n) dst[n] = PG8_LD32(lds + PG8_SB(b, h) + boff + n * 2048); } while (0)
#define PG8_LO(x) __builtin_bit_cast(bf16x8, __builtin_shufflevector(x, x, 0, 1, 2, 3))
#define PG8_HI(x) __builtin_bit_cast(bf16x8, __builtin_shufflevector(x, x, 4, 5, 6, 7))
#define PG8_MMA(ai, bj, At, Bt) do { __builtin_amdgcn_s_setprio(1); _Pragma("unroll") for (int m = 0; m < 4; ++m) _Pragma("unroll") for (int n = 0; n < 2; ++n) { \
        if constexpr (FP8) asm volatile("v_mfma_scale_f32_16x16x128_f8f6f4 %0, %1, %2, %0, %3, %3 op_sel_hi:[0,0,0]" : "+v"(acc[ai][bj][m][n]) : "v"(Bt[n]), "v"(At[m]), "v"(sc8));     \
        else { acc[ai][bj][m][n] = __builtin_amdgcn_mfma_f32_16x16x32_bf16(PG8_LO(Bt[n]), PG8_LO(At[m]), acc[ai][bj][m][n], 0, 0, 0); \
               acc[ai][bj][m][n] = __builtin_amdgcn_mfma_f32_16x16x32_bf16(PG8_HI(Bt[n]), PG8_HI(At[m]), acc[ai][bj][m][n], 0, 0, 0); } } __builtin_amdgcn_s_setprio(0); } while (0)
#define PG8_WAIT_V(n) asm volatile("s_waitcnt vmcnt(" #n ")" ::: "memory")
#define PG8_WAIT_L(n) asm volatile("s_waitcnt lgkmcnt(" #n ")" ::: "memory")
#define PG8_BAR __builtin_amdgcn_s_barrier()
#define PG8_SCHED __builtin_amdgcn_sched_barrier(0)
    Unit cur, nxt; int ui = 0;
    if (!S.next(0, cur)) return;
    unsigned vG[2][2] = {{0u, 0u}, {0u, 0u}};
    if constexpr (GATHER) { PG8_TOK_DMA(cur); PG8_WAIT_V(0); PG8_TOK_READ(); PG8_WAIT_L(0); }
    f32x4 acc[2][2][4][2];
#pragma unroll
    for (int a = 0; a < 2; ++a)
#pragma unroll
        for (int b = 0; b < 2; ++b)
#pragma unroll
            for (int m = 0; m < 4; ++m)
#pragma unroll
                for (int n = 0; n < 2; ++n) acc[a][b][m][n] = (f32x4){0.f, 0.f, 0.f, 0.f};
    i32x8 At[4], B0[2], B1[2];
    const int sc8 = 0x7f7f7f7f;
    const char* cA = cur.a; const char* cB = cur.b;
    PG8_STAGE(PG8_SB(0, 0), cB, voffB); PG8_STAGE(PG8_SB(0, 1), cB + hstep, voffB); PG8_STAGE_A(PG8_SA(0, 0), cA, 0); PG8_STAGE_A(PG8_SA(0, 1), cA, 1);
    if (wr == 1) PG8_BAR;
    PG8_WAIT_V(2); PG8_BAR;
    PG8_STAGE(PG8_SB(1, 0), cB + kstep, voffB); PG8_STAGE_A(PG8_SA(1, 0), cA + kstep, 0); PG8_STAGE(PG8_SB(1, 1), cB + hstep + kstep, voffB);
    PG8_WAIT_V(6); PG8_BAR;
    for (;;) {
        const bool has_next = S.next(ui + 1, nxt);
        const char* nA = has_next ? nxt.a : cA; const char* nB = has_next ? nxt.b : cB;
        if constexpr (GATHER) { if (has_next) PG8_TOK_DMA(nxt); }
#pragma unroll 1
        for (int t = 0; t < nt; t += 2) {
            const bool last = (t == nt - 2);
            const char* a1 = cA + (size_t)(t + 1) * kstep;
            const char* a2 = last ? nA : cA + (size_t)(t + 2) * kstep; const char* b2 = last ? nB : cB + (size_t)(t + 2) * kstep;
            const char* a3 = a2 + kstep; const char* b3 = b2 + kstep;
            PG8_LDB(B0, 0, 0); PG8_LDB(B1, 0, 1); PG8_SCHED; PG8_LDA(At, 0, 0); PG8_STAGE_A(PG8_SA(1, 1), a1, 1);
            if constexpr (GATHER) { if (last && has_next) PG8_TOK_READ(); }
            PG8_WAIT_V(8); PG8_WAIT_L(0); PG8_BAR; PG8_MMA(0, 0, At, B0); PG8_MMA(0, 1, At, B1); PG8_BAR; PG8_SCHED;
            PG8_LDA(At, 0, 1); PG8_STAGE(PG8_SB(0, 0), b2, voffB); PG8_STAGE(PG8_SB(0, 1), b2 + hstep, voffB); PG8_STAGE_A(PG8_SA(0, 0), a2, 0);
            PG8_WAIT_V(8); PG8_WAIT_L(0); PG8_BAR; PG8_MMA(1, 0, At, B0); PG8_MMA(1, 1, At, B1); PG8_BAR; PG8_SCHED;
            PG8_LDB(B0, 1, 0); PG8_LDB(B1, 1, 1); PG8_SCHED; PG8_LDA(At, 1, 0); PG8_STAGE_A(PG8_SA(0, 1), a2, 1);
            PG8_WAIT_V(8); PG8_WAIT_L(0); PG8_BAR; PG8_MMA(0, 0, At, B0); PG8_MMA(0, 1, At, B1); PG8_BAR; PG8_SCHED;
            PG8_LDA(At, 1, 1); PG8_STAGE(PG8_SB(1, 0), b3, voffB); PG8_STAGE(PG8_SB(1, 1), b3 + hstep, voffB); PG8_STAGE_A(PG8_SA(1, 0), a3, 0);
            PG8_WAIT_V(8); PG8_WAIT_L(0); PG8_BAR; PG8_MMA(1, 0, At, B0); PG8_MMA(1, 1, At, B1); PG8_BAR; PG8_SCHED;
        }
        if (wr == 0) PG8_BAR;
        if constexpr (FP8) asm volatile("s_nop 15\n\ts_nop 15" ::: "memory");
        { int t2 = threadIdx.x; asm volatile("" : "+v"(t2));
          const int wid2 = __builtin_amdgcn_readfirstlane(t2 >> 6), l2 = t2 & 63; E(acc, cur, wid2 >> 2, wid2 & 3, l2 & 15, l2 >> 4); }
        if (!has_next) break;
        if (!E.keep(cur)) {
#pragma unroll
        for (int a = 0; a < 2; ++a)
#pragma unroll
            for (int b = 0; b < 2; ++b)
#pragma unroll
                for (int m = 0; m < 4; ++m)
#pragma unroll
                    for (int n = 0; n < 2; ++n) acc[a][b][m][n] = (f32x4){0.f, 0.f, 0.f, 0.f};
        }
        cur = nxt; cA = nA; cB = nB; ++ui;
        if (wr == 1) PG8_BAR;
    }
    PG8_WAIT_V(0);
    PG8_BAR;
#undef PG8_SA
#undef PG8_SB
#undef PG8_STAGE
#undef PG8_STAGE_A
#undef PG8_TOK_DMA
#undef PG8_TOK_READ
#undef PG8_LDA
#undef PG8_LDB
#undef PG8_MMA
#undef PG8_LD32
#undef PG8_LO
#undef PG8_HI
#undef PG8_WAIT_V
#undef PG8_WAIT_L
#undef PG8_BAR
#undef PG8_SCHED
}
}
struct DenseSched {
    const char* A; const char* Bt; int nM, nN, K, G, c; int pn0 = 0;
    __device__ __forceinline__ bool next(int i, pg8::Unit& u) const {
        const long L = (long)i * G + c; if (L >= (long)nM * nN) return false;
        pg8::tile_of((int)L, nM, nN, u.pm, u.pn); u.aux = 0;
        u.a = A + (size_t)u.pm * 256 * K * 2; u.b = Bt + (size_t)u.pn * 256 * K * 2; u.pn += pn0; return true;
    }
    __device__ __forceinline__ const int* arow_ptr(const pg8::Unit&) const { return nullptr; }
};
struct GateSched {
    const char* A; const char* Bt; int nM, nN, K, G, c; int r0 = 0;
    __device__ __forceinline__ bool next(int i, pg8::Unit& u) const {
        const int br = i % 3; const long L = (long)(i / 3 + r0) * G + c; if (L >= (long)nM * nN) return false;
        int pn; pg8::tile_of((int)L, nM, nN, u.pm, pn); const int gp = 4 * br + pn; u.aux = 0;
        u.a = A + (size_t)u.pm * 256 * K * 2; u.b = Bt + (size_t)gp * 256 * K * 2; u.pn = 12 + gp; return true;
    }
    __device__ __forceinline__ const int* arow_ptr(const pg8::Unit&) const { return nullptr; }
};
struct GateSchedU {
    const char* A; const char* Bt; int nM, nN, K, U0, n;
    __device__ __forceinline__ bool next(int i, pg8::Unit& u) const {
        if (i >= n) return false; const int U = U0 + i, br = U % 3, L = U / 3;
        int pn; pg8::tile_of(L, nM, nN, u.pm, pn); const int gp = 4 * br + pn; u.aux = 0;
        u.a = A + (size_t)u.pm * 256 * K * 2; u.b = Bt + (size_t)gp * 256 * K * 2; u.pn = 12 + gp; return true;
    }
    __device__ __forceinline__ const int* arow_ptr(const pg8::Unit&) const { return nullptr; }
};
struct GateSchedX {
    const char* A; const char* Bt; int nM, nN, K, c, mode;
    __device__ __forceinline__ bool next(int i, pg8::Unit& u) const {
        if (i >= 4) return false;
        const int L = mode ? (i == 0 ? c : 256 + c) : c + 128 * (i >> 1), br = mode ? (i == 0 ? 2 : i - 1) : (i & 1);
        int pn; pg8::tile_of(L, nM, nN, u.pm, pn); const int gp = 4 * br + pn; u.aux = 0;
        u.a = A + (size_t)u.pm * 256 * K * 2; u.b = Bt + (size_t)gp * 256 * K * 2; u.pn = 12 + gp; return true;
    }
    __device__ __forceinline__ const int* arow_ptr(const pg8::Unit&) const { return nullptr; }
};
struct BranchSched {
    const char* ws; const char* WBR; int nM, nN, G, c;
    __device__ __forceinline__ bool next(int i, pg8::Unit& u) const {
        const int br = i % 3; const long L = (long)(i / 3) * G + c; if (L >= (long)nM * nN) return false;
        pg8::tile_of((int)L, nM, nN, u.pm, u.pn); u.aux = br;
        u.a = ws + (br == 0 ? WS_YB0 : (br == 1 ? WS_YB1 : WS_YB2)) + (size_t)u.pm * 256 * 512 * 2; u.b = WBR + (size_t)br * 1024 * 512 * 2 + (size_t)u.pn * 256 * 512 * 2; return true;
    }
    __device__ __forceinline__ const int* arow_ptr(const pg8::Unit&) const { return nullptr; }
};
struct MoeSched {
    const char* A; const char* Wt; const int* tile_e; const int* slot_tok; int nM, nN, K, G, c; size_t estride; LAS const int* te_lds;
    __device__ __forceinline__ bool next(int i, pg8::Unit& u) const {
        const long L = (long)i * G + c; if (L >= (long)nM * nN) return false;
        pg8::tile_of((int)L, nM, nN, u.pm, u.pn); u.aux = __builtin_amdgcn_readfirstlane(te_lds[u.pm]);
        u.a = A; u.b = Wt + (size_t)u.aux * estride + (size_t)u.pn * 256 * K * 2; return true;
    }
    __device__ __forceinline__ const int* arow_ptr(const pg8::Unit& u) const { return slot_tok + u.pm * 256; }
};
struct MoeSched2 {
    const char* A; const char* Wt; const int* tile_e; int nM, nN, K, G, c; size_t estride; LAS const int* te_lds;
    __device__ __forceinline__ bool next(int i, pg8::Unit& u) const {
        const long L = (long)i * G + c; if (L >= (long)nM * nN) return false;
        pg8::tile_of((int)L, nM, nN, u.pm, u.pn); u.aux = __builtin_amdgcn_readfirstlane(te_lds[u.pm]);
        u.a = A + (size_t)u.pm * 256 * K * 2; u.b = Wt + (size_t)u.aux * estride + (size_t)u.pn * 256 * K * 2; return true;
    }
    __device__ __forceinline__ const int* arow_ptr(const pg8::Unit&) const { return nullptr; }
};

#define EPI_LOOP_ROWS for (int ai = 0; ai < 2; ++ai) _Pragma("unroll") for (int m = 0; m < 4; ++m)
typedef f32x4 acc_t[2][2][4][2];
#define EPI_NOKEEP __device__ __forceinline__ bool keep(const pg8::Unit&) const { return false; }

template <bool NT> struct EpiInT {
    EPI_NOKEEP
    bf16_t* P; bf16_t* GATE; const float* b_swa; float gscale = 1.0f; float pscale = 1.0f;
    __device__ __forceinline__ void operator()(acc_t& acc, const pg8::Unit& u, int wr, int wc, int fr, int fq) const {
        const int row0 = u.pm * 256 + wr * 64 + fr; const int colt = u.pn * 256 + wc * 32 + 8 * fq;
        const bool gate = u.pn >= 12; const bool hasb = (u.pn >= 7 && u.pn < 10);
        bf16_t* base = P + colt; unsigned char* gbase = (unsigned char*)GATE + (colt - 3072);
        f32x4 bv[2][2];
#pragma unroll
        for (int bj = 0; bj < 2; ++bj)
#pragma unroll
            for (int n = 0; n < 2; ++n) bv[bj][n] = hasb ? *(const f32x4*)(b_swa + (colt - SWA_OFF) + bj * 128 + 4 * n) : (f32x4){0.f, 0.f, 0.f, 0.f};
#pragma unroll
        EPI_LOOP_ROWS { bf16_t* rowp = base + (size_t)(row0 + ai * 128 + m * 16) * 3072;
#pragma unroll
            for (int bj = 0; bj < 2; ++bj) { f32x4 v0 = acc[ai][bj][m][0] * pscale + bv[bj][0], v1 = acc[ai][bj][m][1] * pscale + bv[bj][1];
                if (gate) {
                    unsigned q[8];
#pragma unroll
                    for (int j = 0; j < 4; ++j) { q[j] = (unsigned)(fsigmoid(v0[j] * gscale) * 255.0f + 0.5f); q[4 + j] = (unsigned)(fsigmoid(v1[j] * gscale) * 255.0f + 0.5f); }
#pragma unroll
                    for (int j = 0; j < 8; ++j) q[j] = q[j] < 1u ? 1u : q[j];
                    u32x2 w8; w8.x = q[0] | (q[1] << 8) | (q[2] << 16) | (q[3] << 24); w8.y = q[4] | (q[5] << 8) | (q[6] << 16) | (q[7] << 24);
                    unsigned char* gp = gbase + (size_t)(row0 + ai * 128 + m * 16) * 3072 + bj * 128;
                    if constexpr (NT) __builtin_nontemporal_store(w8, (u32x2*)gp); else *(u32x2*)gp = w8;
                    continue; }
                u32x4 w; w.x = cvt_pk_bf16(v0[0], v0[1]); w.y = cvt_pk_bf16(v0[2], v0[3]); w.z = cvt_pk_bf16(v1[0], v1[1]); w.w = cvt_pk_bf16(v1[2], v1[3]);
                if constexpr (NT) __builtin_nontemporal_store(w, (u32x4*)(rowp + bj * 128)); else *(u32x4*)(rowp + bj * 128) = w; } }
    }
};
#ifndef G1_NT
#define G1_NT 1
#endif
#ifndef GATE_NT
#define GATE_NT 1
#endif
typedef EpiInT<G1_NT != 0> EpiIn; typedef EpiInT<GATE_NT != 0> EpiGateNT;
struct EpiPlain {
    EPI_NOKEEP
    bf16_t* O; int ldc;
    __device__ __forceinline__ void operator()(acc_t& acc, const pg8::Unit& u, int wr, int wc, int fr, int fq) const {
        const int row0 = u.pm * 256 + wr * 64 + fr; const int colt = u.pn * 256 + wc * 32 + 8 * fq;
#pragma unroll
        EPI_LOOP_ROWS { bf16_t* rowp = O + (size_t)(row0 + ai * 128 + m * 16) * ldc + colt;
#pragma unroll
            for (int bj = 0; bj < 2; ++bj) { const f32x4 v0 = acc[ai][bj][m][0], v1 = acc[ai][bj][m][1];
                u32x4 w; w.x = pk2(v0[0], v0[1]); w.y = pk2(v0[2], v0[3]); w.z = pk2(v1[0], v1[1]); w.w = pk2(v1[2], v1[3]);
                *(u32x4*)(rowp + bj * 128) = w; } }
    }
};
struct EpiLora {
    EPI_NOKEEP
    unsigned char* ws; const float* w0; const float* a0;
    __device__ __forceinline__ void operator()(acc_t& acc, const pg8::Unit& u, int wr, int wc, int fr, int fq) const {
        const int row0 = u.pm * 256 + wr * 64 + fr; const int colt = (u.pn & 1) * 256 + wc * 32 + 8 * fq; const int kind = u.pn >> 1;
        f32x4 bv[2][2];
#pragma unroll
        for (int bj = 0; bj < 2; ++bj)
#pragma unroll
            for (int n = 0; n < 2; ++n) bv[bj][n] = kind == 0 ? *(const f32x4*)(w0 + colt + bj * 128 + 4 * n) : (kind == 1 ? *(const f32x4*)(a0 + colt + bj * 128 + 4 * n) : (f32x4){0.f, 0.f, 0.f, 0.f});
#pragma unroll
        EPI_LOOP_ROWS { const size_t ro = (size_t)(row0 + ai * 128 + m * 16) * 512 + colt;
#pragma unroll
            for (int bj = 0; bj < 2; ++bj) { f32x4 v0 = acc[ai][bj][m][0] + bv[bj][0], v1 = acc[ai][bj][m][1] + bv[bj][1];
                if (kind == 0) {
#pragma unroll
                    for (int j = 0; j < 4; ++j) { v0[j] = -0.60653066f * fsigmoid(v0[j]); v1[j] = -0.60653066f * fsigmoid(v1[j]); if (!RW_CHUNKED) { v0[j] = fexp(v0[j]); v1[j] = fexp(v1[j]); } }
                    float* W = (float*)(ws + WS_W); *(f32x4*)(W + ro + bj * 128) = v0; *(f32x4*)(W + ro + bj * 128 + 4) = v1;
                } else {
                    if (kind == 1) {
#pragma unroll
                        for (int j = 0; j < 4; ++j) { v0[j] = fsigmoid(v0[j]); v1[j] = fsigmoid(v1[j]); } }
                    u32x4 w; w.x = cvt_pk_bf16(v0[0], v0[1]); w.y = cvt_pk_bf16(v0[2], v0[3]); w.z = cvt_pk_bf16(v1[0], v1[1]); w.w = cvt_pk_bf16(v1[2], v1[3]);
                    const size_t bo = (kind == 1) ? WS_ASIG : WS_YB0; *(u32x4*)((bf16_t*)(ws + bo) + ro + bj * 128) = w; } } }
    }
};
struct EpiBranch {
    bf16_t* MERGED; const bf16_t* GATE;
    __device__ __forceinline__ bool keep(const pg8::Unit& u) const { return u.aux != 2; }
    __device__ __forceinline__ void operator()(acc_t& acc, const pg8::Unit& u, int wr, int wc, int fr, int fq) const {
        const int row0 = u.pm * 256 + wr * 64 + fr; const int colt = u.pn * 256 + wc * 32 + 8 * fq; const int br = u.aux;
#pragma unroll
        for (int ai = 0; ai < 2; ++ai) {
            u32x2 g[4][2], gn[4][2]; const unsigned char* G8 = (const unsigned char*)GATE;
#pragma unroll
            for (int m = 0; m < 4; ++m)
#pragma unroll
                for (int bj = 0; bj < 2; ++bj) { const size_t r = (size_t)(row0 + ai * 128 + m * 16); const int c = colt + bj * 128;
                    g[m][bj] = *(const u32x2*)(G8 + r * 3072 + br * 1024 + c);
                    gn[m][bj] = g[m][bj]; if (br != 2) gn[m][bj] = *(const u32x2*)(G8 + r * 3072 + (br + 1) * 1024 + c); }
#pragma unroll
            for (int m = 0; m < 4; ++m)
#pragma unroll
                for (int bj = 0; bj < 2; ++bj) { const u32x2 gg = g[m][bj], nn = gn[m][bj];
                    float s[8];
                    { float a[8], b[8];
#pragma unroll
                      for (int j = 0; j < 4; ++j) { a[j] = (float)((gg.x >> (8 * j)) & 0xffu); a[4 + j] = (float)((gg.y >> (8 * j)) & 0xffu); b[j] = (float)((nn.x >> (8 * j)) & 0xffu); b[4 + j] = (float)((nn.y >> (8 * j)) & 0xffu); }
#pragma unroll
                      for (int j = 0; j < 8; ++j) s[j] = (br != 2) ? a[j] * __builtin_amdgcn_rcpf(b[j]) : a[j] * (1.0f / 255.0f); }
                    f32x4 v0 = acc[ai][bj][m][0], v1 = acc[ai][bj][m][1];
                    v0[0] *= s[0]; v0[1] *= s[1]; v0[2] *= s[2]; v0[3] *= s[3]; v1[0] *= s[4]; v1[1] *= s[5]; v1[2] *= s[6]; v1[3] *= s[7];
                    acc[ai][bj][m][0] = v0; acc[ai][bj][m][1] = v1;
                    if (br == 2) { const size_t r = (size_t)(row0 + ai * 128 + m * 16); const int c = colt + bj * 128;
                        u32x4 w; w.x = cvt_pk_bf16(v0[0], v0[1]); w.y = cvt_pk_bf16(v0[2], v0[3]); w.z = cvt_pk_bf16(v1[0], v1[1]); w.w = cvt_pk_bf16(v1[2], v1[3]);
                        *(u32x4*)(MERGED + r * 1024 + c) = w; } }
        }
    }
};
struct EpiOut {
    EPI_NOKEEP
    const float* X; float* H1;
    __device__ __forceinline__ void operator()(acc_t& acc, const pg8::Unit& u, int wr, int wc, int fr, int fq) const {
        const int row0 = u.pm * 256 + wr * 64 + fr; const int colt = u.pn * 256 + wc * 32 + 8 * fq;
#pragma unroll
        for (int ai = 0; ai < 2; ++ai) {
            f32x4 x0[4][2], x1[4][2];
#pragma unroll
            for (int m = 0; m < 4; ++m)
#pragma unroll
                for (int bj = 0; bj < 2; ++bj) { const size_t ro = (size_t)(row0 + ai * 128 + m * 16) * 1024 + colt + bj * 128; x0[m][bj] = *(const f32x4*)(X + ro); x1[m][bj] = *(const f32x4*)(X + ro + 4); }
#pragma unroll
            for (int m = 0; m < 4; ++m)
#pragma unroll
                for (int bj = 0; bj < 2; ++bj) { const size_t ro = (size_t)(row0 + ai * 128 + m * 16) * 1024 + colt + bj * 128;
                    *(f32x4*)(H1 + ro) = x0[m][bj] + acc[ai][bj][m][0]; *(f32x4*)(H1 + ro + 4) = x1[m][bj] + acc[ai][bj][m][1]; }
        }
    }
};
struct EpiUp {
    EPI_NOKEEP
    bf16_t* ACT; const float* b1; const float* slot_rs;
    __device__ __forceinline__ void operator()(acc_t& acc, const pg8::Unit& u, int wr, int wc, int fr, int fq) const {
        const int row0 = u.pm * 256 + wr * 64 + fr; const int colt = u.pn * 256 + wc * 32 + 8 * fq;
        const float* bb = b1 + (size_t)u.aux * 2048 + colt;
        f32x4 bv[2][2];
#pragma unroll
        for (int bj = 0; bj < 2; ++bj)
#pragma unroll
            for (int n = 0; n < 2; ++n) bv[bj][n] = *(const f32x4*)(bb + bj * 128 + 4 * n);
#pragma unroll
        EPI_LOOP_ROWS { const int r = row0 + ai * 128 + m * 16; const float rs = slot_rs[r] * (MOE_FP8 ? 1.0f / W8_SCALE : 1.0f);
#pragma unroll
            for (int bj = 0; bj < 2; ++bj) { const f32x4 v0 = acc[ai][bj][m][0] * rs + bv[bj][0], v1 = acc[ai][bj][m][1] * rs + bv[bj][1];
                float o[4];
#pragma unroll
                for (int p = 0; p < 4; ++p) { float gl = p < 2 ? v0[2 * p] : v1[2 * p - 4], ln = p < 2 ? v0[2 * p + 1] : v1[2 * p - 3];
                    gl = fminf(gl, 7.0f); ln = fminf(fmaxf(ln, -7.0f), 7.0f); o[p] = gl * fsigmoid(1.702f * gl) * (ln + 1.0f); }
                if (MOE_FP8) *(unsigned*)((unsigned char*)ACT + (size_t)r * 1024 + ((colt + bj * 128) >> 1)) = cvt_fp8x4(o[0], o[1], o[2], o[3]);
                else { u32x2 w; w.x = cvt_pk_bf16(o[0], o[1]); w.y = cvt_pk_bf16(o[2], o[3]);
                *(u32x2*)(ACT + (size_t)r * 1024 + ((colt + bj * 128) >> 1)) = w; } } }
    }
};
struct EpiDown {
    EPI_NOKEEP
    bf16_t* YS; const float* b2; const float* slot_g;
    __device__ __forceinline__ void operator()(acc_t& acc, const pg8::Unit& u, int wr, int wc, int fr, int fq) const {
        const int row0 = u.pm * 256 + wr * 64 + fr; const int colt = u.pn * 256 + wc * 32 + 8 * fq;
        const float* bb = b2 + (size_t)u.aux * 1024 + colt;
        const float ws_ = MOE_FP8 ? 1.0f / W8_SCALE : 1.0f;
#pragma unroll
        for (int bj = 0; bj < 2; ++bj) { const f32x4 b0 = *(const f32x4*)(bb + bj * 128), b1 = *(const f32x4*)(bb + bj * 128 + 4);
#pragma unroll
            EPI_LOOP_ROWS { const int r = row0 + ai * 128 + m * 16; const float g = slot_g[r];
                const f32x4 v0 = (acc[ai][bj][m][0] * ws_ + b0) * g, v1 = (acc[ai][bj][m][1] * ws_ + b1) * g;
                if (YS_FP8) { u32x2 w8; w8.x = cvt_fp8x4(v0[0], v0[1], v0[2], v0[3]); w8.y = cvt_fp8x4(v1[0], v1[1], v1[2], v1[3]); *(u32x2*)((unsigned char*)YS + (size_t)r * 1024 + colt + bj * 128) = w8; }
                else { u32x4 w; w.x = cvt_pk_bf16(v0[0], v0[1]); w.y = cvt_pk_bf16(v0[2], v0[3]); w.z = cvt_pk_bf16(v1[0], v1[1]); w.w = cvt_pk_bf16(v1[2], v1[3]);
                *(u32x4*)(YS + (size_t)r * 1024 + colt + bj * 128) = w; } } }
    }
};
struct Args {
    const float* in[30]; float* out; unsigned char* ws; int ph_lo, ph_hi;
};
typedef __attribute__((address_space(4))) const unsigned char* kptr_t;
__device__ __forceinline__ kptr_t karg_at(int off) { asm volatile("" : "+s"(off)); return (kptr_t)__builtin_amdgcn_kernarg_segment_ptr() + off; }
struct KA {
    __device__ __forceinline__ const float* in(int i) const { return *(const float* const __attribute__((address_space(4)))*)karg_at(8 * i); }
    __device__ __forceinline__ float* out() const { return *(float* const __attribute__((address_space(4)))*)karg_at(240); }
    __device__ __forceinline__ unsigned char* ws() const { return *(unsigned char* const __attribute__((address_space(4)))*)karg_at(248); }
    __device__ __forceinline__ int ph_lo() const { return *(const int __attribute__((address_space(4)))*)karg_at(256); }
    __device__ __forceinline__ int ph_hi() const { return *(const int __attribute__((address_space(4)))*)karg_at(260); }
};
struct Ctx {
    LAS unsigned char* lds; int G, bid;
};
struct Ids { int tid, lane, wave; };
__device__ __forceinline__ Ids get_ids() { int t = threadIdx.x; asm volatile("" : "+v"(t)); Ids I; I.tid = t; I.lane = t & 63; I.wave = __builtin_amdgcn_readfirstlane(t >> 6); return I; }

#define XB_TMO      128
#define XB_XCNT(j)  (256  + 64 * (j))
#define XB_XSUB(j)  (1280 + 64 * (j))
#define XB_XGEN(j)  (2304 + 64 * (j))
#define XB_TOP      3328
#define XB_TOPGEN   3392
#define XCD_BAR_WORDS 3456
#define XB_SPIN_CAP (1u << 22)
__device__ __forceinline__ unsigned xb_ld(unsigned* p)              { return __hip_atomic_load(p, __ATOMIC_RELAXED, __HIP_MEMORY_SCOPE_AGENT); }
__device__ __forceinline__ unsigned xb_add(unsigned* p, unsigned v) { return __hip_atomic_fetch_add(p, v, __ATOMIC_RELAXED, __HIP_MEMORY_SCOPE_AGENT); }
__device__ __forceinline__ unsigned xb_xcc_id() { return (unsigned)__builtin_amdgcn_s_getreg((3 << 11) | 20) & 0xFu; }
#define XB_SPIN(cond, bar) do { unsigned _sp = 0; while (cond) { __builtin_amdgcn_s_sleep(1); \
    if ((++_sp & 255u) == 0u) { if (xb_ld(&(bar)[XB_TMO])) break; if (_sp > XB_SPIN_CAP) { atomicAdd(&(bar)[XB_TMO], 1u); break; } } } } while (0)
struct XcdBarrier { unsigned* bar; unsigned x; volatile LAS unsigned* st; };
__device__ __forceinline__ XcdBarrier xcd_barrier_post(unsigned* bar, volatile LAS unsigned* st) {
    XcdBarrier b; b.bar = bar; b.x = xb_xcc_id(); b.st = st;
    if (threadIdx.x == 0) (void)xb_add(&bar[XB_XCNT(b.x)], 1u);
    return b;
}
__device__ __forceinline__ void xcd_barrier_complete(unsigned* bar, unsigned x, unsigned& nloc, unsigned& nx) {
    const unsigned G = gridDim.x * gridDim.y * gridDim.z;
    unsigned sum, cnt, mine, sp = 0u;
    for (;;) {
        sum = 0u; cnt = 0u; mine = 0u;
#pragma unroll
        for (unsigned j = 0; j < 16; ++j) { const unsigned c = xb_ld(&bar[XB_XCNT(j)]); sum += c; cnt += (c > 0u) ? 1u : 0u; mine = (j == x) ? c : mine; }
        if (sum == G) break;
        __builtin_amdgcn_s_sleep(1);
        if ((++sp & 255u) == 0u) { if (xb_ld(&bar[XB_TMO])) break; if (sp > XB_SPIN_CAP) { atomicAdd(&bar[XB_TMO], 1u); break; } }
    }
    nloc = mine > 0u ? mine : 1u; nx = cnt > 0u ? cnt : 1u;
}
__device__ __forceinline__ void xcd_barrier(const XcdBarrier& b) {
    asm volatile("s_waitcnt vmcnt(0)" ::: "memory");
    __syncthreads();
    if (threadIdx.x == 0) {
        unsigned* bar = b.bar;
        __builtin_amdgcn_s_waitcnt(0);
        unsigned nloc = b.st[0], nx = b.st[1];
        if (nloc == 0u) { xcd_barrier_complete(bar, b.x, nloc, nx); b.st[0] = nloc; b.st[1] = nx; }
        const unsigned old = xb_add(&bar[XB_XSUB(b.x)], 1u);
        const unsigned gen = old / nloc;
        if (old + 1u == (gen + 1u) * nloc) {
            __builtin_amdgcn_fence(__ATOMIC_RELEASE, "agent");
            asm volatile("s_waitcnt vmcnt(0)" ::: "memory");
            const unsigned og = xb_add(&bar[XB_TOP], 1u);
            const unsigned tg = og / nx;
            if (og + 1u == (tg + 1u) * nx) xb_add(&bar[XB_TOPGEN], 1u);
            else XB_SPIN(xb_ld(&bar[XB_TOPGEN]) == tg, bar);
            __builtin_amdgcn_fence(__ATOMIC_ACQUIRE, "agent");
            xb_add(&bar[XB_XGEN(b.x)], 1u);
            asm volatile("s_waitcnt vmcnt(0)" ::: "memory");
        } else {
            XB_SPIN(xb_ld(&bar[XB_XGEN(b.x)]) == gen, bar);
            __builtin_amdgcn_fence(__ATOMIC_ACQUIRE, "agent");
            asm volatile("s_waitcnt vmcnt(0)" ::: "memory");
        }
    }
    __syncthreads();
}

struct TItem { const float* W; bf16_t* WT; const float* ksc; int K, N, row_off, item; int f8; };
__device__ __forceinline__ void t_load(const TItem& t, float (&v)[32], int lane) {
    const int nblk = t.N / 32, kb = t.item / nblk, nb = t.item % nblk, k0 = 64 * kb, n0 = 32 * nb;
    const float* p = t.W + (size_t)(k0 + (lane >> 5)) * t.N + n0 + (lane & 31);
#pragma unroll
    for (int i = 0; i < 32; ++i) v[i] = p[(size_t)(2 * i) * t.N];
}
__device__ __forceinline__ void t_store(const TItem& t, const float (&v)[32], LAS float* scr, int lane) {
    const int nblk = t.N / 32, kb = t.item / nblk, nb = t.item % nblk, k0 = 64 * kb, n0 = 32 * nb;
#pragma unroll
    for (int i = 0; i < 32; ++i) { const int kk = 2 * i + (lane >> 5); float x = v[i]; if (t.ksc) x *= t.ksc[k0 + kk]; scr[kk * 33 + (lane & 31)] = x; }
    LDS_WAIT(); asm volatile("" ::: "memory");
    const int c = lane & 7;
#pragma unroll
    for (int j = 0; j < 4; ++j) { const int n = (lane >> 3) + 8 * j; const LAS float* s = scr + (8 * c) * 33 + n;
        if (t.f8) { u32x2 o; o.x = cvt_fp8x4(s[0 * 33] * W8_SCALE, s[1 * 33] * W8_SCALE, s[2 * 33] * W8_SCALE, s[3 * 33] * W8_SCALE); o.y = cvt_fp8x4(s[4 * 33] * W8_SCALE, s[5 * 33] * W8_SCALE, s[6 * 33] * W8_SCALE, s[7 * 33] * W8_SCALE);
            *(u32x2*)((unsigned char*)t.WT + (size_t)(t.row_off + n0 + n) * t.K + k0 + 8 * c) = o; }
        else { u32x4 o; o.x = pk2(s[0 * 33], s[1 * 33]); o.y = pk2(s[2 * 33], s[3 * 33]); o.z = pk2(s[4 * 33], s[5 * 33]); o.w = pk2(s[6 * 33], s[7 * 33]);
        *(u32x4*)(t.WT + (size_t)(t.row_off + n0 + n) * t.K + k0 + 8 * c) = o; } }
    LDS_WAIT(); asm volatile("" ::: "memory");
}
__device__ __forceinline__ void rms_row_to_bf16(const float* xrow, const float* w, bf16_t* orow, int lane, unsigned char* o8row) {
    const f32x4* xr = (const f32x4*)xrow + lane; const f32x4* wr = (const f32x4*)w + lane;
    f32x4 v[4]; float s = 0.f;
#pragma unroll
    for (int j = 0; j < 4; ++j) { v[j] = xr[64 * j]; s += (v[j].x * v[j].x + v[j].y * v[j].y) + (v[j].z * v[j].z + v[j].w * v[j].w); }
    const float rstd = 1.f / sqrtf(wave_sum(s) * (1.f / 1024.f) + 1e-5f);
    u32x2* o8 = (u32x2*)orow + lane;
#pragma unroll
    for (int j = 0; j < 4; ++j) { const f32x4 ww = wr[64 * j]; const float y0 = v[j].x * rstd * ww.x, y1 = v[j].y * rstd * ww.y, y2 = v[j].z * rstd * ww.z, y3 = v[j].w * rstd * ww.w;
        u32x2 o; o.x = pk2(y0, y1); o.y = pk2(y2, y3); if (orow) o8[64 * j] = o; if (o8row) ((unsigned*)o8row)[lane + 64 * j] = cvt_fp8x4(y0, y1, y2, y3); }
}
__device__ __forceinline__ void phase0(const KA& a, const Ctx& C) {
    const Ids I = get_ids();
    unsigned char* ws = a.ws();
    LAS float* scr = (LAS float*)(C.lds + I.wave * 16384);
    const int gw = C.bid * NWAVES + I.wave, NGW = C.G * NWAVES;
    bf16_t* WBIG = (bf16_t*)(ws + WS_WBIG); bf16_t* WMKV = (bf16_t*)(ws + WS_WMKV); bf16_t* WBR = (bf16_t*)(ws + WS_WBR); bf16_t* WOUT = (bf16_t*)(ws + WS_WOUT);
    bf16_t* W1T = (bf16_t*)(ws + WS_W1T); bf16_t* W2T = (bf16_t*)(ws + WS_W2T);
    constexpr int I_IN = 16 * 96, I_G = 16 * 32, I_MKV = 16 * 32, I_BR = 8 * 32, I_OUT = 16 * 32, I_E1 = 16 * 64, I_E2 = 16 * 32;
    constexpr int NITEMS = I_IN + 3 * I_G + I_MKV + 3 * I_BR + I_OUT;
    auto decode = [&](int it) -> TItem {
        TItem t; int r = it; t.ksc = nullptr; t.row_off = 0; t.K = 1024; t.N = 1024; t.f8 = 0;
        if (r < I_IN) { t.W = a.in(4); t.N = 3072; t.WT = WBIG; t.item = r; t.f8 = G1_FP8; return t; } r -= I_IN;
        if (r < 3 * I_G) { const int g = r / I_G; t.W = a.in(19) + (size_t)g * 1024 * 1024; t.WT = (bf16_t*)(ws + WS_WG8); t.row_off = 1024 * g; t.item = r % I_G; t.f8 = 1; return t; } r -= 3 * I_G;
        if (r < I_MKV) { t.W = a.in(18); t.WT = WMKV; t.item = r; return t; } r -= I_MKV;
        if (r < 3 * I_BR) { const int g = r / I_BR; t.W = a.in(20) + (size_t)g * 512 * 1024; t.K = 512; t.WT = WBR + (size_t)g * 1024 * 512; t.item = r % I_BR; return t; } r -= 3 * I_BR;
        if (r < I_OUT) { t.W = a.in(21); t.WT = WOUT; t.item = r; return t; } r -= I_OUT;
        if (r < NEXP * I_E1) { const int e = r / I_E1; t.W = a.in(25) + (size_t)e * 1024 * 2048; t.N = 2048; t.WT = (bf16_t*)((unsigned char*)W1T + (size_t)e * 2048 * 1024 * (MOE_FP8 ? 1 : 2)); t.ksc = a.in(22); t.item = r % I_E1; t.f8 = MOE_FP8; return t; } r -= NEXP * I_E1;
        { const int e = r / I_E2; t.W = a.in(27) + (size_t)e * 1024 * 1024; t.WT = (bf16_t*)((unsigned char*)W2T + (size_t)e * 1024 * 1024 * (MOE_FP8 ? 1 : 2)); t.item = r % I_E2; t.f8 = MOE_FP8; return t; }
    };
    {
        float va[32], vb[32];
        int it = gw;
        TItem ta, tb;
        if (it < NITEMS) { ta = decode(it); t_load(ta, va, I.lane); }
        while (it < NITEMS) {
            const int it2 = it + NGW;
            if (it2 < NITEMS) { tb = decode(it2); t_load(tb, vb, I.lane); }
            t_store(ta, va, scr, I.lane);
            it = it2;
            if (it < NITEMS) {
                const int it3 = it + NGW;
                if (it3 < NITEMS) { ta = decode(it3); t_load(ta, va, I.lane); }
                t_store(tb, vb, scr, I.lane);
                it = it3;
            }
        }
    }
    { bf16_t* WRW = (bf16_t*)(ws + WS_WRW); const float* w2 = a.in(8); const float* a2 = a.in(10); const float* g2 = a.in(11);
      for (int i = C.bid * 512 + I.tid; i < 1536 * 256; i += C.G * 512) { const int n = i >> 8, k = i & 255; float v = 0.f;
          if (n < 512) { if (k < 64) v = w2[k * 512 + n]; } else if (n < 1024) { if (k >= 64 && k < 128) v = a2[(k - 64) * 512 + (n - 512)]; } else { if (k >= 128) v = g2[(k - 128) * 512 + (n - 1024)]; }
          WRW[i] = (bf16_t)f2bf(v); } }
    { bf16_t* WRT = (bf16_t*)(ws + MS_WRT); const float* wr = a.in(23); const float* fw = a.in(22);
      for (int i = C.bid * 512 + I.tid; i < 32 * 1024; i += C.G * 512) { const int e = i >> 10, k = i & 1023; const float v = wr[k * 32 + e] * fw[k];
          const unsigned hi = f2bf(v); const float lo = v - __builtin_bit_cast(float, hi << 16); WRT[i] = (bf16_t)hi; WRT[32 * 1024 + i] = (bf16_t)f2bf(lo); } }
    bf16_t* XN = (bf16_t*)(ws + WS_XN); bf16_t* MEMN = (bf16_t*)(ws + WS_MEMN);
    { const float* X = a.in(0); const f32x4* wr = (const f32x4*)a.in(2) + I.lane; f32x4 ww[4];
#pragma unroll
      for (int j = 0; j < 4; ++j) ww[j] = wr[64 * j];
      f32x4 v[4], vn[4];
      if (gw < NTOK) {
#pragma unroll
          for (int j = 0; j < 4; ++j) v[j] = ((const f32x4*)(X + (size_t)gw * 1024) + I.lane)[64 * j]; }
      for (int m = gw; m < NTOK; m += NGW) {
          const int mn = m + NGW;
          if (mn < NTOK) {
#pragma unroll
              for (int j = 0; j < 4; ++j) vn[j] = ((const f32x4*)(X + (size_t)mn * 1024) + I.lane)[64 * j]; }
          float s = 0.f;
#pragma unroll
          for (int j = 0; j < 4; ++j) s += (v[j].x * v[j].x + v[j].y * v[j].y) + (v[j].z * v[j].z + v[j].w * v[j].w);
          const float rstd = 1.f / sqrtf(wave_sum(s) * (1.f / 1024.f) + 1e-5f);
#pragma unroll
          for (int j = 0; j < 4; ++j) { const float y0 = v[j].x * rstd * ww[j].x, y1 = v[j].y * rstd * ww[j].y, y2 = v[j].z * rstd * ww[j].z, y3 = v[j].w * rstd * ww[j].w;
              if (!G1_FP8) { u32x2 o; o.x = pk2(y0, y1); o.y = pk2(y2, y3); ((u32x2*)(XN + (size_t)m * 1024) + I.lane)[64 * j] = o; }
              ((unsigned*)(ws + WS_XN8 + (size_t)m * 1024))[I.lane + 64 * j] = cvt_fp8x4(y0, y1, y2, y3); }
#pragma unroll
          for (int j = 0; j < 4; ++j) v[j] = vn[j];
      } }
    for (int m = gw; m < NMEM; m += NGW) rms_row_to_bf16(a.in(1) + (size_t)m * 1024, a.in(3), MEMN + (size_t)m * 1024, I.lane, nullptr);
}
__device__ __forceinline__ void t_load4(const TItem& t, f32x4 (&v)[8], int lane) {
    const int nblk = t.N / 32, kb = t.item / nblk, nb = t.item % nblk, k0 = 64 * kb, n0 = 32 * nb;
    const float* p = t.W + (size_t)(k0 + (lane >> 3)) * t.N + n0 + 4 * (lane & 7);
#pragma unroll
    for (int i = 0; i < 8; ++i) v[i] = *(const f32x4*)(p + (size_t)(8 * i) * t.N);
}
__device__ __forceinline__ void t_store4(const TItem& t, const f32x4 (&v)[8], LAS float* scr, int lane) {
    const int nblk = t.N / 32, kb = t.item / nblk, nb = t.item % nblk, k0 = 64 * kb, n0 = 32 * nb;
#pragma unroll
    for (int i = 0; i < 8; ++i) { const int kk = 8 * i + (lane >> 3); f32x4 x = v[i]; if (t.ksc) x = x * t.ksc[k0 + kk];
        LAS float* d = scr + kk * 33 + 4 * (lane & 7); d[0] = x[0]; d[1] = x[1]; d[2] = x[2]; d[3] = x[3]; }
    LDS_WAIT(); asm volatile("" ::: "memory");
    const int c = lane & 7;
#pragma unroll
    for (int j = 0; j < 4; ++j) { const int n = (lane >> 3) + 8 * j; const LAS float* s = scr + (8 * c) * 33 + n;
        if (t.f8) { u32x2 o; o.x = cvt_fp8x4(s[0 * 33] * W8_SCALE, s[1 * 33] * W8_SCALE, s[2 * 33] * W8_SCALE, s[3 * 33] * W8_SCALE); o.y = cvt_fp8x4(s[4 * 33] * W8_SCALE, s[5 * 33] * W8_SCALE, s[6 * 33] * W8_SCALE, s[7 * 33] * W8_SCALE);
            *(u32x2*)((unsigned char*)t.WT + (size_t)(t.row_off + n0 + n) * t.K + k0 + 8 * c) = o; }
        else { u32x4 o; o.x = pk2(s[0 * 33], s[1 * 33]); o.y = pk2(s[2 * 33], s[3 * 33]); o.z = pk2(s[4 * 33], s[5 * 33]); o.w = pk2(s[6 * 33], s[7 * 33]);
        *(u32x4*)(t.WT + (size_t)(t.row_off + n0 + n) * t.K + k0 + 8 * c) = o; } }
    LDS_WAIT(); asm volatile("" ::: "memory");
}
__device__ __forceinline__ void phase0_moe(const KA& a, const Ctx& C) {
    const Ids I = get_ids();
    unsigned char* ws = a.ws();
    LAS float* scr = (LAS float*)(C.lds + I.wave * 16384);
    bf16_t* W1T = (bf16_t*)(ws + WS_W1T); bf16_t* W2T = (bf16_t*)(ws + WS_W2T);
    constexpr int I_E1 = 16 * 64, I_E2 = 16 * 32, NM = NEXP * (I_E1 + I_E2), NCH = 16;
    unsigned* ctr = (unsigned*)(ws + WS_CTL) + CW_MOEW;
    auto decode = [&](int r) -> TItem {
        TItem t; t.ksc = nullptr; t.row_off = 0; t.K = 1024; t.N = 1024; t.f8 = MOE_FP8;
        if (r < NEXP * I_E1) { const int e = r / I_E1; t.W = a.in(25) + (size_t)e * 1024 * 2048; t.N = 2048; t.WT = (bf16_t*)((unsigned char*)W1T + (size_t)e * 2048 * 1024 * (MOE_FP8 ? 1 : 2)); t.ksc = a.in(22); t.item = r % I_E1; return t; } r -= NEXP * I_E1;
        { const int e = r / I_E2; t.W = a.in(27) + (size_t)e * 1024 * 1024; t.WT = (bf16_t*)((unsigned char*)W2T + (size_t)e * 1024 * 1024 * (MOE_FP8 ? 1 : 2)); t.item = r % I_E2; return t; }
    };
    __syncthreads();
    for (;;) {
        unsigned c0 = 0u; if (I.lane == 0) c0 = __hip_atomic_fetch_add(ctr, (unsigned)NCH, __ATOMIC_RELAXED, __HIP_MEMORY_SCOPE_AGENT);
        const int c = __builtin_amdgcn_readfirstlane((int)c0);
        if (c >= NM) break;
        f32x4 v0[8], v1[8], v2[8], v3[8];
        t_load4(decode(c), v0, I.lane); t_load4(decode(c + 1), v1, I.lane); t_load4(decode(c + 2), v2, I.lane);
#pragma unroll 1
        for (int j = 0; j < NCH; j += 4) {
            t_load4(decode(c + j + 3), v3, I.lane); t_store4(decode(c + j), v0, scr, I.lane);
            if (j + 4 < NCH) t_load4(decode(c + j + 4), v0, I.lane); t_store4(decode(c + j + 1), v1, scr, I.lane);
            if (j + 5 < NCH) t_load4(decode(c + j + 5), v1, I.lane); t_store4(decode(c + j + 2), v2, scr, I.lane);
            if (j + 6 < NCH) t_load4(decode(c + j + 6), v2, I.lane); t_store4(decode(c + j + 3), v3, scr, I.lane); }
    }
    __syncthreads();
}

__device__ __forceinline__ void phase_lerp(const KA& a, const Ctx& C) {
    const Ids I = get_ids();
    unsigned char* ws = a.ws();
    const bf16_t* P = (const bf16_t*)(ws + WS_P); const float* mu = a.in(6);
    bf16_t* R = (bf16_t*)(ws + WS_R); bf16_t* KR = (bf16_t*)(ws + WS_KR); bf16_t* V = (bf16_t*)(ws + WS_V); bf16_t* LIN = (bf16_t*)(ws + WS_LIN);
    const int gw = C.bid * NWAVES + I.wave, NGW = C.G * NWAVES;
    f32x4 m0[4], m1[4];
#pragma unroll
    for (int it = 0; it < 4; ++it) { const int c = I.lane + 64 * it; m0[it] = (f32x4){0.f, 0.f, 0.f, 0.f}; m1[it] = m0[it]; if (c < 224) { m0[it] = *(const f32x4*)(mu + c * 8); m1[it] = *(const f32x4*)(mu + c * 8 + 4); } }
    u32x4 pa[4], pb[4], na[4], nb[4];
#define LERP_LOAD(mm, A, B) do { const bool _hp = ((mm) & (SEQ - 1)) != 0; const bf16_t* _cur = P + (size_t)(mm) * 3072; _Pragma("unroll") for (int it = 0; it < 4; ++it) { const int c = I.lane + 64 * it; \
        A[it] = (u32x4){0u, 0u, 0u, 0u}; B[it] = A[it]; if (c < 224) { A[it] = *(const u32x4*)(_cur + c * 8); if (_hp) B[it] = *(const u32x4*)(_cur - 3072 + c * 8); } } } while (0)
    if (gw < NTOK) LERP_LOAD(gw, pa, pb);
    for (int m = gw; m < NTOK; m += NGW) {
        if (m + NGW < NTOK) LERP_LOAD(m + NGW, na, nb);
#pragma unroll
        for (int it = 0; it < 4; ++it) { const int c = I.lane + 64 * it;
            if (c < 224) { const int col0 = c * 8; const u32x4 qa = pa[it], qb = pb[it];
                float v[8];
                v[0] = bf_lo(qa.x) + (bf_lo(qb.x) - bf_lo(qa.x)) * m0[it][0]; v[1] = bf_hi(qa.x) + (bf_hi(qb.x) - bf_hi(qa.x)) * m0[it][1];
                v[2] = bf_lo(qa.y) + (bf_lo(qb.y) - bf_lo(qa.y)) * m0[it][2]; v[3] = bf_hi(qa.y) + (bf_hi(qb.y) - bf_hi(qa.y)) * m0[it][3];
                v[4] = bf_lo(qa.z) + (bf_lo(qb.z) - bf_lo(qa.z)) * m1[it][0]; v[5] = bf_hi(qa.z) + (bf_hi(qb.z) - bf_hi(qa.z)) * m1[it][1];
                v[6] = bf_lo(qa.w) + (bf_lo(qb.w) - bf_lo(qa.w)) * m1[it][2]; v[7] = bf_hi(qa.w) + (bf_hi(qb.w) - bf_hi(qa.w)) * m1[it][3];
                bf16_t* dst;
                if (col0 < 512) dst = R + (size_t)m * 512 + col0;
                else if (col0 < 1024) dst = KR + (size_t)m * 512 + (col0 - 512);
                else if (col0 < 1536) dst = V + (size_t)m * 512 + (col0 - 1024);
                else { dst = LIN + (size_t)m * 256 + (col0 - 1536);
                    if (col0 < 1600) {
#pragma unroll
                        for (int j = 0; j < 8; ++j) { const float e2 = fexp(2.0f * v[j]); v[j] = 1.0f - 2.0f * __builtin_amdgcn_rcpf(e2 + 1.0f); }
                    } else if (col0 >= 1664) {
#pragma unroll
                        for (int j = 0; j < 8; ++j) v[j] = fsigmoid(v[j]);
                    } }
                u32x4 o; o.x = pk2(v[0], v[1]); o.y = pk2(v[2], v[3]); o.z = pk2(v[4], v[5]); o.w = pk2(v[6], v[7]);
                *(u32x4*)dst = o; } }
#pragma unroll
        for (int it = 0; it < 4; ++it) { pa[it] = na[it]; pb[it] = nb[it]; }
    }
#undef LERP_LOAD
}

__device__ __forceinline__ s16x4 vtr(LAS const unsigned char* p) { typedef short v4i16_t __attribute__((ext_vector_type(4))); return __builtin_bit_cast(s16x4, __builtin_amdgcn_ds_read_tr16_b64_v4i16((LAS v4i16_t*)p)); }
template <int DH, int NKT, int KP, bool SWA>
__device__ __forceinline__ void attn_qtile(const bf16x8 (&qf)[DH / 32], LAS const unsigned char* Kl, LAS const unsigned char* Vl, int lane, float scale,
                                           int t, int s0, int smin, float slope, float sink, f32x4 (&o)[DH / 16]) {
    const int fr = lane & 15, fq = lane >> 4;
    f32x4 s[NKT];
#pragma unroll
    for (int kt = 0; kt < NKT; ++kt) { s[kt] = (f32x4){0.f, 0.f, 0.f, 0.f};
#pragma unroll
        for (int ks = 0; ks < DH / 32; ++ks) { const bf16x8 kf = *(const LAS bf16x8*)(Kl + (kt * 16 + fr) * KP + (ks * 32 + fq * 8) * 2);
            s[kt] = __builtin_amdgcn_mfma_f32_16x16x32_bf16(kf, qf[ks], s[kt], 0, 0, 0); } }
    float mx = -1e30f;
#pragma unroll
    for (int kt = 0; kt < NKT; ++kt)
#pragma unroll
        for (int r = 0; r < 4; ++r) { float v = s[kt][r] * scale;
            if (SWA) { const int sp = s0 + kt * 16 + fq * 4 + r; const int dist = t - sp; const bool valid = (dist >= 0) && (dist < 128) && (sp >= smin); v = valid ? v - slope * (float)dist : -1e30f; }
            s[kt][r] = v; mx = fmaxf(mx, v); }
    mx = fmaxf(mx, __shfl_xor(mx, 16)); mx = fmaxf(mx, __shfl_xor(mx, 32));
    if (SWA) mx = fmaxf(mx, sink);
    float sum = 0.f;
#pragma unroll
    for (int kt = 0; kt < NKT; ++kt)
#pragma unroll
        for (int r = 0; r < 4; ++r) { const float p = fexp(s[kt][r] - mx); s[kt][r] = p; sum += p; }
    sum += __shfl_xor(sum, 16); sum += __shfl_xor(sum, 32);
    if (SWA) sum += fexp(sink - mx);
    const float inv = 1.0f / sum;
#pragma unroll
    for (int dt = 0; dt < DH / 16; ++dt) o[dt] = (f32x4){0.f, 0.f, 0.f, 0.f};
    const int q4 = fr >> 2, p4 = fr & 3;
#pragma unroll
    for (int c = 0; c < NKT / 2; ++c) {
        u32x4 pw; pw.x = cvt_pk_bf16(s[2 * c][0], s[2 * c][1]); pw.y = cvt_pk_bf16(s[2 * c][2], s[2 * c][3]); pw.z = cvt_pk_bf16(s[2 * c + 1][0], s[2 * c + 1][1]); pw.w = cvt_pk_bf16(s[2 * c + 1][2], s[2 * c + 1][3]);
        const bf16x8 pf = __builtin_bit_cast(bf16x8, pw);
#pragma unroll
        for (int dt = 0; dt < DH / 16; ++dt) {
            const s16x4 lo = vtr(Vl + (c * 32 + fq * 4 + q4) * KP + (dt * 16 + p4 * 4) * 2);
            const s16x4 hi = vtr(Vl + (c * 32 + 16 + fq * 4 + q4) * KP + (dt * 16 + p4 * 4) * 2);
            bf16x8 vf; vf[0] = lo[0]; vf[1] = lo[1]; vf[2] = lo[2]; vf[3] = lo[3]; vf[4] = hi[0]; vf[5] = hi[1]; vf[6] = hi[2]; vf[7] = hi[3];
            o[dt] = __builtin_amdgcn_mfma_f32_16x16x32_bf16(vf, pf, o[dt], 0, 0, 0); } }
#pragma unroll
    for (int dt = 0; dt < DH / 16; ++dt) o[dt] = o[dt] * inv;
}

__device__ __forceinline__ void phase_swa(const KA& a, const Ctx& C) {
    const Ids I = get_ids();
    unsigned char* ws = a.ws();
    const bf16_t* P = (const bf16_t*)(ws + WS_P); bf16_t* Y = (bf16_t*)(ws + WS_YB1); const float* sinks = a.in(17);
    constexpr int KP = 144, ROWS = 272;
    LAS unsigned char* Kl = C.lds; LAS unsigned char* Vl = C.lds + ROWS * KP;
    for (int u = C.bid; u < BATCH * 2 * 32; u += C.G) {
        const int qb = u & 31, hk = (u >> 5) & 1, b = u >> 6;
        const int pos0 = qb * 128 - 128;
        __syncthreads();
        for (int i = I.tid; i < ROWS * 8 * 2; i += 512) { const int which = i >= ROWS * 8; const int j = which ? i - ROWS * 8 : i; const int r = j >> 3, ch = j & 7; const int pos = pos0 + r;
            u32x4 v = (u32x4){0u, 0u, 0u, 0u};
            if (pos >= 0 && r < 256) v = *(const u32x4*)(P + (size_t)(b * SEQ + pos) * 3072 + SWA_OFF + 512 + which * 128 + hk * 64 + ch * 8);
            *(LAS u32x4*)((which ? Vl : Kl) + r * KP + ch * 16) = v; }
        __syncthreads();
        const int g = I.wave >> 1, half = I.wave & 1, h = hk * 4 + g;
        const float slope = __builtin_amdgcn_exp2f(-(float)(h + 1)); const float sink = sinks[h];
        const int fr = I.lane & 15, fq = I.lane >> 4;
#pragma unroll 1
        for (int qt = 0; qt < 4; ++qt) {
            const int trel = half * 64 + qt * 16;
            const int tq = qb * 128 + trel + fr;
            const bf16_t* qrow = P + (size_t)(b * SEQ + tq) * 3072 + SWA_OFF + h * 64;
            bf16x8 qf[2]; qf[0] = *(const bf16x8*)(qrow + fq * 8); qf[1] = *(const bf16x8*)(qrow + 32 + fq * 8);
            f32x4 o[4];
            attn_qtile<64, 10, KP, true>(qf, Kl + trel * KP, Vl + trel * KP, I.lane, 0.125f, tq, pos0 + trel, 0, slope, sink, o);
            bf16_t* yrow = Y + (size_t)(b * SEQ + tq) * 512 + h * 64;
#pragma unroll
            for (int dt = 0; dt < 4; ++dt) { u32x2 w; w.x = cvt_pk_bf16(o[dt][0], o[dt][1]); w.y = cvt_pk_bf16(o[dt][2], o[dt][3]); *(u32x2*)(yrow + dt * 16 + fq * 4) = w; }
        }
    }
    __syncthreads();
}

__device__ __forceinline__ void phase_mem(const KA& a, const Ctx& C) {
    const Ids I = get_ids();
    unsigned char* ws = a.ws();
    const bf16_t* P = (const bf16_t*)(ws + WS_P); const bf16_t* KVM = (const bf16_t*)(ws + WS_KVM); bf16_t* Y = (bf16_t*)(ws + WS_YB2);
    constexpr int KP = 272, ROWS = 256;
    LAS unsigned char* Kl = C.lds; LAS unsigned char* Vl = C.lds + ROWS * KP;
    for (int u = C.bid; u < BATCH * 4 * 8; u += C.G) {
        const int qb = u & 7, h = (u >> 3) & 3, b = u >> 5;
        __syncthreads();
        for (int i = I.tid; i < ROWS * 16 * 2; i += 512) { const int which = i >= ROWS * 16; const int j = which ? i - ROWS * 16 : i; const int r = j >> 4, ch = j & 15;
            const u32x4 v = *(const u32x4*)(KVM + (size_t)(b * MEM_LEN + r) * 1024 + which * 512 + h * 128 + ch * 8);
            *(LAS u32x4*)((which ? Vl : Kl) + r * KP + ch * 16) = v; }
        __syncthreads();
        const int fr = I.lane & 15, fq = I.lane >> 4;
#pragma unroll 1
        for (int qt = 0; qt < 4; ++qt) {
            const int tq = qb * 512 + I.wave * 64 + qt * 16 + fr;
            const bf16_t* qrow = P + (size_t)(b * SEQ + tq) * 3072 + MEMQ_OFF + h * 128;
            bf16x8 qf[4];
#pragma unroll
            for (int ks = 0; ks < 4; ++ks) qf[ks] = *(const bf16x8*)(qrow + ks * 32 + fq * 8);
            f32x4 o[8];
            attn_qtile<128, 16, KP, false>(qf, Kl, Vl, I.lane, 0.08838834764831845f, 0, 0, 0, 0.f, 0.f, o);
            bf16_t* yrow = Y + (size_t)(b * SEQ + tq) * 512 + h * 128;
#pragma unroll
            for (int dt = 0; dt < 8; ++dt) { u32x2 w; w.x = cvt_pk_bf16(o[dt][0], o[dt][1]); w.y = cvt_pk_bf16(o[dt][2], o[dt][3]); *(u32x2*)(yrow + dt * 16 + fq * 4) = w; }
        }
    }
    __syncthreads();
}
__device__ __forceinline__ float dpp_add16(float x) {
    x += __builtin_bit_cast(float, __builtin_amdgcn_update_dpp(0, __builtin_bit_cast(int, x), 0xB1, 0xF, 0xF, true));
    x += __builtin_bit_cast(float, __builtin_amdgcn_update_dpp(0, __builtin_bit_cast(int, x), 0x4E, 0xF, 0xF, true));
    x += __builtin_bit_cast(float, __builtin_amdgcn_update_dpp(0, __builtin_bit_cast(int, x), 0x124, 0xF, 0xF, true));
    x += __builtin_bit_cast(float, __builtin_amdgcn_update_dpp(0, __builtin_bit_cast(int, x), 0x128, 0xF, 0xF, true));
    return x;
}
struct RwRaw { u32x2 r, kr, as, v; f32x4 w; };
struct RwOps { f32x4 w4, a4, b4, k4, r4; float vv; };
__device__ __forceinline__ void phase_rwkv(const KA& a, const Ctx& C) {
    const Ids I = get_ids();
    unsigned char* ws = a.ws();
    const bf16_t* R = (const bf16_t*)(ws + WS_R); const bf16_t* KR = (const bf16_t*)(ws + WS_KR); const bf16_t* V = (const bf16_t*)(ws + WS_V); const bf16_t* ASIG = (const bf16_t*)(ws + WS_ASIG);
    const float* W = (const float*)(ws + WS_W); float* YRAW = (float*)(ws + WS_YRAW); float* BONUS = (float*)(ws + MS_BONUS);
    const float* k_k = a.in(12); const float* k_a = a.in(13); const float* r_k = a.in(14);
    constexpr int TC = 32, NCH = SEQ / TC;
    LAS float* SEQB = (LAS float*)C.lds;
    LAS float* VB = (LAS float*)(C.lds + 2 * TC * 5 * 64 * 4);
    LAS float* YO = VB + 2 * TC * 16;
    LAS float* DUMMY = YO + 2 * TC * 16;
    for (int item = C.bid; item < BATCH * 8 * 4; item += C.G) {
        const int rg = item & 3, h = (item >> 2) & 7, b = item >> 5;
        const int colh = h * 64; const size_t row0 = (size_t)b * SEQ;
        const bool loader = I.wave >= 4; const int lw = I.wave - 4;
        const int g4 = I.lane >> 4, q = I.lane & 15;
        f32x4 kkc = (f32x4){0.f, 0.f, 0.f, 0.f}, kac = kkc, rkc = kkc;
        if (loader) { kkc = *(const f32x4*)(k_k + colh + 4 * q); kac = *(const f32x4*)(k_a + colh + 4 * q); rkc = *(const f32x4*)(r_k + colh + 4 * q); }
        f32x2 s01 = (f32x2){0.f, 0.f}, s23 = s01;
        const int crow = I.tid >> 4, kq = I.tid & 15;
        RwRaw cur[2], nxt[2];
#define RW_LOAD(cn, raw) do { _Pragma("unroll") for (int j = 0; j < 2; ++j) { const size_t m = row0 + (size_t)(cn) * TC + lw * 8 + j * 4 + g4; const size_t o = m * 512 + colh + 4 * q; \
            raw[j].r = *(const u32x2*)(R + o); raw[j].kr = *(const u32x2*)(KR + o); raw[j].as = *(const u32x2*)(ASIG + o); raw[j].w = *(const f32x4*)(W + o); \
            raw[j].v = *(const u32x2*)(V + m * 512 + colh + rg * 16 + 4 * (q & 3)); } } while (0)
        if (loader) RW_LOAD(0, cur);
        __syncthreads();
#pragma unroll 1
        for (int c = -1; c < NCH; ++c) {
            if (loader) {
                if (c + 2 < NCH) RW_LOAD(c + 2, nxt);
                if (c + 1 < NCH) {
                    const int buf = (c + 1) & 1;
#pragma unroll
                    for (int j = 0; j < 2; ++j) { const int tl = lw * 8 + j * 4 + g4;
                        const f32x4 r = (f32x4){bf_lo(cur[j].r.x), bf_hi(cur[j].r.x), bf_lo(cur[j].r.y), bf_hi(cur[j].r.y)};
                        const f32x4 kr = (f32x4){bf_lo(cur[j].kr.x), bf_hi(cur[j].kr.x), bf_lo(cur[j].kr.y), bf_hi(cur[j].kr.y)};
                        const f32x4 as = (f32x4){bf_lo(cur[j].as.x), bf_hi(cur[j].as.x), bf_lo(cur[j].as.y), bf_hi(cur[j].as.y)};
                        const f32x4 kkv = kr * kkc;
                        const float n2 = dpp_add16((kkv[0] * kkv[0] + kkv[1] * kkv[1]) + (kkv[2] * kkv[2] + kkv[3] * kkv[3]));
                        const f32x4 kkn = kkv * (1.0f / fmaxf(sqrtf(n2), 1e-12f));
                        const f32x4 kmod = kr * ((as - 1.0f) * kac + 1.0f);
                        LAS float* d = SEQB + ((buf * TC + tl) * 5) * 64 + 4 * q;
                        *(LAS f32x4*)(d) = cur[j].w; *(LAS f32x4*)(d + 64) = -kkn; *(LAS f32x4*)(d + 128) = kkn * as; *(LAS f32x4*)(d + 192) = kmod; *(LAS f32x4*)(d + 256) = r;
                        if (q < 4) *(LAS f32x4*)(VB + (buf * TC + tl) * 16 + 4 * q) = (f32x4){bf_lo(cur[j].v.x), bf_hi(cur[j].v.x), bf_lo(cur[j].v.y), bf_hi(cur[j].v.y)};
                        if (rg == 0) { const f32x4 t = r * kmod * rkc; const float bs = dpp_add16((t[0] + t[1]) + (t[2] + t[3])); if (q == 0) BONUS[(row0 + (size_t)(c + 1) * TC + tl) * 8 + h] = bs; } }
                }
                if (c >= 1) {
                    const int buf = (c - 1) & 1; const int lt = I.tid - 256;
#pragma unroll
                    for (int i = 0; i < 2; ++i) { const int e = lt + 256 * i; const int tl = e >> 4, rr = e & 15;
                        YRAW[(row0 + (size_t)(c - 1) * TC + tl) * 512 + colh + rg * 16 + rr] = YO[(buf * TC + tl) * 16 + rr]; }
                }
                cur[0] = nxt[0]; cur[1] = nxt[1];
            } else if (c >= 0) {
                const int buf = c & 1;
                const LAS float* dbase = SEQB + (buf * TC * 5) * 64 + kq * 4; const LAS float* vbase = VB + buf * TC * 16 + crow;
                LAS float* ybase = (kq == 0) ? (YO + buf * TC * 16 + crow) : (DUMMY + I.tid);
#define RW_OPS(o, tl) do { const LAS float* d = dbase + (tl) * 320; o.w4 = *(const LAS f32x4*)(d); o.a4 = *(const LAS f32x4*)(d + 64); o.b4 = *(const LAS f32x4*)(d + 128); o.k4 = *(const LAS f32x4*)(d + 192); o.r4 = *(const LAS f32x4*)(d + 256); o.vv = vbase[(tl) * 16]; } while (0)
                RwOps oc, on; RW_OPS(oc, 0);
#pragma unroll
                for (int tl = 0; tl < TC; ++tl) {
                    if (tl + 1 < TC) RW_OPS(on, tl + 1);
                    const f32x2 vv2 = (f32x2){oc.vv, oc.vv};
                    f32x2 pa = s01 * (f32x2){oc.a4[0], oc.a4[1]}; pa = s23 * (f32x2){oc.a4[2], oc.a4[3]} + pa;
                    float sa = pa[0] + pa[1];
                    const f32x2 t01 = s01 * (f32x2){oc.w4[0], oc.w4[1]} + vv2 * (f32x2){oc.k4[0], oc.k4[1]}, t23 = s23 * (f32x2){oc.w4[2], oc.w4[3]} + vv2 * (f32x2){oc.k4[2], oc.k4[3]};
                    sa = dpp_add16(sa);
                    const f32x2 sa2 = (f32x2){sa, sa};
                    s01 = sa2 * (f32x2){oc.b4[0], oc.b4[1]} + t01; s23 = sa2 * (f32x2){oc.b4[2], oc.b4[3]} + t23;
                    f32x2 py = s01 * (f32x2){oc.r4[0], oc.r4[1]}; py = s23 * (f32x2){oc.r4[2], oc.r4[3]} + py;
                    float y = py[0] + py[1];
                    y = dpp_add16(y);
                    ybase[tl * 16] = y;
                    oc = on;
                }
#undef RW_OPS
            }
            __syncthreads();
        }
#undef RW_LOAD
        if (loader) {
            const int buf = (NCH - 1) & 1; const int lt = I.tid - 256;
#pragma unroll
            for (int i = 0; i < 2; ++i) { const int e = lt + 256 * i; const int tl = e >> 4, rr = e & 15;
                YRAW[(row0 + (size_t)(NCH - 1) * TC + tl) * 512 + colh + rg * 16 + rr] = YO[(buf * TC + tl) * 16 + rr]; }
        }
    }
    __syncthreads();
}

__device__ __forceinline__ void phase_gn(const KA& a, const Ctx& C) {
    const Ids I = get_ids();
    unsigned char* ws = a.ws();
    const float* YRAW = (const float*)(ws + WS_YRAW); const float* BONUS = (const float*)(ws + MS_BONUS); const bf16_t* V = (const bf16_t*)(ws + WS_V);
    bf16_t* Y0 = (bf16_t*)(ws + WS_YB0);
    const float* lw = a.in(15); const float* lb = a.in(16);
    const int gw = C.bid * NWAVES + I.wave, NGW = C.G * NWAVES;
    float lwv[8], lbv[8];
#pragma unroll
    for (int h = 0; h < 8; ++h) { lwv[h] = lw[h * 64 + I.lane]; lbv[h] = lb[h * 64 + I.lane]; }
    for (int m = gw; m < NTOK; m += NGW) {
        const size_t o = (size_t)m * 512 + I.lane;
        float y[8], s1[8], vv[8], gg[8], bn[8];
#pragma unroll
        for (int h = 0; h < 8; ++h) { y[h] = YRAW[o + h * 64]; vv[h] = bf1(V[o + h * 64]); gg[h] = bf1(Y0[o + h * 64]); bn[h] = BONUS[m * 8 + h]; s1[h] = y[h]; }
#pragma unroll
        for (int of = 1; of < 64; of <<= 1) {
#pragma unroll
            for (int h = 0; h < 8; ++h) s1[h] += __shfl_xor(s1[h], of); }
        float d[8], s2[8];
#pragma unroll
        for (int h = 0; h < 8; ++h) { d[h] = y[h] - s1[h] * (1.0f / 64.0f); s2[h] = d[h] * d[h]; }
#pragma unroll
        for (int of = 1; of < 64; of <<= 1) {
#pragma unroll
            for (int h = 0; h < 8; ++h) s2[h] += __shfl_xor(s2[h], of); }
#pragma unroll
        for (int h = 0; h < 8; ++h) { float yn = d[h] * (1.0f / sqrtf(s2[h] * (1.0f / 64.0f) + 64e-5f)) * lwv[h] + lbv[h]; yn += bn[h] * vv[h]; Y0[o + h * 64] = (bf16_t)f2bf(yn * gg[h]); }
    }
}

__device__ __forceinline__ void phase_router(const KA& a, const Ctx& C) {
    const Ids I = get_ids();
    unsigned char* ws = a.ws();
    const float* H1 = a.out(); bf16_t* HB = (bf16_t*)(ws + WS_HB); const bf16_t* WRT = (const bf16_t*)(ws + MS_WRT); const float* b_router = a.in(24);
    float* RSTD2 = (float*)(ws + MS_RSTD2); int* TOKE = (int*)(ws + MS_TOKE); int* TOKPOS = (int*)(ws + MS_TOKPOS); float* TOKG = (float*)(ws + MS_TOKG);
    unsigned* cnt = (unsigned*)(ws + WS_CTL) + CW_CNT;
    constexpr int WP = 2080;
    LAS unsigned char* WL = C.lds;
    LAS float* LG = (LAS float*)(C.lds + 64 * WP + I.wave * 2304);
    LAS unsigned* lcnt = (LAS unsigned*)(C.lds + 64 * WP + 8 * 2304);
    const int gw = C.bid * NWAVES + I.wave, NGW = C.G * NWAVES;
    const int fr = I.lane & 15, fq = I.lane >> 4;
    for (int i = I.tid; i < 64 * 128; i += 512) { const int row = i >> 7, ch = i & 127; *(LAS u32x4*)(WL + row * WP + ch * 16) = *(const u32x4*)(WRT + (size_t)row * 1024 + ch * 8); }
    for (int grp0 = C.bid * NWAVES; grp0 < NTOK / 16; grp0 += NGW) {
        const int grp = grp0 + I.wave; const bool live = grp < NTOK / 16;
        if (I.tid < 64) lcnt[I.tid] = 0u;
        __syncthreads();
        const int m = (live ? grp : 0) * 16 + fr;
        const float* hrow = H1 + (size_t)m * 1024;
        f32x4 acc0 = (f32x4){0.f, 0.f, 0.f, 0.f}, acc1 = acc0; float ss = 0.f;
        f32x4 xa[8], xb[8];
#define RT_LOADX(X, g) do { _Pragma("unroll") for (int s = 0; s < 4; ++s) { const float* _p = hrow + ((g) * 4 + s) * 32 + fq * 8; X[2 * s] = *(const f32x4*)_p; X[2 * s + 1] = *(const f32x4*)(_p + 4); } } while (0)
#define RT_COMP(X, g) do { _Pragma("unroll") for (int s = 0; s < 4; ++s) { const int k0 = ((g) * 4 + s) * 32 + fq * 8; const f32x4 x0 = X[2 * s], x1 = X[2 * s + 1]; \
            ss += (x0[0] * x0[0] + x0[1] * x0[1]) + (x0[2] * x0[2] + x0[3] * x0[3]) + (x1[0] * x1[0] + x1[1] * x1[1]) + (x1[2] * x1[2] + x1[3] * x1[3]); \
            u32x4 hi; hi.x = pk2(x0[0], x0[1]); hi.y = pk2(x0[2], x0[3]); hi.z = pk2(x1[0], x1[1]); hi.w = pk2(x1[2], x1[3]); \
            { u32x2 q8; q8.x = cvt_fp8x4(x0[0], x0[1], x0[2], x0[3]); q8.y = cvt_fp8x4(x1[0], x1[1], x1[2], x1[3]); *(u32x2*)((unsigned char*)HB + (size_t)m * 1024 + k0) = q8; } \
            u32x4 lo; lo.x = pk2(x0[0] - bf_lo(hi.x), x0[1] - bf_hi(hi.x)); lo.y = pk2(x0[2] - bf_lo(hi.y), x0[3] - bf_hi(hi.y)); lo.z = pk2(x1[0] - bf_lo(hi.z), x1[1] - bf_hi(hi.z)); lo.w = pk2(x1[2] - bf_lo(hi.w), x1[3] - bf_hi(hi.w)); \
            const bf16x8 ah = __builtin_bit_cast(bf16x8, hi), al = __builtin_bit_cast(bf16x8, lo); \
            LAS const unsigned char* _w = WL + fr * WP + k0 * 2; \
            const bf16x8 wh0 = *(const LAS bf16x8*)_w, wh1 = *(const LAS bf16x8*)(_w + 16 * WP), wl0 = *(const LAS bf16x8*)(_w + 32 * WP), wl1 = *(const LAS bf16x8*)(_w + 48 * WP); \
            acc0 = __builtin_amdgcn_mfma_f32_16x16x32_bf16(ah, wh0, acc0, 0, 0, 0); acc0 = __builtin_amdgcn_mfma_f32_16x16x32_bf16(ah, wl0, acc0, 0, 0, 0); acc0 = __builtin_amdgcn_mfma_f32_16x16x32_bf16(al, wh0, acc0, 0, 0, 0); \
            acc1 = __builtin_amdgcn_mfma_f32_16x16x32_bf16(ah, wh1, acc1, 0, 0, 0); acc1 = __builtin_amdgcn_mfma_f32_16x16x32_bf16(ah, wl1, acc1, 0, 0, 0); acc1 = __builtin_amdgcn_mfma_f32_16x16x32_bf16(al, wh1, acc1, 0, 0, 0); } } while (0)
        RT_LOADX(xa, 0);
#pragma unroll 1
        for (int g = 0; g < 8; g += 2) { RT_LOADX(xb, g + 1); RT_COMP(xa, g); if (g + 2 < 8) RT_LOADX(xa, g + 2); RT_COMP(xb, g + 1); }
#undef RT_LOADX
#undef RT_COMP
        ss += __shfl_xor(ss, 16); ss += __shfl_xor(ss, 32);
        const float rstd = 1.0f / sqrtf(ss * (1.0f / 1024.0f) + 1e-5f);
#pragma unroll
        for (int r = 0; r < 4; ++r) { LG[(fq * 4 + r) * 36 + fr] = acc0[r]; LG[(fq * 4 + r) * 36 + 16 + fr] = acc1[r]; }
        LDS_WAIT(); asm volatile("" ::: "memory");
        int sel[4] = {0, 0, 0, 0}; unsigned lpos[4] = {0u, 0u, 0u, 0u};
        if (I.lane < 16 && live) {
            float lg[32];
#pragma unroll
            for (int e = 0; e < 32; ++e) lg[e] = LG[fr * 36 + e] * rstd + b_router[e];
            float sv[4];
#pragma unroll
            for (int j = 0; j < 4; ++j) { float best = -3.0e38f; int bi = 0;
#pragma unroll
                for (int e = 0; e < 32; ++e) { const bool take = lg[e] > best; best = take ? lg[e] : best; bi = take ? e : bi; }
                sel[j] = bi; sv[j] = best;
#pragma unroll
                for (int e = 0; e < 32; ++e) lg[e] = (e == bi) ? -3.0e38f : lg[e]; }
            const float e0 = 1.0f, e1 = fexp(sv[1] - sv[0]), e2 = fexp(sv[2] - sv[0]), e3 = fexp(sv[3] - sv[0]); const float inv = 1.0f / (e0 + e1 + e2 + e3);
            const float gt[4] = {e0 * inv, e1 * inv, e2 * inv, e3 * inv};
            RSTD2[m] = rstd;
#pragma unroll
            for (int j = 0; j < 4; ++j) { lpos[j] = __hip_atomic_fetch_add(lcnt + sel[j], 1u, __ATOMIC_RELAXED, __HIP_MEMORY_SCOPE_WORKGROUP); TOKE[m * 4 + j] = sel[j]; TOKG[m * 4 + j] = gt[j]; }
        }
        __syncthreads();
        if (I.tid < 32) { const unsigned n = lcnt[I.tid]; lcnt[32 + I.tid] = n ? atomicAdd(cnt + I.tid * 64, n) : 0u; }
        __syncthreads();
        if (I.lane < 16 && live) {
#pragma unroll
            for (int j = 0; j < 4; ++j) TOKPOS[m * 4 + j] = (int)(lcnt[32 + sel[j]] + lpos[j]);
        }
        __syncthreads();
    }
}

__device__ __forceinline__ void phase_slots(const KA& a, const Ctx& C) {
    const Ids I = get_ids();
    unsigned char* ws = a.ws();
    const unsigned* cnt = (const unsigned*)(ws + WS_CTL) + CW_CNT; unsigned* ctl = (unsigned*)(ws + WS_CTL);
    const float* RSTD2 = (const float*)(ws + MS_RSTD2); const int* TOKE = (const int*)(ws + MS_TOKE); const int* TOKPOS = (const int*)(ws + MS_TOKPOS); const float* TOKG = (const float*)(ws + MS_TOKG);
    int* TOKSLOT = (int*)(ws + MS_TOKSLOT); int* SLOTTOK = (int*)(ws + MS_SLOTTOK); float* SLOTG = (float*)(ws + MS_SLOTG); float* SLOTRS = (float*)(ws + MS_SLOTRS); int* TILEE = (int*)(ws + MS_TILEE);
    LAS int* off = (LAS int*)C.lds; LAS int* cn = off + 40;
    __syncthreads();
    if (I.tid == 0) { int o = 0; for (int e = 0; e < NEXP; ++e) { const int c = (int)__hip_atomic_load(cnt + e * 64, __ATOMIC_RELAXED, __HIP_MEMORY_SCOPE_AGENT); off[e] = o; cn[e] = c; o += ((c + 255) >> 8) << 8; } off[NEXP] = o; }
    __syncthreads();
    if (C.bid == 0) {
        if (I.tid == 0) ctl[CW_NTILES] = (unsigned)(off[NEXP] >> 8);
        for (int e = 0; e < NEXP; ++e) for (int t = (off[e] >> 8) + I.tid; t < (off[e + 1] >> 8); t += 512) TILEE[t] = e;
    }
    for (int i = C.bid * 512 + I.tid; i < NTOK * 4; i += C.G * 512) { const int m = i >> 2; const int e = TOKE[i]; const int slot = off[e] + TOKPOS[i];
        TOKSLOT[i] = slot; SLOTTOK[slot] = m; SLOTG[slot] = TOKG[i]; SLOTRS[slot] = RSTD2[m]; }
    for (int e = 0; e < NEXP; ++e) for (int s = off[e] + cn[e] + C.bid * 512 + I.tid; s < off[e + 1]; s += C.G * 512) { SLOTTOK[s] = 0; SLOTG[s] = 0.f; SLOTRS[s] = 0.f; }
    __syncthreads();
}

__device__ __forceinline__ void phase_final(const KA& a, const Ctx& C) {
    const Ids I = get_ids();
    unsigned char* ws = a.ws();
    float* OUT = a.out(); const bf16_t* YS = (const bf16_t*)(ws + WS_YSLOT); const int* TOKSLOT = (const int*)(ws + MS_TOKSLOT); const float* fw = a.in(29);
    const int gw = C.bid * NWAVES + I.wave, NGW = C.G * NWAVES;
    const f32x4* fwp = (const f32x4*)fw + I.lane; f32x4 fwv[4];
#pragma unroll
    for (int j = 0; j < 4; ++j) fwv[j] = fwp[64 * j];
    f32x4 v[4], vn[4]; unsigned ys[4][4], ysn[4][4]; int sl[4], sln[4];
#define FIN_LOAD_A(mm, V, S) do { const f32x4* _o = (const f32x4*)(OUT + (size_t)(mm) * 1024) + I.lane; _Pragma("unroll") for (int j = 0; j < 4; ++j) { V[j] = _o[64 * j]; S[j] = TOKSLOT[(mm) * 4 + j]; } } while (0)
#define FIN_LOAD_B(S, Y) do { _Pragma("unroll") for (int s = 0; s < 4; ++s) { const unsigned* _y = (const unsigned*)((const unsigned char*)YS + (size_t)S[s] * 1024) + I.lane; _Pragma("unroll") for (int j = 0; j < 4; ++j) Y[s][j] = _y[64 * j]; } } while (0)
    if (gw < NTOK) { FIN_LOAD_A(gw, v, sl); FIN_LOAD_B(sl, ys); }
    if (gw + NGW < NTOK) FIN_LOAD_A(gw + NGW, vn, sln);
    for (int m = gw; m < NTOK; m += NGW) {
        f32x4* orow = (f32x4*)(OUT + (size_t)m * 1024) + I.lane;
        const bool has1 = m + NGW < NTOK, has2 = m + 2 * NGW < NTOK;
        if (has1) FIN_LOAD_B(sln, ysn);
#pragma unroll
        for (int s = 0; s < 4; ++s)
#pragma unroll
            for (int j = 0; j < 4; ++j) { const int y = (int)ys[s][j]; v[j][0] += __builtin_amdgcn_cvt_f32_fp8(y, 0); v[j][1] += __builtin_amdgcn_cvt_f32_fp8(y, 1); v[j][2] += __builtin_amdgcn_cvt_f32_fp8(y, 2); v[j][3] += __builtin_amdgcn_cvt_f32_fp8(y, 3); }
        float ss = 0.f;
#pragma unroll
        for (int j = 0; j < 4; ++j) ss += (v[j][0] * v[j][0] + v[j][1] * v[j][1]) + (v[j][2] * v[j][2] + v[j][3] * v[j][3]);
        const float rstd = 1.0f / sqrtf(wave_sum(ss) * (1.0f / 1024.0f) + 1e-5f);
#pragma unroll
        for (int j = 0; j < 4; ++j) __builtin_nontemporal_store(v[j] * rstd * fwv[j], orow + 64 * j);
#pragma unroll
        for (int j = 0; j < 4; ++j) { v[j] = vn[j]; sl[j] = sln[j];
#pragma unroll
            for (int s = 0; s < 4; ++s) ys[s][j] = ysn[s][j]; }
        if (has2) FIN_LOAD_A(m + 2 * NGW, vn, sln);
    }
#undef FIN_LOAD_A
#undef FIN_LOAD_B
}

constexpr size_t WS_RWT = WS_RWT0;
constexpr size_t WS_RWS = 936 * MiB;
constexpr size_t WS_GC = WS_MISC + 8 * MiB;
constexpr int RT_TA = 0, RT_TL = 1, RT_BT = 2, RT_KT = 3, RT_RT = 4, RT_VT = 5;
__device__ __forceinline__ int toff(int r, int c16) { return r * 128 + ((c16 ^ ((r >> 1) & 7)) << 4); }
__device__ __forceinline__ bf16x8 frag_row(LAS const unsigned char* t, int row, int ks, int fq) { return *(const LAS bf16x8*)(t + toff(row, 4 * ks + fq)); }
__device__ __forceinline__ bf16x8 frag_row_slots(LAS const unsigned char* t, int row, int js, int fq) {
    const u32x2 lo = *(const LAS u32x2*)(t + toff(row, 4 * js + (fq >> 1)) + (fq & 1) * 8), hi = *(const LAS u32x2*)(t + toff(row, 4 * js + 2 + (fq >> 1)) + (fq & 1) * 8);
    u32x4 w; w.x = lo.x; w.y = lo.y; w.z = hi.x; w.w = hi.y; return __builtin_bit_cast(bf16x8, w);
}
__device__ __forceinline__ bf16x8 frag_tr(LAS const unsigned char* t, int ct, int js, int lane) {
    const int fq = lane >> 4, i = lane & 15, q = i >> 2, p = i & 3;
    const int r0 = 32 * js + 4 * fq + q, r1 = r0 + 16; const int c16 = 2 * ct + (p >> 1), bo = (p & 1) * 8;
    const s16x4 lo = vtr(t + toff(r0, c16) + bo), hi = vtr(t + toff(r1, c16) + bo);
    bf16x8 f; f[0] = lo[0]; f[1] = lo[1]; f[2] = lo[2]; f[3] = lo[3]; f[4] = hi[0]; f[5] = hi[1]; f[6] = hi[2]; f[7] = hi[3]; return f;
}
__device__ __forceinline__ float dpp_add8(float x) {
    x += __builtin_bit_cast(float, __builtin_amdgcn_update_dpp(0, __builtin_bit_cast(int, x), 0xB1, 0xF, 0xF, true));
    x += __builtin_bit_cast(float, __builtin_amdgcn_update_dpp(0, __builtin_bit_cast(int, x), 0x4E, 0xF, 0xF, true));
    x += __builtin_bit_cast(float, __builtin_amdgcn_update_dpp(0, __builtin_bit_cast(int, x), 0x141, 0xF, 0xF, true));
    return x;
}
#define MFMA16(a, b, c) __builtin_amdgcn_mfma_f32_16x16x32_bf16(a, b, c, 0, 0, 0)

struct RcRaw { u32x4 kr, as, r, v; f32x4 lw0, lw1, kk0, kk1, ka0, ka1, rk0, rk1; };
#define RC_LBAR() do { asm volatile("s_waitcnt lgkmcnt(0)" ::: "memory"); __builtin_amdgcn_s_barrier(); asm volatile("" ::: "memory"); } while (0)
__device__ __forceinline__ void phase_rwkv_pre(const KA& a, const Ctx& C) {
    const Ids I = get_ids();
    unsigned char* ws = a.ws();
    const bf16_t* R = (const bf16_t*)(ws + WS_R); const bf16_t* KR = (const bf16_t*)(ws + WS_KR); const bf16_t* V = (const bf16_t*)(ws + WS_V); const bf16_t* ASIG = (const bf16_t*)(ws + WS_ASIG);
    const float* LW = (const float*)(ws + WS_W); float* BONUS = (float*)(ws + MS_BONUS); float* GC = (float*)(ws + WS_GC);
    unsigned char* RWT = ws + WS_RWT; unsigned char* SCR = ws + WS_RWS + (size_t)C.bid * (8 * 40960);
    const float* k_k = a.in(12); const float* k_a = a.in(13); const float* r_k = a.in(14);
    LAS unsigned char* lds = C.lds;
    const int tid = I.tid, lane = I.lane, wave = I.wave, fr = lane & 15, fq = lane >> 4;
    const int ri = tid >> 3, cg = tid & 7;
    for (int grp = C.bid; grp < 512; grp += C.G) {
        RcRaw cur, nxt;
#define RC_LOAD(task, raw) do { const int _bh = (task) >> 6, _ch = (task) & 63; const size_t _m = (size_t)(_bh >> 3) * SEQ + _ch * 64 + ri; const size_t _o = _m * 512 + (_bh & 7) * 64 + 8 * cg; \
        raw.kr = *(const u32x4*)(KR + _o); raw.as = *(const u32x4*)(ASIG + _o); raw.r = *(const u32x4*)(R + _o); raw.v = *(const u32x4*)(V + _o); raw.lw0 = *(const f32x4*)(LW + _o); raw.lw1 = *(const f32x4*)(LW + _o + 4); const int _hc = (_bh & 7) * 64 + 8 * cg; \
        raw.kk0 = *(const f32x4*)(k_k + _hc); raw.kk1 = *(const f32x4*)(k_k + _hc + 4); raw.ka0 = *(const f32x4*)(k_a + _hc); raw.ka1 = *(const f32x4*)(k_a + _hc + 4); raw.rk0 = *(const f32x4*)(r_k + _hc); raw.rk1 = *(const f32x4*)(r_k + _hc + 4); } while (0)
        RC_LOAD(grp * 8, cur);
#pragma unroll 1
        for (int tk = 0; tk < 8; ++tk) {
            const int task = grp * 8 + tk; const int bh = task >> 6, ch = task & 63, h = bh & 7; const size_t m = (size_t)(bh >> 3) * SEQ + ch * 64 + ri;
            if (tk + 1 < 8) RC_LOAD(task + 1, nxt);
            LAS float* LWB = (LAS float*)lds;
            LAS float* SCAN = (LAS float*)(lds + 40960);
            LAS unsigned char* AT = lds + 16384; LAS unsigned char* BT = lds + 24576; LAS unsigned char* KT = lds + 32768;
            unsigned char* gt = RWT + (size_t)task * (6 * 8192); unsigned char* sc = SCR + tk * 40960;
            float kr[8], as[8], rr[8], lw[8];
            { const u32x4 x = cur.kr, y = cur.as, z = cur.r;
              kr[0] = bf_lo(x.x); kr[1] = bf_hi(x.x); kr[2] = bf_lo(x.y); kr[3] = bf_hi(x.y); kr[4] = bf_lo(x.z); kr[5] = bf_hi(x.z); kr[6] = bf_lo(x.w); kr[7] = bf_hi(x.w);
              as[0] = bf_lo(y.x); as[1] = bf_hi(y.x); as[2] = bf_lo(y.y); as[3] = bf_hi(y.y); as[4] = bf_lo(y.z); as[5] = bf_hi(y.z); as[6] = bf_lo(y.w); as[7] = bf_hi(y.w);
              rr[0] = bf_lo(z.x); rr[1] = bf_hi(z.x); rr[2] = bf_lo(z.y); rr[3] = bf_hi(z.y); rr[4] = bf_lo(z.z); rr[5] = bf_hi(z.z); rr[6] = bf_lo(z.w); rr[7] = bf_hi(z.w);
              lw[0] = cur.lw0[0]; lw[1] = cur.lw0[1]; lw[2] = cur.lw0[2]; lw[3] = cur.lw0[3]; lw[4] = cur.lw1[0]; lw[5] = cur.lw1[1]; lw[6] = cur.lw1[2]; lw[7] = cur.lw1[3]; }
            const f32x4 kk0 = cur.kk0, kk1 = cur.kk1, ka0 = cur.ka0, ka1 = cur.ka1, rk0 = cur.rk0, rk1 = cur.rk1;
            float kkn[8], km[8]; float n2 = 0.f, bs = 0.f;
#pragma unroll
            for (int j = 0; j < 8; ++j) { const float kkc = j < 4 ? kk0[j & 3] : kk1[j & 3], kac = j < 4 ? ka0[j & 3] : ka1[j & 3], rkc = j < 4 ? rk0[j & 3] : rk1[j & 3];
                kkn[j] = kr[j] * kkc; n2 += kkn[j] * kkn[j]; km[j] = kr[j] * (1.0f + (as[j] - 1.0f) * kac); bs += rr[j] * km[j] * rkc; }
            n2 = dpp_add8(n2); bs = dpp_add8(bs);
            const float inv = 1.0f / fmaxf(sqrtf(n2), 1e-12f);
            if (cg == 0) BONUS[m * 8 + h] = bs;
            *(LAS f32x4*)(LWB + ri * 64 + 8 * cg) = cur.lw0; *(LAS f32x4*)(LWB + ri * 64 + 8 * cg + 4) = cur.lw1;
            RC_LBAR();
            { const int c = tid & 63, rb = tid >> 6; float p[8]; float run = 0.f;
#pragma unroll
              for (int j = 0; j < 8; ++j) { run += LWB[(8 * rb + j) * 64 + c]; p[j] = run; }
              SCAN[rb * 64 + c] = run;
              RC_LBAR();
              float off = 0.f;
#pragma unroll
              for (int q = 0; q < 8; ++q) off += (q < rb) ? SCAN[q * 64 + c] : 0.f;
#pragma unroll
              for (int j = 0; j < 8; ++j) LWB[(8 * rb + j) * 64 + c] = p[j] + off; }
            RC_LBAR();
            { const f32x4 g0 = *(const LAS f32x4*)(LWB + ri * 64 + 8 * cg), g1 = *(const LAS f32x4*)(LWB + ri * 64 + 8 * cg + 4);
              float at[8], bt[8], kt[8], rt[8];
#pragma unroll
              for (int j = 0; j < 8; ++j) { const float g = j < 4 ? g0[j & 3] : g1[j & 3]; const float eg = fexp(g), egi = fexp(-g), egp = fexp(g - lw[j]); const float kn = kkn[j] * inv;
                  at[j] = -kn * egp; bt[j] = kn * as[j] * egi; kt[j] = km[j] * egi; rt[j] = rr[j] * eg;
                  if (ri == 63) GC[(size_t)task * 64 + 8 * cg + j] = eg; }
              const int so = toff(ri, cg);
              u32x4 pa, pb, pk, pr; pa.x = pk2(at[0], at[1]); pa.y = pk2(at[2], at[3]); pa.z = pk2(at[4], at[5]); pa.w = pk2(at[6], at[7]);
              pb.x = pk2(bt[0], bt[1]); pb.y = pk2(bt[2], bt[3]); pb.z = pk2(bt[4], bt[5]); pb.w = pk2(bt[6], bt[7]);
              pk.x = pk2(kt[0], kt[1]); pk.y = pk2(kt[2], kt[3]); pk.z = pk2(kt[4], kt[5]); pk.w = pk2(kt[6], kt[7]);
              pr.x = pk2(rt[0], rt[1]); pr.y = pk2(rt[2], rt[3]); pr.z = pk2(rt[4], rt[5]); pr.w = pk2(rt[6], rt[7]);
              *(LAS u32x4*)(AT + so) = pa; *(LAS u32x4*)(BT + so) = pb; *(LAS u32x4*)(KT + so) = pk;
              *(u32x4*)(sc + 24576 + so) = pa; *(u32x4*)(gt + RT_BT * 8192 + so) = pb; *(u32x4*)(gt + RT_KT * 8192 + so) = pk; *(u32x4*)(gt + RT_RT * 8192 + so) = pr; *(u32x4*)(gt + RT_VT * 8192 + so) = cur.v; }
            RC_LBAR();
            {
              const int which = wave >> 2, it = wave & 3; LAS const unsigned char* XT = which ? KT : BT;
              const bf16x8 b0 = frag_row(AT, 16 * it + fr, 0, fq), b1 = frag_row(AT, 16 * it + fr, 1, fq);
#pragma unroll
              for (int jt = 0; jt < 4; ++jt) { f32x4 d = (f32x4){0.f, 0.f, 0.f, 0.f};
                  if (jt <= it) { d = MFMA16(frag_row(XT, 16 * jt + fr, 0, fq), b0, d); d = MFMA16(frag_row(XT, 16 * jt + fr, 1, fq), b1, d); }
                  const int i = 16 * it + fr, j0 = 16 * jt + 4 * fq;
#pragma unroll
                  for (int r = 0; r < 4; ++r) d[r] = (j0 + r < i) ? d[r] : 0.f;
                  if (which == 0) { u32x2 w; w.x = pk2(d[0], d[1]); w.y = pk2(d[2], d[3]); *(LAS u32x2*)(lds + 43008 + tk * 8192 + (i * 64 + j0) * 2) = w; }
                  else { u32x2 w; w.x = pk2(d[0], d[1]); w.y = pk2(d[2], d[3]); *(u32x2*)(sc + 16384 + toff(i, 2 * jt + (fq >> 1)) + (fq & 1) * 8) = w; } } }
            RC_LBAR();
            cur = nxt;
        }
#undef RC_LOAD
        __syncthreads();
        { int ln = lane; asm volatile("" : "+v"(ln));
          LAS unsigned char* L = lds + 43008 + wave * 8192;
          float t[64];
#pragma unroll
          for (int i = 0; i < 64; ++i) { float a0 = (ln == i) ? 1.0f : 0.f, a1 = 0.f, a2 = 0.f, a3 = 0.f;
#pragma unroll
              for (int jb = 0; jb < (i + 3) / 4; ++jb) { const u32x2 l4 = *(const LAS u32x2*)(L + (i * 64 + 4 * jb) * 2);
                  a0 += bf_lo(l4.x) * t[4 * jb]; if (4 * jb + 1 < i) a1 += bf_hi(l4.x) * t[4 * jb + 1]; if (4 * jb + 2 < i) a2 += bf_lo(l4.y) * t[4 * jb + 2]; if (4 * jb + 3 < i) a3 += bf_hi(l4.y) * t[4 * jb + 3]; }
              t[i] = (a0 + a1) + (a2 + a3); }
          LDS_WAIT(); asm volatile("" ::: "memory");
#pragma unroll
          for (int i = 0; i < 64; ++i) *(LAS bf16_t*)(L + toff(i, ln >> 3) + (ln & 7) * 2) = (bf16_t)f2bf(t[i]);
        }
        __syncthreads();
        { u32x4 nA, nK;
          { const unsigned char* sc = SCR; nA = *(const u32x4*)(sc + 24576 + tid * 16); nK = *(const u32x4*)(sc + 16384 + tid * 16); }
#pragma unroll 1
          for (int tk = 0; tk < 8; ++tk) {
            const int task = grp * 8 + tk; unsigned char* gt = RWT + (size_t)task * (6 * 8192);
            LAS unsigned char* TT = lds + 43008 + tk * 8192; LAS unsigned char* AT = lds + 8192; LAS unsigned char* LK = lds + 16384;
            *(LAS u32x4*)(AT + tid * 16) = nA; *(LAS u32x4*)(LK + tid * 16) = nK;
            if (tk + 1 < 8) { const unsigned char* sc = SCR + (tk + 1) * 40960; nA = *(const u32x4*)(sc + 24576 + tid * 16); nK = *(const u32x4*)(sc + 16384 + tid * 16); }
            RC_LBAR();
            { const int which = wave >> 2, it = wave & 3; LAS const unsigned char* X = which ? LK : AT;
              const bf16x8 b0 = frag_row_slots(TT, 16 * it + fr, 0, fq), b1 = frag_row_slots(TT, 16 * it + fr, 1, fq);
#pragma unroll
              for (int ct = 0; ct < 4; ++ct) { f32x4 d = (f32x4){0.f, 0.f, 0.f, 0.f};
                  d = MFMA16(frag_tr(X, ct, 0, lane), b0, d); d = MFMA16(frag_tr(X, ct, 1, lane), b1, d);
                  u32x2 w; w.x = pk2(d[0], d[1]); w.y = pk2(d[2], d[3]);
                  *(u32x2*)(gt + (which ? RT_TL : RT_TA) * 8192 + toff(16 * it + fr, 2 * ct + (fq >> 1)) + (fq & 1) * 8) = w; } }
            RC_LBAR();
          } }
        __syncthreads();
    }
}

struct RsStage { u32x4 t[6]; };
__device__ __forceinline__ void phase_rwkv_seq(const KA& a, const Ctx& C) {
    const Ids I = get_ids();
    unsigned char* ws = a.ws();
    const unsigned char* RWT = ws + WS_RWT; const float* GC = (const float*)(ws + WS_GC); const float* BONUS = (const float*)(ws + MS_BONUS);
    bf16_t* Y0 = (bf16_t*)(ws + WS_YB0);
    const float* lnw = a.in(15); const float* lnb = a.in(16);
    LAS unsigned char* lds = C.lds;
    const int tid0 = I.tid, lane0 = I.lane, wave = I.wave;
    const int tid = tid0, lane = lane0, fr = lane & 15, fq = lane >> 4;
#define RS_OPAQUE_IDS() int lane = lane0; asm volatile("" : "+v"(lane)); const int fr = lane & 15, fq = lane >> 4, tid = wave * 64 + lane; (void)tid; (void)fr; (void)fq
    LAS unsigned char* L_TA = lds; LAS unsigned char* L_TL = lds + 8192; LAS unsigned char* L_Z = lds + 12 * 8192;
    LAS float* L_GC = (LAS float*)(lds + 13 * 8192); LAS float* L_LN = (LAS float*)(lds + 13 * 8192 + 16384);
#define L_BT(bf) (lds + (2 + (bf)) * 8192)
#define L_KT(bf) (lds + (4 + (bf)) * 8192)
#define L_RT(bf) (lds + (6 + (bf)) * 8192)
#define L_VT(bf) (lds + (8 + (bf)) * 8192)
#define L_S(bf)  (lds + (10 + (bf)) * 8192)
#define RS_LOAD(st, chn) do { const unsigned char* _g = gt0 + (size_t)(chn) * (6 * 8192) + tid * 16; _Pragma("unroll") for (int _q = 0; _q < 6; ++_q) st.t[_q] = *(const u32x4*)(_g + _q * 8192); } while (0)
#define RS_WRITE4(st, bfn) do { *(LAS u32x4*)(L_BT(bfn) + tid * 16) = st.t[RT_BT]; *(LAS u32x4*)(L_KT(bfn) + tid * 16) = st.t[RT_KT]; *(LAS u32x4*)(L_RT(bfn) + tid * 16) = st.t[RT_RT]; *(LAS u32x4*)(L_VT(bfn) + tid * 16) = st.t[RT_VT]; } while (0)
#define RS_WRITE2(st) do { *(LAS u32x4*)(L_TA + tid * 16) = st.t[RT_TA]; *(LAS u32x4*)(L_TL + tid * 16) = st.t[RT_TL]; } while (0)
#define RS_BAR() do { asm volatile("s_waitcnt lgkmcnt(0)" ::: "memory"); __builtin_amdgcn_s_barrier(); asm volatile("" ::: "memory"); } while (0)
    for (int bh = C.bid; bh < BATCH * 8; bh += C.G) {
        const int h = bh & 7; const size_t row0 = (size_t)(bh >> 3) * SEQ;
        const unsigned char* gt0 = RWT + (size_t)bh * 64 * (6 * 8192);
        const float* gc0 = GC + (size_t)bh * 64 * 64;
        __syncthreads();
        RsStage sA, sB;
        RS_LOAD(sA, 0);
        *(LAS u32x4*)(L_S(0) + tid * 16) = (u32x4){0u, 0u, 0u, 0u};
        RS_WRITE4(sA, 0); RS_WRITE2(sA);
        RS_LOAD(sA, 1); RS_LOAD(sB, 2);
#pragma unroll
        for (int q = 0; q < 2; ++q) *(LAS f32x4*)(L_GC + (q * 512 + tid) * 4) = *(const f32x4*)(gc0 + (size_t)(q * 512 + tid) * 4);
        if (tid < 64) { L_LN[tid] = lnw[h * 64 + tid]; L_LN[64 + tid] = lnb[h * 64 + tid]; }
        if (wave < 4) {
            const int vt = wave;
            f32x4 sm[4];
#pragma unroll
            for (int kt = 0; kt < 4; ++kt) sm[kt] = (f32x4){0.f, 0.f, 0.f, 0.f};
            __syncthreads();
#define RS_SCHUNK(ch, SX) do { const int bf = (ch) & 1; RS_OPAQUE_IDS(); \
                RS_WRITE4(SX, bf ^ 1); \
                  \
                { const bf16x8 s0 = frag_row(L_S(bf), 16 * vt + fr, 0, fq), s1 = frag_row(L_S(bf), 16 * vt + fr, 1, fq); \
                  const bf16x8 v0 = frag_tr(L_VT(bf), vt, 0, lane), v1 = frag_tr(L_VT(bf), vt, 1, lane); \
                  _Pragma("unroll") for (int it = 0; it < 4; ++it) { f32x4 d = (f32x4){0.f, 0.f, 0.f, 0.f}; \
                      d = MFMA16(s0, frag_row(L_TA, 16 * it + fr, 0, fq), d); d = MFMA16(s1, frag_row(L_TA, 16 * it + fr, 1, fq), d); \
                      d = MFMA16(v0, frag_row_slots(L_TL, 16 * it + fr, 0, fq), d); d = MFMA16(v1, frag_row_slots(L_TL, 16 * it + fr, 1, fq), d); \
                      u32x2 w; w.x = pk2(d[0], d[1]); w.y = pk2(d[2], d[3]); \
                      *(LAS u32x2*)(L_Z + toff(16 * it + fr, 2 * vt + (fq >> 1)) + (fq & 1) * 8) = w; } } \
                RS_BAR();                                          \
                RS_WRITE2(SX); RS_LOAD(SX, (ch) + 3); \
                  \
                { const bf16x8 z0 = frag_tr(L_Z, vt, 0, lane), z1 = frag_tr(L_Z, vt, 1, lane), v0 = frag_tr(L_VT(bf), vt, 0, lane), v1 = frag_tr(L_VT(bf), vt, 1, lane); \
                  _Pragma("unroll") for (int kt = 0; kt < 4; ++kt) { f32x4 d = sm[kt]; \
                      d = MFMA16(frag_tr(L_BT(bf), kt, 0, lane), z0, d); d = MFMA16(frag_tr(L_BT(bf), kt, 1, lane), z1, d); \
                      d = MFMA16(frag_tr(L_KT(bf), kt, 0, lane), v0, d); d = MFMA16(frag_tr(L_KT(bf), kt, 1, lane), v1, d); \
                      d = d * *(const LAS f32x4*)(L_GC + (ch) * 64 + 16 * kt + 4 * fq); sm[kt] = d; \
                      u32x2 w; w.x = pk2(d[0], d[1]); w.y = pk2(d[2], d[3]); \
                      *(LAS u32x2*)(L_S(bf ^ 1) + toff(16 * vt + fr, 2 * kt + (fq >> 1)) + (fq & 1) * 8) = w; } } \
                RS_BAR();                                          \
            } while (0)
#pragma unroll 1
            for (int c2 = 0; c2 < 64; c2 += 2) { RS_SCHUNK(c2, sA); RS_SCHUNK(c2 + 1, sB); }
#undef RS_SCHUNK
        } else {
            const int it = wave - 4;
            u32x2 g8A[4], g8B[4]; float bonA, bonB;
#define RS_SMALL(chn, G8, BON) do { const size_t _m = row0 + (size_t)(chn) * 64 + 16 * it + fr; _Pragma("unroll") for (int _v = 0; _v < 4; ++_v) G8[_v] = *(const u32x2*)(Y0 + _m * 512 + h * 64 + 16 * _v + 4 * fq); BON = BONUS[_m * 8 + h]; } while (0)
            RS_SMALL(0, g8A, bonA);
            __syncthreads();
#define RS_YCHUNK(ch, SX, G8C, BONC, G8N, BONN) do { const int bf = (ch) & 1; RS_OPAQUE_IDS(); \
                RS_WRITE4(SX, bf ^ 1); RS_SMALL((ch) + 1, G8N, BONN); \
                  \
                const bf16x8 r0 = frag_row(L_RT(bf), 16 * it + fr, 0, fq), r1 = frag_row(L_RT(bf), 16 * it + fr, 1, fq); \
                u32x4 mbw[2], mkw[2]; \
                _Pragma("unroll") for (int jt = 0; jt < 4; ++jt) { f32x4 db = (f32x4){0.f, 0.f, 0.f, 0.f}, dk = db; \
                    if (jt <= it) { db = MFMA16(frag_row(L_BT(bf), 16 * jt + fr, 0, fq), r0, db); db = MFMA16(frag_row(L_BT(bf), 16 * jt + fr, 1, fq), r1, db); \
                                    dk = MFMA16(frag_row(L_KT(bf), 16 * jt + fr, 0, fq), r0, dk); dk = MFMA16(frag_row(L_KT(bf), 16 * jt + fr, 1, fq), r1, dk); } \
                    const int i = 16 * it + fr, j0 = 16 * jt + 4 * fq; \
                    _Pragma("unroll") for (int r = 0; r < 4; ++r) { const bool keep = (j0 + r <= i); db[r] = keep ? db[r] : 0.f; dk[r] = keep ? dk[r] : 0.f; } \
                    if (jt & 1) { mbw[jt >> 1].z = pk2(db[0], db[1]); mbw[jt >> 1].w = pk2(db[2], db[3]); mkw[jt >> 1].z = pk2(dk[0], dk[1]); mkw[jt >> 1].w = pk2(dk[2], dk[3]); } \
                    else        { mbw[jt >> 1].x = pk2(db[0], db[1]); mbw[jt >> 1].y = pk2(db[2], db[3]); mkw[jt >> 1].x = pk2(dk[0], dk[1]); mkw[jt >> 1].y = pk2(dk[2], dk[3]); } } \
                const bf16x8 mb0 = __builtin_bit_cast(bf16x8, mbw[0]), mb1 = __builtin_bit_cast(bf16x8, mbw[1]), mk0 = __builtin_bit_cast(bf16x8, mkw[0]), mk1 = __builtin_bit_cast(bf16x8, mkw[1]); \
                RS_BAR();                                          \
                RS_WRITE2(SX); RS_LOAD(SX, (ch) + 3); \
                  \
                { const size_t m = row0 + (size_t)(ch) * 64 + 16 * it + fr; bf16_t* yrow = Y0 + m * 512 + h * 64; \
                  f32x4 y[4]; float s1 = 0.f, s2 = 0.f; \
                  _Pragma("unroll") for (int vt = 0; vt < 4; ++vt) { f32x4 d = (f32x4){0.f, 0.f, 0.f, 0.f}; \
                      d = MFMA16(frag_row(L_S(bf), 16 * vt + fr, 0, fq), r0, d); d = MFMA16(frag_row(L_S(bf), 16 * vt + fr, 1, fq), r1, d); \
                      d = MFMA16(frag_tr(L_Z, vt, 0, lane), mb0, d); d = MFMA16(frag_tr(L_Z, vt, 1, lane), mb1, d); \
                      d = MFMA16(frag_tr(L_VT(bf), vt, 0, lane), mk0, d); d = MFMA16(frag_tr(L_VT(bf), vt, 1, lane), mk1, d); \
                      y[vt] = d; s1 += (d[0] + d[1]) + (d[2] + d[3]); s2 += (d[0] * d[0] + d[1] * d[1]) + (d[2] * d[2] + d[3] * d[3]); } \
                  s1 += __shfl_xor(s1, 16); s1 += __shfl_xor(s1, 32); s2 += __shfl_xor(s2, 16); s2 += __shfl_xor(s2, 32); \
                  const float mean = s1 * (1.0f / 64.0f); const float var = fmaxf(s2 * (1.0f / 64.0f) - mean * mean, 0.f); const float rstd = 1.0f / sqrtf(var + 64e-5f); \
                  _Pragma("unroll") for (int vt = 0; vt < 4; ++vt) { const u32x2 vv = *(const LAS u32x2*)(L_VT(bf) + toff(16 * it + fr, 2 * vt + (fq >> 1)) + (fq & 1) * 8); \
                      const float vf[4] = {bf_lo(vv.x), bf_hi(vv.x), bf_lo(vv.y), bf_hi(vv.y)}; const float gf[4] = {bf_lo(G8C[vt].x), bf_hi(G8C[vt].x), bf_lo(G8C[vt].y), bf_hi(G8C[vt].y)}; \
                      const f32x4 lw4 = *(const LAS f32x4*)(L_LN + 16 * vt + 4 * fq), lb4 = *(const LAS f32x4*)(L_LN + 64 + 16 * vt + 4 * fq); \
                      float o[4]; \
                      _Pragma("unroll") for (int r = 0; r < 4; ++r) o[r] = ((y[vt][r] - mean) * rstd * lw4[r] + lb4[r] + BONC * vf[r]) * gf[r]; \
                      u32x2 w; w.x = pk2(o[0], o[1]); w.y = pk2(o[2], o[3]); *(u32x2*)(yrow + 16 * vt + 4 * fq) = w; } } \
                RS_BAR();                                          \
            } while (0)
#pragma unroll 1
            for (int c2 = 0; c2 < 64; c2 += 2) { RS_YCHUNK(c2, sA, g8A, bonA, g8B, bonB); RS_YCHUNK(c2 + 1, sB, g8B, bonB, g8A, bonA); }
#undef RS_YCHUNK
#undef RS_SMALL
        }
    }
#undef RS_BAR
#undef RS_OPAQUE_IDS
#undef RS_LOAD
#undef RS_WRITE4
#undef RS_WRITE2
#undef L_BT
#undef L_KT
#undef L_RT
#undef L_VT
#undef L_S
    __syncthreads();
}

constexpr int N_PHASES = 14;
__global__ void __launch_bounds__(512, 2) mega(Args a_unused) {
    const KA a;
    extern __shared__ __attribute__((aligned(16))) unsigned char lds_raw[];
    cg::grid_group grid = cg::this_grid();
    Ctx C; C.lds = (LAS unsigned char*)lds_raw; C.G = gridDim.x; C.bid = blockIdx.x;
    const int lo = a.ph_lo(), hi = a.ph_hi();
#define ws (a.ws())
    volatile LAS unsigned* xst = (volatile LAS unsigned*)(C.lds + LDS_BYTES - 16);
    if (threadIdx.x < 4) xst[threadIdx.x] = 0u;
    __syncthreads();
    const XcdBarrier xbar = xcd_barrier_post((unsigned*)(ws + WS_CTL) + CW_BAR, xst);
#define IN(k) (lo <= (k) && (k) < hi)
#ifdef PROBE_A
#define STAMP(k) do { if (blockIdx.x == 0 && threadIdx.x == 0) ((unsigned long long*)(ws + WS_CTL + 4096))[k] = __builtin_amdgcn_s_memrealtime(); } while (0)
#else
#define STAMP(k) do { } while (0)
#endif
#define SEAM(k) do { if (IN(k) && IN((k) + 1)) { if (lo < 0) grid.sync(); else xcd_barrier(xbar); } STAMP((k) + 1); } while (0)
    STAMP(0);
    if (IN(0)) phase0(a, C);
    SEAM(0);
    if (IN(1)) {
#if G1_FP8
        { int KE = 512; asm volatile("" : "+s"(KE));
          DenseSched S{(const char*)(ws + WS_XN8), (const char*)(ws + WS_WBIG), NTOK / 256, 3072 / 256, KE, C.G, C.bid};
          EpiIn E{(bf16_t*)(ws + WS_P), (bf16_t*)(ws + WS_GATE), a.in(5), 1.0f, 1.0f / W8_SCALE};
          pg8::gemm_phase<EpiIn, DenseSched, false, true>(C.lds, KE, S, E); }
#else
        { DenseSched S{(const char*)(ws + WS_XN), (const char*)(ws + WS_WBIG), NTOK / 256, 3072 / 256, 1024, C.G, C.bid};
          EpiIn E{(bf16_t*)(ws + WS_P), (bf16_t*)(ws + WS_GATE), a.in(5)};
          pg8::gemm_phase<EpiIn, DenseSched, false>(C.lds, 1024, S, E); }
#endif
        if (C.G <= 96) {
          DenseSched S{(const char*)(ws + WS_MEMN), (const char*)(ws + WS_WMKV), NMEM / 256, 1024 / 256, 1024, C.G, C.bid};
          EpiPlain E{(bf16_t*)(ws + WS_KVM), 1024};
          pg8::gemm_phase<EpiPlain, DenseSched, false>(C.lds, 1024, S, E); }
    }
    SEAM(1);
    if (IN(2)) phase_lerp(a, C);
    SEAM(2);
    if (IN(3)) {
        int Kl = 256; asm volatile("" : "+s"(Kl)); DenseSched S{(const char*)(ws + WS_LIN), (const char*)(ws + WS_WRW), NTOK / 256, 1536 / 256, Kl, C.G, C.bid};
        EpiLora E{ws, a.in(7), a.in(9)};
        pg8::gemm_phase<EpiLora, DenseSched, false>(C.lds, Kl, S, E);
    }
    SEAM(3);
    if (IN(4)) phase_rwkv_pre(a, C);
    SEAM(4);
    if (IN(5)) {
        if (C.G > 96) { if (C.bid < 64) { Ctx C2 = C; C2.G = 64; phase_rwkv_seq(a, C2); phase0_moe(a, C2); } else { Ctx C2 = C; C2.bid = C.bid - 64; C2.G = C.G - 64;
              unsigned* kvc = (unsigned*)(ws + WS_CTL) + CW_KV;
              if (C2.bid < 32) {
                  DenseSched S{(const char*)(ws + WS_MEMN), (const char*)(ws + WS_WMKV), NMEM / 256, 1024 / 256, 1024, 32, C2.bid};
                  EpiPlain E{(bf16_t*)(ws + WS_KVM), 1024};
                  pg8::gemm_phase<EpiPlain, DenseSched, false>(C.lds, 1024, S, E);
                  asm volatile("s_waitcnt vmcnt(0)" ::: "memory"); __syncthreads();
                  if (threadIdx.x == 0) { __builtin_amdgcn_fence(__ATOMIC_RELEASE, "agent"); asm volatile("s_waitcnt vmcnt(0)" ::: "memory"); (void)__hip_atomic_fetch_add(kvc, 1u, __ATOMIC_RELAXED, __HIP_MEMORY_SCOPE_AGENT); }
              }
              phase_swa(a, C2);
              if (threadIdx.x == 0) { unsigned sp = 0; while (__hip_atomic_load(kvc, __ATOMIC_RELAXED, __HIP_MEMORY_SCOPE_AGENT) < 32u && ++sp < (1u << 24)) __builtin_amdgcn_s_sleep(2);
                  __builtin_amdgcn_fence(__ATOMIC_ACQUIRE, "agent"); asm volatile("s_waitcnt vmcnt(0)" ::: "memory"); }
              __syncthreads();
              phase_mem(a, C2);
              phase0_moe(a, C2); } }
        else { phase_rwkv_seq(a, C); phase_swa(a, C); phase_mem(a, C); phase0_moe(a, C); }
    }
    SEAM(5);
    if (IN(6)) {
        int KE = 512; asm volatile("" : "+s"(KE));
        EpiGateNT E{(bf16_t*)(ws + WS_P), (bf16_t*)(ws + WS_GATE), a.in(5), 1.0f / W8_SCALE};
        { GateSched S{(const char*)(ws + WS_XN8), (const char*)(ws + WS_WG8), NTOK / 256, 4, KE, C.G, C.bid};
          pg8::gemm_phase<EpiGateNT, GateSched, false, true>(C.lds, KE, S, E); }
    }
    STAMP(7);
    if (IN(7)) {
        BranchSched S{(const char*)ws, (const char*)(ws + WS_WBR), NTOK / 256, 4, C.G, C.bid};
        EpiBranch E{(bf16_t*)(ws + WS_MERGED), (const bf16_t*)(ws + WS_GATE)};
        pg8::gemm_phase<EpiBranch, BranchSched, false>(C.lds, 512, S, E);
    }
    SEAM(7);
    if (IN(8)) {
        DenseSched S{(const char*)(ws + WS_MERGED), (const char*)(ws + WS_WOUT), NTOK / 256, 4, 1024, C.G, C.bid};
        EpiOut E{a.in(0), a.out()};
        pg8::gemm_phase<EpiOut, DenseSched, false>(C.lds, 1024, S, E);
    }
    SEAM(8);
    if (IN(9)) phase_router(a, C);
    SEAM(9);
    if (IN(10)) phase_slots(a, C);
    SEAM(10);
    if (IN(11)) {
        const int ntiles = __builtin_amdgcn_readfirstlane((int)__hip_atomic_load((unsigned*)(ws + WS_CTL) + CW_NTILES, __ATOMIC_RELAXED, __HIP_MEMORY_SCOPE_AGENT));
        int KE = MOE_FP8 ? 512 : 1024; asm volatile("" : "+s"(KE));
        LAS int* te_lds = (LAS int*)(C.lds + pg8::STAGE_BYTES + 8192);
        for (int i = threadIdx.x; i < 544; i += 512) te_lds[i] = ((const int*)(ws + MS_TILEE))[i < ntiles ? i : 0];
        __syncthreads();
        MoeSched S{(const char*)(ws + WS_HB), (const char*)(ws + WS_W1T), (const int*)(ws + MS_TILEE), (const int*)(ws + MS_SLOTTOK), ntiles, 8, KE, C.G, C.bid, (size_t)2048 * KE * 2, te_lds};
        EpiUp E{(bf16_t*)(ws + WS_ACT), a.in(26), (const float*)(ws + MS_SLOTRS)};
        pg8::gemm_phase<EpiUp, MoeSched, true, MOE_FP8 != 0>(C.lds, KE, S, E);
    }
    SEAM(11);
    if (IN(12)) {
        const int ntiles = __builtin_amdgcn_readfirstlane((int)__hip_atomic_load((unsigned*)(ws + WS_CTL) + CW_NTILES, __ATOMIC_RELAXED, __HIP_MEMORY_SCOPE_AGENT));
        int KE = MOE_FP8 ? 512 : 1024; asm volatile("" : "+s"(KE));
        LAS int* te_lds = (LAS int*)(C.lds + pg8::STAGE_BYTES + 8192);
        for (int i = threadIdx.x; i < 544; i += 512) te_lds[i] = ((const int*)(ws + MS_TILEE))[i < ntiles ? i : 0];
        __syncthreads();
        MoeSched2 S{(const char*)(ws + WS_ACT), (const char*)(ws + WS_W2T), (const int*)(ws + MS_TILEE), ntiles, 4, KE, C.G, C.bid, (size_t)1024 * KE * 2, te_lds};
        EpiDown E{(bf16_t*)(ws + WS_YSLOT), a.in(28), (const float*)(ws + MS_SLOTG)};
        pg8::gemm_phase<EpiDown, MoeSched2, false, MOE_FP8 != 0>(C.lds, KE, S, E);
    }
    SEAM(12);
    if (IN(13)) phase_final(a, C);
#ifdef PROBE_A
    STAMP(14);
    __syncthreads();
    if (blockIdx.x == 0 && threadIdx.x == 0) {
        asm volatile("s_waitcnt vmcnt(0)" ::: "memory");
        const unsigned long long* ts = (const unsigned long long*)(ws + WS_CTL + 4096);
        const float da = (float)(ts[PROBE_A + 1] - ts[PROBE_A]) * 0.001f;
        a.out()[0] += da;
        const unsigned long long db = (ts[PROBE_B + 1] - ts[PROBE_B]) * 4ull;
        const unsigned long long t0 = __builtin_amdgcn_s_memrealtime();
        while (__builtin_amdgcn_s_memrealtime() - t0 < db) __builtin_amdgcn_s_sleep(8);
    }
#endif
#undef IN
#undef SEAM
#undef ws
}

#ifndef MK_MULTI
#define MK_MULTI 0
#endif
extern "C" void kernel_launch(void* const* d_in, const int* in_sizes, int n_in, void* d_out, int out_size, void* d_ws, size_t ws_size, hipStream_t stream) {
    static int grid = 0;
    if (grid == 0) {
        int dev = 0, cus = 0, per_cu = 0;
        if (n_in != 30 || ws_size < WS_END) { fprintf(stderr, "kernel_launch: unexpected n_in %d / ws %zu\n", n_in, ws_size); grid = -1; return; }
        (void)hipGetDevice(&dev); (void)hipDeviceGetAttribute(&cus, hipDeviceAttributeMultiprocessorCount, dev);
        (void)hipFuncSetAttribute((const void*)mega, hipFuncAttributeMaxDynamicSharedMemorySize, LDS_BYTES);
        (void)hipOccupancyMaxActiveBlocksPerMultiprocessor(&per_cu, (const void*)mega, 512, LDS_BYTES);
        (void)hipGetLastError();
        if (per_cu < 1) per_cu = 1;
        grid = cus;
        fprintf(stderr, "kernel_launch: cus %d per_cu %d grid %d ws %zu\n", cus, per_cu, grid, ws_size);
    }
    if (grid < 0) return;
    (void)hipMemsetAsync((char*)d_ws + WS_CTL, 0, CTL_BYTES, stream);
    Args a{};
    for (int i = 0; i < 30; ++i) a.in[i] = (const float*)d_in[i];
    a.out = (float*)d_out; a.ws = (unsigned char*)d_ws;
#if MK_MULTI
    for (int p = 0; p < N_PHASES; ++p) { a.ph_lo = p; a.ph_hi = p + 1; hipLaunchKernelGGL(mega, dim3(grid), dim3(512), LDS_BYTES, stream, a); }
#else
    a.ph_lo = 0; a.ph_hi = N_PHASES;
    void* args[] = {&a};
    hipError_t e = hipLaunchCooperativeKernel((const void*)mega, dim3(grid), dim3(512), args, LDS_BYTES, stream);
    if (e != hipSuccess) fprintf(stderr, "cooperative launch failed: %s (grid %d)\n", hipGetErrorString(e), grid);
#endif
}
```

```cpp
#include <hip/hip_runtime.h>
#include <hip/hip_cooperative_groups.h>
#include <cstdio>
#include <cstdint>
namespace cg = cooperative_groups;

#define LAS __attribute__((address_space(3)))
#define GAS __attribute__((address_space(1)))
typedef unsigned short bf16_t;
typedef short bf16x8 __attribute__((ext_vector_type(8)));
typedef short s16x4 __attribute__((ext_vector_type(4)));
typedef float f32x4 __attribute__((ext_vector_type(4)));
typedef float f32x2 __attribute__((ext_vector_type(2)));
typedef unsigned u32x4 __attribute__((ext_vector_type(4)));
typedef unsigned u32x2 __attribute__((ext_vector_type(2)));

constexpr int BATCH = 8, SEQ = 4096, NTOK = BATCH * SEQ, DM = 1024;
constexpr int RW_PROJ = 1792, SWA_OFF = 1792, MEMQ_OFF = 2560, IN_PROJ = 3072;
constexpr int MEM_LEN = 256, NMEM = BATCH * MEM_LEN;
constexpr int NEXP = 32, TOPK = 4, DFF = 1024;
constexpr int MAXSLOT = NTOK * TOPK + NEXP * 256;
constexpr int NWAVES = 8;

constexpr size_t MiB = 1u << 20;
constexpr size_t WS_CTL = 0, CTL_BYTES = 64 * 1024;
constexpr size_t WS_WBIG = 1 * MiB;
constexpr size_t WS_WMKV = 13 * MiB;
constexpr size_t WS_WBR = 15 * MiB;
constexpr size_t WS_WOUT = 18 * MiB;
constexpr size_t WS_WRW = 20 * MiB;
constexpr size_t WS_MISC = 21 * MiB;
constexpr size_t WS_W2T = 32 * MiB;
constexpr size_t WS_W1T = 96 * MiB;
constexpr size_t WS_YSLOT = 96 * MiB;
constexpr size_t WS_PREP = 224 * MiB;
constexpr size_t WS_R = WS_PREP, WS_KR = WS_PREP + 32 * MiB, WS_V = WS_PREP + 64 * MiB, WS_ASIG = WS_PREP + 96 * MiB, WS_W = WS_PREP + 128 * MiB, WS_LIN = WS_PREP + 192 * MiB;
constexpr size_t WS_MERGED = 552 * MiB;
constexpr size_t WS_HB = 288 * MiB;
constexpr size_t WS_XN = 448 * MiB;
constexpr size_t WS_YB0 = 64 * MiB, WS_YB1 = 160 * MiB, WS_YB2 = 192 * MiB;
constexpr size_t WS_XN8 = 512 * MiB;
constexpr size_t WS_WG8 = 7 * MiB;
constexpr size_t WS_MEMN = 544 * MiB;
constexpr size_t WS_KVM = 548 * MiB;
constexpr size_t WS_P = 552 * MiB;
constexpr size_t WS_GATE = 256 * MiB;
constexpr size_t WS_H1B = 352 * MiB;
constexpr size_t WS_RWT0 = 744 * MiB;
constexpr size_t WS_YRAW = 552 * MiB;
constexpr size_t WS_ACT = 552 * MiB;
constexpr size_t WS_END = 1016 * MiB;
#ifndef RW_CHUNKED
#define RW_CHUNKED 1
#endif
constexpr size_t MS_RSTD2 = WS_MISC;
constexpr size_t MS_TOKE = WS_MISC + 1 * MiB / 2;
constexpr size_t MS_TOKPOS = WS_MISC + 1 * MiB;
constexpr size_t MS_TOKSLOT = WS_MISC + 3 * MiB / 2;
constexpr size_t MS_TOKG = WS_MISC + 2 * MiB;
constexpr size_t MS_SLOTTOK = WS_MISC + 5 * MiB / 2;
constexpr size_t MS_SLOTG = WS_MISC + 7 * MiB / 2;
constexpr size_t MS_SLOTRS = WS_MISC + 9 * MiB / 2;
constexpr size_t MS_TILEE = WS_MISC + 11 * MiB / 2;
constexpr size_t MS_BONUS = WS_MISC + 6 * MiB;
constexpr size_t MS_WRT = WS_MISC + 7 * MiB;
constexpr int CW_CNT = 4096;
constexpr int CW_NTILES = 128;
constexpr int CW_MOEW = 320;
constexpr int CW_KV = 192;
constexpr int CW_BAR = 8192;

constexpr int LDS_BYTES = 155648;

__device__ __forceinline__ unsigned f2bf(float f) { unsigned u = __builtin_bit_cast(unsigned, f); return (u + 0x7fffu + ((u >> 16) & 1u)) >> 16; }
__device__ __forceinline__ unsigned cvt_pk_bf16(float lo, float hi) { unsigned r; asm volatile("v_cvt_pk_bf16_f32 %0, %1, %2" : "=v"(r) : "v"(lo), "v"(hi)); return r; }
typedef float f32x2_t_ __attribute__((ext_vector_type(2)));
typedef __bf16 bf16x2_t_ __attribute__((ext_vector_type(2)));
__device__ __forceinline__ unsigned pk2(float lo, float hi) { const f32x2_t_ v = {lo, hi}; const bf16x2_t_ b = __builtin_convertvector(v, bf16x2_t_); return __builtin_bit_cast(unsigned, b); }
__device__ __forceinline__ float bf_lo(unsigned u) { return __builtin_bit_cast(float, u << 16); }
__device__ __forceinline__ float bf_hi(unsigned u) { return __builtin_bit_cast(float, u & 0xffff0000u); }
__device__ __forceinline__ float bf1(bf16_t u) { return __builtin_bit_cast(float, (unsigned)u << 16); }
__device__ __forceinline__ float fexp(float x) { return __builtin_amdgcn_exp2f(x * 1.44269504f); }
__device__ __forceinline__ float fsigmoid(float x) { return __builtin_amdgcn_rcpf(1.0f + fexp(-x)); }
__device__ __forceinline__ float wave_sum(float v) {
#pragma unroll
    for (int o = 1; o < 64; o <<= 1) v += __shfl_xor(v, o);
    return v;
}
__device__ __forceinline__ unsigned cvt_fp8x4(float a, float b, float c, float d) { int w = 0; w = __builtin_amdgcn_cvt_pk_fp8_f32(a, b, w, false); w = __builtin_amdgcn_cvt_pk_fp8_f32(c, d, w, true); return (unsigned)w; }
typedef int i32x8 __attribute__((ext_vector_type(8)));
#ifndef MOE_FP8
#define MOE_FP8 1
#endif
#ifndef YS_FP8
#define YS_FP8 1
#endif
#ifndef G1_FP8
#define G1_FP8 0
#endif
constexpr float W8_SCALE = 32.0f;
#define LDS_WAIT() asm volatile("s_waitcnt lgkmcnt(0)" ::: "memory")
#define VM_WAIT() asm volatile("s_waitcnt vmcnt(0)" ::: "memory")

namespace pg8 {
constexpr int BM = 256, BK = 64, HALF = 128, HTB = HALF * BK * 2, STAGE_BYTES = 8 * HTB, NXCD = 8, WGM = 8;
__host__ __device__ __forceinline__ int lds_byte(int r, int c) { const int st = (r >> 4) * 2 + (c >> 5), rr = r & 15, cc = c & 31, ob = rr * 64 + cc * 2; return st * 1024 + (ob ^ (((ob >> 9) & 1) << 5)); }
__host__ __device__ __forceinline__ void stage_rc(int b, int& R, int& C) { const int st = b / 1024, sb = b % 1024, swz = sb ^ (((sb >> 9) & 1) << 5); R = (st >> 1) * 16 + swz / 64; C = (st & 1) * 32 + (swz % 64) / 2; }
__host__ __device__ __forceinline__ int perm32(int rho) { const int n = rho >> 4, i = rho & 15; return 8 * (i >> 2) + 4 * n + (i & 3); }

struct Unit { int pm, pn, aux; const char* a; const char* b; };

__device__ __forceinline__ void tile_of(int L, int nM, int nN, int& pm, int& pn) {
    const int nwg = nM * nN; int wgid = L;
    { const int q = nwg / NXCD, r = nwg % NXCD, xcd = wgid % NXCD, off = wgid / NXCD; wgid = (xcd < r ? xcd * (q + 1) : r * (q + 1) + (xcd - r) * q) + off; }
    const int nig = WGM * nN, gid = wgid / nig, fm = gid * WGM, gsz = (nM - fm) < WGM ? (nM - fm) : WGM;
    pm = fm + ((wgid % nig) % gsz); pn = (wgid % nig) / gsz;
}

template <class Epi, class Sched, bool GATHER, bool FP8 = false>
__device__ __forceinline__ void gemm_phase(LAS unsigned char* lds, const int K, const Sched& S, const Epi& E, const int Klen = 0) {
    const int tid = threadIdx.x, wid = __builtin_amdgcn_readfirstlane(tid >> 6), lane = tid & 63, wr = wid >> 2, wc = wid & 3, fr = lane & 15, fq = lane >> 4;
    const int nt = (Klen > 0 ? Klen : K) / BK;
    unsigned voffA[2], voffB[2];
#pragma unroll
    for (int i = 0; i < 2; ++i) { int R, C; stage_rc(tid * 16 + i * 8192, R, C); const int Rb = (R & ~31) + perm32(R & 31); voffA[i] = (unsigned)(R * K + C) * 2u; voffB[i] = (unsigned)(Rb * K + C) * 2u; }
    const size_t kstep = (size_t)(BK * 2);
    const size_t hstep = (size_t)HALF * K * 2;
    const unsigned ldsw = (unsigned)wid * 1024u;
    const int aoff = FP8 ? lds_byte(wr * 64 + fr, fq * 16) : lds_byte(wr * 64 + fr, fq * 8), boff = FP8 ? lds_byte(wc * 32 + fr, fq * 16) : lds_byte(wc * 32 + fr, fq * 8);
    LAS unsigned char* tokbuf = lds + STAGE_BYTES + wid * 1024;
#define PG8_SA(b, h) (((b) * 2 + (h)) * HTB)
#define PG8_SB(b, h) ((4 + (b) * 2 + (h)) * HTB)
#define PG8_STAGE(bufoff, gbase, voff) do { _Pragma("unroll") for (int _i = 0; _i < 2; ++_i) \
        __builtin_amdgcn_global_load_lds((const unsigned*)((const char*)(gbase) + (voff)[_i]), (LAS unsigned*)(lds + (bufoff) + ldsw + _i * 8192), 16, 0, 0); } while (0)
#define PG8_STAGE_A(bufoff, gbase, h) do { if constexpr (GATHER) { PG8_STAGE(bufoff, gbase, vG[h]); } else { PG8_STAGE(bufoff, (gbase) + (h) * hstep, voffA); } } while (0)
#define PG8_TOK_DMA(u) do { const int* _tp = S.arow_ptr(u); _Pragma("unroll") for (int _h = 0; _h < 2; ++_h) _Pragma("unroll") for (int _i = 0; _i < 2; ++_i) { int _R, _C; stage_rc(tid * 16 + _i * 8192, _R, _C); \
        __builtin_amdgcn_global_load_lds((const unsigned*)(_tp + _h * HALF + _R), (LAS unsigned*)(tokbuf + (_h * 2 + _i) * 256), 4, 0, 0); } } while (0)
#define PG8_TOK_READ() do { _Pragma("unroll") for (int _h = 0; _h < 2; ++_h) _Pragma("unroll") for (int _i = 0; _i < 2; ++_i) { int _R, _C; stage_rc(tid * 16 + _i * 8192, _R, _C); \
        const int _tk = *(const LAS int*)(tokbuf + (_h * 2 + _i) * 256 + lane * 4); vG[_h][_i] = (unsigned)(_tk * K + _C) * 2u; } } while (0)
#define PG8_LD32(p) __builtin_bit_cast(i32x8, __builtin_shufflevector(*(const LAS u32x4*)(p), *(const LAS u32x4*)((p) + (FP8 ? 16 : 1024)), 0, 1, 2, 3, 4, 5, 6, 7))
#define PG8_LDA(dst, b, h) do { _Pragma("unroll") for (int m = 0; m < 4; ++m) dst[m] = PG8_LD32(lds + PG8_SA(b, h) + aoff + m * 2048); } while (0)
#define PG8_LDB(dst, b, h) do { _Pragma("unroll") for (int n = 0; n < 2; ++n) dst[n] = PG8_LD32(lds + PG8_SB(b, h) + boff + n * 2048); } while (0)
#define PG8_LO(x) __builtin_bit_cast(bf16x8, __builtin_shufflevector(x, x, 0, 1, 2, 3))
#define PG8_HI(x) __builtin_bit_cast(bf16x8, __builtin_shufflevector(x, x, 4, 5, 6, 7))
#define PG8_MMA(ai, bj, At, Bt) do { __builtin_amdgcn_s_setprio(1); _Pragma("unroll") for (int m = 0; m < 4; ++m) _Pragma("unroll") for (int n = 0; n < 2; ++n) { \
        if constexpr (FP8) asm volatile("v_mfma_scale_f32_16x16x128_f8f6f4 %0, %1, %2, %0, %3, %3 op_sel_hi:[0,0,0]" : "+v"(acc[ai][bj][m][n]) : "v"(Bt[n]), "v"(At[m]), "v"(sc8));     \
        else { acc[ai][bj][m][n] = __builtin_amdgcn_mfma_f32_16x16x32_bf16(PG8_LO(Bt[n]), PG8_LO(At[m]), acc[ai][bj][m][n], 0, 0, 0); \
               acc[ai][bj][m][n] = __builtin_amdgcn_mfma_f32_16x16x32_bf16(PG8_HI(Bt[n]), PG8_HI(At[m]), acc[ai][bj][m][n], 0, 0, 0); } } __builtin_amdgcn_s_setprio(0); } while (0)
#define PG8_WAIT_V(n) asm volatile("s_waitcnt vmcnt(" #n ")" ::: "memory")
#define PG8_WAIT_L(n) asm volatile("s_waitcnt lgkmcnt(" #n ")" ::: "memory")
#define PG8_BAR __builtin_amdgcn_s_barrier()
#define PG8_SCHED __builtin_amdgcn_sched_barrier(0)
    Unit cur, nxt; int ui = 0;
    if (!S.next(0, cur)) return;
    unsigned vG[2][2] = {{0u, 0u}, {0u, 0u}};
    if constexpr (GATHER) { PG8_TOK_DMA(cur); PG8_WAIT_V(0); PG8_TOK_READ(); PG8_WAIT_L(0); }
    f32x4 acc[2][2][4][2];
#pragma unroll
    for (int a = 0; a < 2; ++a)
#pragma unroll
        for (int b = 0; b < 2; ++b)
#pragma unroll
            for (int m = 0; m < 4; ++m)
#pragma unroll
                for (int n = 0; n < 2; ++n) acc[a][b][m][n] = (f32x4){0.f, 0.f, 0.f, 0.f};
    i32x8 At[4], B0[2], B1[2];
    const int sc8 = 0x7f7f7f7f;
    const char* cA = cur.a; const char* cB = cur.b;
    PG8_STAGE(PG8_SB(0, 0), cB, voffB); PG8_STAGE(PG8_SB(0, 1), cB + hstep, voffB); PG8_STAGE_A(PG8_SA(0, 0), cA, 0); PG8_STAGE_A(PG8_SA(0, 1), cA, 1);
    if (wr == 1) PG8_BAR;
    PG8_WAIT_V(2); PG8_BAR;
    PG8_STAGE(PG8_SB(1, 0), cB + kstep, voffB); PG8_STAGE_A(PG8_SA(1, 0), cA + kstep, 0); PG8_STAGE(PG8_SB(1, 1), cB + hstep + kstep, voffB);
    PG8_WAIT_V(6); PG8_BAR;
    for (;;) {
        const bool has_next = S.next(ui + 1, nxt);
        const char* nA = has_next ? nxt.a : cA; const char* nB = has_next ? nxt.b : cB;
        if constexpr (GATHER) { if (has_next) PG8_TOK_DMA(nxt); }
#pragma unroll 1
        for (int t = 0; t < nt; t += 2) {
            const bool last = (t == nt - 2);
            const char* a1 = cA + (size_t)(t + 1) * kstep;
            const char* a2 = last ? nA : cA + (size_t)(t + 2) * kstep; const char* b2 = last ? nB : cB + (size_t)(t + 2) * kstep;
            const char* a3 = a2 + kstep; const char* b3 = b2 + kstep;
            PG8_LDB(B0, 0, 0); PG8_LDB(B1, 0, 1); PG8_SCHED; PG8_LDA(At, 0, 0); PG8_STAGE_A(PG8_SA(1, 1), a1, 1);
            if constexpr (GATHER) { if (last && has_next) PG8_TOK_READ(); }
            PG8_WAIT_V(8); PG8_WAIT_L(0); PG8_BAR; PG8_MMA(0, 0, At, B0); PG8_MMA(0, 1, At, B1); PG8_BAR; PG8_SCHED;
            PG8_LDA(At, 0, 1); PG8_STAGE(PG8_SB(0, 0), b2, voffB); PG8_STAGE(PG8_SB(0, 1), b2 + hstep, voffB); PG8_STAGE_A(PG8_SA(0, 0), a2, 0);
            PG8_WAIT_V(8); PG8_WAIT_L(0); PG8_BAR; PG8_MMA(1, 0, At, B0); PG8_MMA(1, 1, At, B1); PG8_BAR; PG8_SCHED;
            PG8_LDB(B0, 1, 0); PG8_LDB(B1, 1, 1); PG8_SCHED; PG8_LDA(At, 1, 0); PG8_STAGE_A(PG8_SA(0, 1), a2, 1);
            PG8_WAIT_V(8); PG8_WAIT_L(0); PG8_BAR; PG8_MMA(0, 0, At, B0); PG8_MMA(0, 1, At, B1); PG8_BAR; PG8_SCHED;
            PG8_LDA(At, 1, 1); PG8_STAGE(PG8_SB(1, 0), b3, voffB); PG8_STAGE(PG8_SB(1, 1), b3 + hstep, voffB); PG8_STAGE_A(PG8_SA(1, 0), a3, 0);
            PG8_WAIT_V(8); PG8_WAIT_L(0); PG8_BAR; PG8_MMA(1, 0, At, B0); PG8_MMA(1, 1, At, B1); PG8_BAR; PG8_SCHED;
        }
        if (wr == 0) PG8_BAR;
        if constexpr (FP8) asm volatile("s_nop 15\n\ts_nop 15" ::: "memory");
        { int t2 = threadIdx.x; asm volatile("" : "+v"(t2));
          const int wid2 = __builtin_amdgcn_readfirstlane(t2 >> 6), l2 = t2 & 63; E(acc, cur, wid2 >> 2, wid2 & 3, l2 & 15, l2 >> 4); }
        if (!has_next) break;
        if (!E.keep(cur)) {
#pragma unroll
        for (int a = 0; a < 2; ++a)
#pragma unroll
            for (int b = 0; b < 2; ++b)
#pragma unroll
                for (int m = 0; m < 4; ++m)
#pragma unroll
                    for (int n = 0; n < 2; ++n) acc[a][b][m][n] = (f32x4){0.f, 0.f, 0.f, 0.f};
        }
        cur = nxt; cA = nA; cB = nB; ++ui;
        if (wr == 1) PG8_BAR;
    }
    PG8_WAIT_V(0);
    PG8_BAR;
#undef PG8_SA
#undef PG8_SB
#undef PG8_STAGE
#undef PG8_STAGE_A
#undef PG8_TOK_DMA
#undef PG8_TOK_READ
#undef PG8_LDA
#undef PG8_LDB
#undef PG8_MMA
#undef PG8_LD32
#undef PG8_LO
#undef PG8_HI
#undef PG8_WAIT_V
#undef PG8_WAIT_L
#undef PG8_BAR
#undef PG8_SCHED
}
}
struct DenseSched {
    const char* A; const char* Bt; int nM, nN, K, G, c; int pn0 = 0;
    __device__ __forceinline__ bool next(int i, pg8::Unit& u) const {
        const long L = (long)i * G + c; if (L >= (long)nM * nN) return false;
        pg8::tile_of((int)L, nM, nN, u.pm, u.pn); u.aux = 0;
        u.a = A + (size_t)u.pm * 256 * K * 2; u.b = Bt + (size_t)u.pn * 256 * K * 2; u.pn += pn0; return true;
    }
    __device__ __forceinline__ const int* arow_ptr(const pg8::Unit&) const { return nullptr; }
};
struct LoraSched {
    const char* A; const char* Bt; int nM, nN, K, G, c;
    __device__ __forceinline__ bool next(int i, pg8::Unit& u) const {
        const long L = (long)i * G + c; if (L >= (long)nM * nN) return false;
        pg8::tile_of((int)L, nM, nN, u.pm, u.pn); u.aux = 0; const size_t koff = (u.pn >= 4) ? 128 * 2 : 0;
        u.a = A + (size_t)u.pm * 256 * K * 2 + koff; u.b = Bt + (size_t)u.pn * 256 * K * 2 + koff; return true;
    }
    __device__ __forceinline__ const int* arow_ptr(const pg8::Unit&) const { return nullptr; }
};
struct GateSched {
    const char* A; const char* Bt; int nM, nN, K, G, c; int r0 = 0;
    __device__ __forceinline__ bool next(int i, pg8::Unit& u) const {
        const int br = i % 3; const long L = (long)(i / 3 + r0) * G + c; if (L >= (long)nM * nN) return false;
        int pn; pg8::tile_of((int)L, nM, nN, u.pm, pn); const int gp = 4 * br + pn; u.aux = 0;
        u.a = A + (size_t)u.pm * 256 * K * 2; u.b = Bt + (size_t)gp * 256 * K * 2; u.pn = 12 + gp; return true;
    }
    __device__ __forceinline__ const int* arow_ptr(const pg8::Unit&) const { return nullptr; }
};
struct GateSchedU {
    const char* A; const char* Bt; int nM, nN, K, U0, n;
    __device__ __forceinline__ bool next(int i, pg8::Unit& u) const {
        if (i >= n) return false; const int U = U0 + i, br = U % 3, L = U / 3;
        int pn; pg8::tile_of(L, nM, nN, u.pm, pn); const int gp = 4 * br + pn; u.aux = 0;
        u.a = A + (size_t)u.pm * 256 * K * 2; u.b = Bt + (size_t)gp * 256 * K * 2; u.pn = 12 + gp; return true;
    }
    __device__ __forceinline__ const int* arow_ptr(const pg8::Unit&) const { return nullptr; }
};
struct GateSchedX {
    const char* A; const char* Bt; int nM, nN, K, c, mode;
    __device__ __forceinline__ bool next(int i, pg8::Unit& u) const {
        if (i >= 4) return false;
        const int L = mode ? (i == 0 ? c : 256 + c) : c + 128 * (i >> 1), br = mode ? (i == 0 ? 2 : i - 1) : (i & 1);
        int pn; pg8::tile_of(L, nM, nN, u.pm, pn); const int gp = 4 * br + pn; u.aux = 0;
        u.a = A + (size_t)u.pm * 256 * K * 2; u.b = Bt + (size_t)gp * 256 * K * 2; u.pn = 12 + gp; return true;
    }
    __device__ __forceinline__ const int* arow_ptr(const pg8::Unit&) const { return nullptr; }
};
struct BranchSched {
    const char* ws; const char* WBR; int nM, nN, G, c;
    __device__ __forceinline__ bool next(int i, pg8::Unit& u) const {
        const int br = i % 3; const long L = (long)(i / 3) * G + c; if (L >= (long)nM * nN) return false;
        pg8::tile_of((int)L, nM, nN, u.pm, u.pn); u.aux = br;
        u.a = ws + (br == 0 ? WS_YB0 : (br == 1 ? WS_YB1 : WS_YB2)) + (size_t)u.pm * 256 * 512 * 2; u.b = WBR + (size_t)br * 1024 * 512 * 2 + (size_t)u.pn * 256 * 512 * 2; return true;
    }
    __device__ __forceinline__ const int* arow_ptr(const pg8::Unit&) const { return nullptr; }
};
struct MoeSched {
    const char* A; const char* Wt; const int* tile_e; const int* slot_tok; int nM, nN, K, G, c; size_t estride; LAS const int* te_lds;
    __device__ __forceinline__ bool next(int i, pg8::Unit& u) const {
        const long L = (long)i * G + c; if (L >= (long)nM * nN) return false;
        pg8::tile_of((int)L, nM, nN, u.pm, u.pn); u.aux = __builtin_amdgcn_readfirstlane(te_lds[u.pm]);
        u.a = A; u.b = Wt + (size_t)u.aux * estride + (size_t)u.pn * 256 * K * 2; return true;
    }
    __device__ __forceinline__ const int* arow_ptr(const pg8::Unit& u) const { return slot_tok + u.pm * 256; }
};
struct MoeSched2 {
    const char* A; const char* Wt; const int* tile_e; int nM, nN, K, G, c; size_t estride; LAS const int* te_lds;
    __device__ __forceinline__ bool next(int i, pg8::Unit& u) const {
        const long L = (long)i * G + c; if (L >= (long)nM * nN) return false;
        pg8::tile_of((int)L, nM, nN, u.pm, u.pn); u.aux = __builtin_amdgcn_readfirstlane(te_lds[u.pm]);
        u.a = A + (size_t)u.pm * 256 * K * 2; u.b = Wt + (size_t)u.aux * estride + (size_t)u.pn * 256 * K * 2; return true;
    }
    __device__ __forceinline__ const int* arow_ptr(const pg8::Unit&) const { return nullptr; }
};

#define EPI_LOOP_ROWS for (int ai = 0; ai < 2; ++ai) _Pragma("unroll") for (int m = 0; m < 4; ++m)
typedef f32x4 acc_t[2][2][4][2];
#define EPI_NOKEEP __device__ __forceinline__ bool keep(const pg8::Unit&) const { return false; }

template <bool NT> struct EpiInT {
    EPI_NOKEEP
    bf16_t* P; bf16_t* GATE; const float* b_swa; float gscale = 1.0f; float pscale = 1.0f;
    __device__ __forceinline__ void operator()(acc_t& acc, const pg8::Unit& u, int wr, int wc, int fr, int fq) const {
        const int row0 = u.pm * 256 + wr * 64 + fr; const int colt = u.pn * 256 + wc * 32 + 8 * fq;
        const bool gate = u.pn >= 12; const bool hasb = (u.pn >= 7 && u.pn < 10);
        bf16_t* base = P + colt; unsigned char* gbase = (unsigned char*)GATE + (colt - 3072);
        f32x4 bv[2][2];
#pragma unroll
        for (int bj = 0; bj < 2; ++bj)
#pragma unroll
            for (int n = 0; n < 2; ++n) bv[bj][n] = hasb ? *(const f32x4*)(b_swa + (colt - SWA_OFF) + bj * 128 + 4 * n) : (f32x4){0.f, 0.f, 0.f, 0.f};
#pragma unroll
        EPI_LOOP_ROWS { bf16_t* rowp = base + (size_t)(row0 + ai * 128 + m * 16) * 3072;
#pragma unroll
            for (int bj = 0; bj < 2; ++bj) { f32x4 v0 = acc[ai][bj][m][0] * pscale + bv[bj][0], v1 = acc[ai][bj][m][1] * pscale + bv[bj][1];
                if (gate) {
                    unsigned q[8];
#pragma unroll
                    for (int j = 0; j < 4; ++j) { q[j] = (unsigned)(fsigmoid(v0[j] * gscale) * 255.0f + 0.5f); q[4 + j] = (unsigned)(fsigmoid(v1[j] * gscale) * 255.0f + 0.5f); }
#pragma unroll
                    for (int j = 0; j < 8; ++j) q[j] = q[j] < 1u ? 1u : q[j];
                    u32x2 w8; w8.x = q[0] | (q[1] << 8) | (q[2] << 16) | (q[3] << 24); w8.y = q[4] | (q[5] << 8) | (q[6] << 16) | (q[7] << 24);
                    unsigned char* gp = gbase + (size_t)(row0 + ai * 128 + m * 16) * 3072 + bj * 128;
                    if constexpr (NT) __builtin_nontemporal_store(w8, (u32x2*)gp); else *(u32x2*)gp = w8;
                    continue; }
                u32x4 w; w.x = cvt_pk_bf16(v0[0], v0[1]); w.y = cvt_pk_bf16(v0[2], v0[3]); w.z = cvt_pk_bf16(v1[0], v1[1]); w.w = cvt_pk_bf16(v1[2], v1[3]);
                if constexpr (NT) __builtin_nontemporal_store(w, (u32x4*)(rowp + bj * 128)); else *(u32x4*)(rowp + bj * 128) = w; } }
    }
};
#ifndef G1_NT
#define G1_NT 1
#endif
#ifndef GATE_NT
#define GATE_NT 0
#endif
typedef EpiInT<G1_NT != 0> EpiIn; typedef EpiInT<GATE_NT != 0> EpiGateNT;
struct EpiPlain {
    EPI_NOKEEP
    bf16_t* O; int ldc;
    __device__ __forceinline__ void operator()(acc_t& acc, const pg8::Unit& u, int wr, int wc, int fr, int fq) const {
        const int row0 = u.pm * 256 + wr * 64 + fr; const int colt = u.pn * 256 + wc * 32 + 8 * fq;
#pragma unroll
        EPI_LOOP_ROWS { bf16_t* rowp = O + (size_t)(row0 + ai * 128 + m * 16) * ldc + colt;
#pragma unroll
            for (int bj = 0; bj < 2; ++bj) { const f32x4 v0 = acc[ai][bj][m][0], v1 = acc[ai][bj][m][1];
                u32x4 w; w.x = pk2(v0[0], v0[1]); w.y = pk2(v0[2], v0[3]); w.z = pk2(v1[0], v1[1]); w.w = pk2(v1[2], v1[3]);
                *(u32x4*)(rowp + bj * 128) = w; } }
    }
};
struct EpiLora {
    EPI_NOKEEP
    unsigned char* ws; const float* w0; const float* a0;
    __device__ __forceinline__ void operator()(acc_t& acc, const pg8::Unit& u, int wr, int wc, int fr, int fq) const {
        const int row0 = u.pm * 256 + wr * 64 + fr; const int colt = (u.pn & 1) * 256 + wc * 32 + 8 * fq; const int kind = u.pn >> 1;
        f32x4 bv[2][2];
#pragma unroll
        for (int bj = 0; bj < 2; ++bj)
#pragma unroll
            for (int n = 0; n < 2; ++n) bv[bj][n] = kind == 0 ? *(const f32x4*)(w0 + colt + bj * 128 + 4 * n) : (kind == 1 ? *(const f32x4*)(a0 + colt + bj * 128 + 4 * n) : (f32x4){0.f, 0.f, 0.f, 0.f});
#pragma unroll
        EPI_LOOP_ROWS { const size_t ro = (size_t)(row0 + ai * 128 + m * 16) * 512 + colt;
#pragma unroll
            for (int bj = 0; bj < 2; ++bj) { f32x4 v0 = acc[ai][bj][m][0] + bv[bj][0], v1 = acc[ai][bj][m][1] + bv[bj][1];
                if (kind == 0) {
#pragma unroll
                    for (int j = 0; j < 4; ++j) { v0[j] = -0.60653066f * fsigmoid(v0[j]); v1[j] = -0.60653066f * fsigmoid(v1[j]); if (!RW_CHUNKED) { v0[j] = fexp(v0[j]); v1[j] = fexp(v1[j]); } }
                    float* W = (float*)(ws + WS_W); *(f32x4*)(W + ro + bj * 128) = v0; *(f32x4*)(W + ro + bj * 128 + 4) = v1;
                } else {
                    if (kind == 1) {
#pragma unroll
                        for (int j = 0; j < 4; ++j) { v0[j] = fsigmoid(v0[j]); v1[j] = fsigmoid(v1[j]); } }
                    u32x4 w; w.x = cvt_pk_bf16(v0[0], v0[1]); w.y = cvt_pk_bf16(v0[2], v0[3]); w.z = cvt_pk_bf16(v1[0], v1[1]); w.w = cvt_pk_bf16(v1[2], v1[3]);
                    const size_t bo = (kind == 1) ? WS_ASIG : WS_YB0; *(u32x4*)((bf16_t*)(ws + bo) + ro + bj * 128) = w; } } }
    }
};
struct EpiBranch {
    bf16_t* MERGED; const bf16_t* GATE;
    __device__ __forceinline__ bool keep(const pg8::Unit& u) const { return u.aux != 2; }
    __device__ __forceinline__ void operator()(acc_t& acc, const pg8::Unit& u, int wr, int wc, int fr, int fq) const {
        const int row0 = u.pm * 256 + wr * 64 + fr; const int colt = u.pn * 256 + wc * 32 + 8 * fq; const int br = u.aux;
#pragma unroll
        for (int ai = 0; ai < 2; ++ai) {
            u32x2 g[4][2], gn[4][2]; const unsigned char* G8 = (const unsigned char*)GATE;
#pragma unroll
            for (int m = 0; m < 4; ++m)
#pragma unroll
                for (int bj = 0; bj < 2; ++bj) { const size_t r = (size_t)(row0 + ai * 128 + m * 16); const int c = colt + bj * 128;
                    g[m][bj] = *(const u32x2*)(G8 + r * 3072 + br * 1024 + c);
                    gn[m][bj] = g[m][bj]; if (br != 2) gn[m][bj] = *(const u32x2*)(G8 + r * 3072 + (br + 1) * 1024 + c); }
#pragma unroll
            for (int m = 0; m < 4; ++m)
#pragma unroll
                for (int bj = 0; bj < 2; ++bj) { const u32x2 gg = g[m][bj], nn = gn[m][bj];
                    float s[8];
                    { float a[8], b[8];
#pragma unroll
                      for (int j = 0; j < 4; ++j) { a[j] = (float)((gg.x >> (8 * j)) & 0xffu); a[4 + j] = (float)((gg.y >> (8 * j)) & 0xffu); b[j] = (float)((nn.x >> (8 * j)) & 0xffu); b[4 + j] = (float)((nn.y >> (8 * j)) & 0xffu); }
#pragma unroll
                      for (int j = 0; j < 8; ++j) s[j] = (br != 2) ? a[j] * __builtin_amdgcn_rcpf(b[j]) : a[j] * (1.0f / 255.0f); }
                    f32x4 v0 = acc[ai][bj][m][0], v1 = acc[ai][bj][m][1];
                    v0[0] *= s[0]; v0[1] *= s[1]; v0[2] *= s[2]; v0[3] *= s[3]; v1[0] *= s[4]; v1[1] *= s[5]; v1[2] *= s[6]; v1[3] *= s[7];
                    acc[ai][bj][m][0] = v0; acc[ai][bj][m][1] = v1;
                    if (br == 2) { const size_t r = (size_t)(row0 + ai * 128 + m * 16); const int c = colt + bj * 128;
                        u32x4 w; w.x = cvt_pk_bf16(v0[0], v0[1]); w.y = cvt_pk_bf16(v0[2], v0[3]); w.z = cvt_pk_bf16(v1[0], v1[1]); w.w = cvt_pk_bf16(v1[2], v1[3]);
                        *(u32x4*)(MERGED + r * 1024 + c) = w; } }
        }
    }
};
struct EpiOut {
    EPI_NOKEEP
    const float* X; bf16_t* H1;
    __device__ __forceinline__ void operator()(acc_t& acc, const pg8::Unit& u, int wr, int wc, int fr, int fq) const {
        const int row0 = u.pm * 256 + wr * 64 + fr; const int colt = u.pn * 256 + wc * 32 + 8 * fq;
#pragma unroll
        for (int ai = 0; ai < 2; ++ai) {
            f32x4 x0[4][2], x1[4][2];
#pragma unroll
            for (int m = 0; m < 4; ++m)
#pragma unroll
                for (int bj = 0; bj < 2; ++bj) { const size_t ro = (size_t)(row0 + ai * 128 + m * 16) * 1024 + colt + bj * 128; x0[m][bj] = *(const f32x4*)(X + ro); x1[m][bj] = *(const f32x4*)(X + ro + 4); }
#pragma unroll
            for (int m = 0; m < 4; ++m)
#pragma unroll
                for (int bj = 0; bj < 2; ++bj) { const size_t ro = (size_t)(row0 + ai * 128 + m * 16) * 1024 + colt + bj * 128;
                    const f32x4 h0 = x0[m][bj] + acc[ai][bj][m][0], h1 = x1[m][bj] + acc[ai][bj][m][1];
                    u32x4 w; w.x = cvt_pk_bf16(h0[0], h0[1]); w.y = cvt_pk_bf16(h0[2], h0[3]); w.z = cvt_pk_bf16(h1[0], h1[1]); w.w = cvt_pk_bf16(h1[2], h1[3]);
                    *(u32x4*)(H1 + ro) = w; }
        }
    }
};
struct EpiUp {
    EPI_NOKEEP
    bf16_t* ACT; const float* b1; const float* slot_rs;
    __device__ __forceinline__ void operator()(acc_t& acc, const pg8::Unit& u, int wr, int wc, int fr, int fq) const {
        const int row0 = u.pm * 256 + wr * 64 + fr; const int colt = u.pn * 256 + wc * 32 + 8 * fq;
        const float* bb = b1 + (size_t)u.aux * 2048 + colt;
        f32x4 bv[2][2];
#pragma unroll
        for (int bj = 0; bj < 2; ++bj)
#pragma unroll
            for (int n = 0; n < 2; ++n) bv[bj][n] = *(const f32x4*)(bb + bj * 128 + 4 * n);
#pragma unroll
        EPI_LOOP_ROWS { const int r = row0 + ai * 128 + m * 16; const float rs = slot_rs[r] * (MOE_FP8 ? 1.0f / W8_SCALE : 1.0f);
#pragma unroll
            for (int bj = 0; bj < 2; ++bj) { const f32x4 v0 = acc[ai][bj][m][0] * rs + bv[bj][0], v1 = acc[ai][bj][m][1] * rs + bv[bj][1];
                float o[4];
#pragma unroll
                for (int p = 0; p < 4; ++p) { float gl = p < 2 ? v0[2 * p] : v1[2 * p - 4], ln = p < 2 ? v0[2 * p + 1] : v1[2 * p - 3];
                    gl = fminf(gl, 7.0f); ln = fminf(fmaxf(ln, -7.0f), 7.0f); o[p] = gl * fsigmoid(1.702f * gl) * (ln + 1.0f); }
                if (MOE_FP8) *(unsigned*)((unsigned char*)ACT + (size_t)r * 1024 + ((colt + bj * 128) >> 1)) = cvt_fp8x4(o[0], o[1], o[2], o[3]);
                else { u32x2 w; w.x = cvt_pk_bf16(o[0], o[1]); w.y = cvt_pk_bf16(o[2], o[3]);
                *(u32x2*)(ACT + (size_t)r * 1024 + ((colt + bj * 128) >> 1)) = w; } } }
    }
};
struct EpiDown {
    EPI_NOKEEP
    bf16_t* YS; const float* b2; const float* slot_g;
    __device__ __forceinline__ void operator()(acc_t& acc, const pg8::Unit& u, int wr, int wc, int fr, int fq) const {
        const int row0 = u.pm * 256 + wr * 64 + fr; const int colt = u.pn * 256 + wc * 32 + 8 * fq;
        const float* bb = b2 + (size_t)u.aux * 1024 + colt;
        const float ws_ = MOE_FP8 ? 1.0f / W8_SCALE : 1.0f;
        float gr[2][4];
#pragma unroll
        EPI_LOOP_ROWS gr[ai][m] = slot_g[row0 + ai * 128 + m * 16];
        f32x4 bq[2][2];
#pragma unroll
        for (int bj = 0; bj < 2; ++bj) { bq[bj][0] = *(const f32x4*)(bb + bj * 128); bq[bj][1] = *(const f32x4*)(bb + bj * 128 + 4); }
        asm volatile("s_waitcnt vmcnt(0)" ::: "memory");
#pragma unroll
        for (int bj = 0; bj < 2; ++bj) {
#pragma unroll
            EPI_LOOP_ROWS { const int r = row0 + ai * 128 + m * 16; const float g = gr[ai][m];
                const f32x4 v0 = (acc[ai][bj][m][0] * ws_ + bq[bj][0]) * g, v1 = (acc[ai][bj][m][1] * ws_ + bq[bj][1]) * g;
                if (YS_FP8) { u32x2 w8; w8.x = cvt_fp8x4(v0[0], v0[1], v0[2], v0[3]); w8.y = cvt_fp8x4(v1[0], v1[1], v1[2], v1[3]); *(u32x2*)((unsigned char*)YS + (size_t)r * 1024 + colt + bj * 128) = w8; }
                else { u32x4 w; w.x = cvt_pk_bf16(v0[0], v0[1]); w.y = cvt_pk_bf16(v0[2], v0[3]); w.z = cvt_pk_bf16(v1[0], v1[1]); w.w = cvt_pk_bf16(v1[2], v1[3]);
                *(u32x4*)(YS + (size_t)r * 1024 + colt + bj * 128) = w; } } }
    }
};
struct Args {
    const float* in[30]; float* out; unsigned char* ws; int ph_lo, ph_hi;
};
typedef __attribute__((address_space(4))) const unsigned char* kptr_t;
__device__ __forceinline__ kptr_t karg_at(int off) { asm volatile("" : "+s"(off)); return (kptr_t)__builtin_amdgcn_kernarg_segment_ptr() + off; }
struct KA {
    __device__ __forceinline__ const float* in(int i) const { return *(const float* const __attribute__((address_space(4)))*)karg_at(8 * i); }
    __device__ __forceinline__ float* out() const { return *(float* const __attribute__((address_space(4)))*)karg_at(240); }
    __device__ __forceinline__ unsigned char* ws() const { return *(unsigned char* const __attribute__((address_space(4)))*)karg_at(248); }
    __device__ __forceinline__ int ph_lo() const { return *(const int __attribute__((address_space(4)))*)karg_at(256); }
    __device__ __forceinline__ int ph_hi() const { return *(const int __attribute__((address_space(4)))*)karg_at(260); }
};
struct Ctx {
    LAS unsigned char* lds; int G, bid;
};
struct Ids { int tid, lane, wave; };
__device__ __forceinline__ Ids get_ids() { int t = threadIdx.x; asm volatile("" : "+v"(t)); Ids I; I.tid = t; I.lane = t & 63; I.wave = __builtin_amdgcn_readfirstlane(t >> 6); return I; }

#define XB_TMO      128
#define XB_XCNT(j)  (256  + 64 * (j))
#define XB_XSUB(j)  (1280 + 64 * (j))
#define XB_XGEN(j)  (2304 + 64 * (j))
#define XB_TOP      3328
#define XB_TOPGEN   3392
#define XCD_BAR_WORDS 3456
#define XB_SPIN_CAP (1u << 22)
__device__ __forceinline__ unsigned xb_ld(unsigned* p)              { return __hip_atomic_load(p, __ATOMIC_RELAXED, __HIP_MEMORY_SCOPE_AGENT); }
__device__ __forceinline__ unsigned xb_add(unsigned* p, unsigned v) { return __hip_atomic_fetch_add(p, v, __ATOMIC_RELAXED, __HIP_MEMORY_SCOPE_AGENT); }
__device__ __forceinline__ unsigned xb_xcc_id() { return (unsigned)__builtin_amdgcn_s_getreg((3 << 11) | 20) & 0xFu; }
#define XB_SPIN(cond, bar) do { unsigned _sp = 0; while (cond) { __builtin_amdgcn_s_sleep(1); \
    if ((++_sp & 255u) == 0u) { if (xb_ld(&(bar)[XB_TMO])) break; if (_sp > XB_SPIN_CAP) { atomicAdd(&(bar)[XB_TMO], 1u); break; } } } } while (0)
struct XcdBarrier { unsigned* bar; unsigned x; volatile LAS unsigned* st; };
__device__ __forceinline__ XcdBarrier xcd_barrier_post(unsigned* bar, volatile LAS unsigned* st) {
    XcdBarrier b; b.bar = bar; b.x = xb_xcc_id(); b.st = st;
    if (threadIdx.x == 0) (void)xb_add(&bar[XB_XCNT(b.x)], 1u);
    return b;
}
__device__ __forceinline__ void xcd_barrier_complete(unsigned* bar, unsigned x, unsigned& nloc, unsigned& nx) {
    const unsigned G = gridDim.x * gridDim.y * gridDim.z;
    unsigned sum, cnt, mine, sp = 0u;
    for (;;) {
        sum = 0u; cnt = 0u; mine = 0u;
#pragma unroll
        for (unsigned j = 0; j < 16; ++j) { const unsigned c = xb_ld(&bar[XB_XCNT(j)]); sum += c; cnt += (c > 0u) ? 1u : 0u; mine = (j == x) ? c : mine; }
        if (sum == G) break;
        __builtin_amdgcn_s_sleep(1);
        if ((++sp & 255u) == 0u) { if (xb_ld(&bar[XB_TMO])) break; if (sp > XB_SPIN_CAP) { atomicAdd(&bar[XB_TMO], 1u); break; } }
    }
    nloc = mine > 0u ? mine : 1u; nx = cnt > 0u ? cnt : 1u;
}
__device__ __forceinline__ void xcd_barrier(const XcdBarrier& b) {
    asm volatile("s_waitcnt vmcnt(0)" ::: "memory");
    __syncthreads();
    if (threadIdx.x == 0) {
        unsigned* bar = b.bar;
        __builtin_amdgcn_s_waitcnt(0);
        unsigned nloc = b.st[0], nx = b.st[1];
        if (nloc == 0u) { xcd_barrier_complete(bar, b.x, nloc, nx); b.st[0] = nloc; b.st[1] = nx; }
        const unsigned old = xb_add(&bar[XB_XSUB(b.x)], 1u);
        const unsigned gen = old / nloc;
        if (old + 1u == (gen + 1u) * nloc) {
            __builtin_amdgcn_fence(__ATOMIC_RELEASE, "agent");
            asm volatile("s_waitcnt vmcnt(0)" ::: "memory");
            const unsigned og = xb_add(&bar[XB_TOP], 1u);
            const unsigned tg = og / nx;
            if (og + 1u == (tg + 1u) * nx) xb_add(&bar[XB_TOPGEN], 1u);
            else XB_SPIN(xb_ld(&bar[XB_TOPGEN]) == tg, bar);
            __builtin_amdgcn_fence(__ATOMIC_ACQUIRE, "agent");
            xb_add(&bar[XB_XGEN(b.x)], 1u);
            asm volatile("s_waitcnt vmcnt(0)" ::: "memory");
        } else {
            XB_SPIN(xb_ld(&bar[XB_XGEN(b.x)]) == gen, bar);
            __builtin_amdgcn_fence(__ATOMIC_ACQUIRE, "agent");
            asm volatile("s_waitcnt vmcnt(0)" ::: "memory");
        }
    }
    __syncthreads();
}

struct TItem { const float* W; bf16_t* WT; const float* ksc; int K, N, row_off, item; int f8; };
__device__ __forceinline__ void t_load(const TItem& t, float (&v)[32], int lane) {
    const int nblk = t.N / 32, kb = t.item / nblk, nb = t.item % nblk, k0 = 64 * kb, n0 = 32 * nb;
    const float* p = t.W + (size_t)(k0 + (lane >> 5)) * t.N + n0 + (lane & 31);
#pragma unroll
    for (int i = 0; i < 32; ++i) v[i] = __builtin_nontemporal_load(p + (size_t)(2 * i) * t.N);
}
__device__ __forceinline__ void t_store(const TItem& t, const float (&v)[32], LAS float* scr, int lane) {
    const int nblk = t.N / 32, kb = t.item / nblk, nb = t.item % nblk, k0 = 64 * kb, n0 = 32 * nb;
#pragma unroll
    for (int i = 0; i < 32; ++i) { const int kk = 2 * i + (lane >> 5); float x = v[i]; if (t.ksc) x *= t.ksc[k0 + kk]; scr[kk * 33 + (lane & 31)] = x; }
    LDS_WAIT(); asm volatile("" ::: "memory");
    const int c = lane & 7;
#pragma unroll
    for (int j = 0; j < 4; ++j) { const int n = (lane >> 3) + 8 * j; const LAS float* s = scr + (8 * c) * 33 + n;
        if (t.f8) { u32x2 o; o.x = cvt_fp8x4(s[0 * 33] * W8_SCALE, s[1 * 33] * W8_SCALE, s[2 * 33] * W8_SCALE, s[3 * 33] * W8_SCALE); o.y = cvt_fp8x4(s[4 * 33] * W8_SCALE, s[5 * 33] * W8_SCALE, s[6 * 33] * W8_SCALE, s[7 * 33] * W8_SCALE);
            *(u32x2*)((unsigned char*)t.WT + (size_t)(t.row_off + n0 + n) * t.K + k0 + 8 * c) = o; }
        else { u32x4 o; o.x = pk2(s[0 * 33], s[1 * 33]); o.y = pk2(s[2 * 33], s[3 * 33]); o.z = pk2(s[4 * 33], s[5 * 33]); o.w = pk2(s[6 * 33], s[7 * 33]);
        *(u32x4*)(t.WT + (size_t)(t.row_off + n0 + n) * t.K + k0 + 8 * c) = o; } }
    LDS_WAIT(); asm volatile("" ::: "memory");
}
__device__ __forceinline__ void rms_row_to_bf16(const float* xrow, const float* w, bf16_t* orow, int lane, unsigned char* o8row) {
    const f32x4* xr = (const f32x4*)xrow + lane; const f32x4* wr = (const f32x4*)w + lane;
    f32x4 v[4], wv[4]; float s = 0.f;
#pragma unroll
    for (int j = 0; j < 4; ++j) { v[j] = xr[64 * j]; wv[j] = wr[64 * j]; }
#pragma unroll
    for (int j = 0; j < 4; ++j) s += (v[j].x * v[j].x + v[j].y * v[j].y) + (v[j].z * v[j].z + v[j].w * v[j].w);
    const float rstd = 1.f / sqrtf(wave_sum(s) * (1.f / 1024.f) + 1e-5f);
    u32x2* o8 = (u32x2*)orow + lane;
#pragma unroll
    for (int j = 0; j < 4; ++j) { const f32x4 ww = wv[j]; const float y0 = v[j].x * rstd * ww.x, y1 = v[j].y * rstd * ww.y, y2 = v[j].z * rstd * ww.z, y3 = v[j].w * rstd * ww.w;
        u32x2 o; o.x = pk2(y0, y1); o.y = pk2(y2, y3); if (orow) o8[64 * j] = o; if (o8row) ((unsigned*)o8row)[lane + 64 * j] = cvt_fp8x4(y0, y1, y2, y3); }
}
__device__ __forceinline__ void phase0(const KA& a, const Ctx& C) {
    const Ids I = get_ids();
    unsigned char* ws = a.ws();
    LAS float* scr = (LAS float*)(C.lds + I.wave * 16384);
    const int gw = C.bid * NWAVES + I.wave, NGW = C.G * NWAVES;
    bf16_t* WBIG = (bf16_t*)(ws + WS_WBIG); bf16_t* WMKV = (bf16_t*)(ws + WS_WMKV); bf16_t* WBR = (bf16_t*)(ws + WS_WBR); bf16_t* WOUT = (bf16_t*)(ws + WS_WOUT);
    bf16_t* W1T = (bf16_t*)(ws + WS_W1T); bf16_t* W2T = (bf16_t*)(ws + WS_W2T);
    constexpr int I_IN = 16 * 96, I_G = 16 * 32, I_MKV = 16 * 32, I_BR = 8 * 32, I_OUT = 16 * 32, I_E1 = 16 * 64, I_E2 = 16 * 32;
    constexpr int NITEMS = I_IN + 3 * I_G + I_MKV + 3 * I_BR + I_OUT;
    auto decode = [&](int it) -> TItem {
        TItem t; int r = it; t.ksc = nullptr; t.row_off = 0; t.K = 1024; t.N = 1024; t.f8 = 0;
        if (r < I_IN) { t.W = a.in(4); t.N = 3072; t.WT = WBIG; t.item = r; t.f8 = G1_FP8; return t; } r -= I_IN;
        if (r < 3 * I_G) { const int g = r / I_G; t.W = a.in(19) + (size_t)g * 1024 * 1024; t.WT = (bf16_t*)(ws + WS_WG8); t.row_off = 1024 * g; t.item = r % I_G; t.f8 = 1; return t; } r -= 3 * I_G;
        if (r < I_MKV) { t.W = a.in(18); t.WT = WMKV; t.item = r; return t; } r -= I_MKV;
        if (r < 3 * I_BR) { const int g = r / I_BR; t.W = a.in(20) + (size_t)g * 512 * 1024; t.K = 512; t.WT = WBR + (size_t)g * 1024 * 512; t.item = r % I_BR; return t; } r -= 3 * I_BR;
        if (r < I_OUT) { t.W = a.in(21); t.WT = WOUT; t.item = r; return t; } r -= I_OUT;
        if (r < NEXP * I_E1) { const int e = r / I_E1; t.W = a.in(25) + (size_t)e * 1024 * 2048; t.N = 2048; t.WT = (bf16_t*)((unsigned char*)W1T + (size_t)e * 2048 * 1024 * (MOE_FP8 ? 1 : 2)); t.ksc = a.in(22); t.item = r % I_E1; t.f8 = MOE_FP8; return t; } r -= NEXP * I_E1;
        { const int e = r / I_E2; t.W = a.in(27) + (size_t)e * 1024 * 1024; t.WT = (bf16_t*)((unsigned char*)W2T + (size_t)e * 1024 * 1024 * (MOE_FP8 ? 1 : 2)); t.item = r % I_E2; t.f8 = MOE_FP8; return t; }
    };
    {
        float va[32], vb[32];
        int it = gw;
        TItem ta, tb;
        if (it < NITEMS) { ta = decode(it); t_load(ta, va, I.lane); }
        while (it < NITEMS) {
            const int it2 = it + NGW;
            if (it2 < NITEMS) { tb = decode(it2); t_load(tb, vb, I.lane); }
            t_store(ta, va, scr, I.lane);
            it = it2;
            if (it < NITEMS) {
                const int it3 = it + NGW;
                if (it3 < NITEMS) { ta = decode(it3); t_load(ta, va, I.lane); }
                t_store(tb, vb, scr, I.lane);
                it = it3;
            }
        }
    }
    { bf16_t* WRW = (bf16_t*)(ws + WS_WRW); const float* w2 = a.in(8); const float* a2 = a.in(10); const float* g2 = a.in(11);
      for (int i = C.bid * 512 + I.tid; i < 1536 * 256; i += C.G * 512) { const int n = i >> 8, k = i & 255; float v = 0.f;
          if (n < 512) { if (k < 64) v = w2[k * 512 + n]; } else if (n < 1024) { if (k >= 64 && k < 128) v = a2[(k - 64) * 512 + (n - 512)]; } else { if (k >= 128) v = g2[(k - 128) * 512 + (n - 1024)]; }
          WRW[i] = (bf16_t)f2bf(v); } }
    { bf16_t* WRT = (bf16_t*)(ws + MS_WRT); const float* wr = a.in(23); const float* fw = a.in(22);
      for (int i = C.bid * 512 + I.tid; i < 32 * 1024; i += C.G * 512) { const int e = i >> 10, k = i & 1023; const float v = wr[k * 32 + e] * fw[k];
          const unsigned hi = f2bf(v); const float lo = v - __builtin_bit_cast(float, hi << 16); WRT[i] = (bf16_t)hi; WRT[32 * 1024 + i] = (bf16_t)f2bf(lo); } }
    bf16_t* XN = (bf16_t*)(ws + WS_XN); bf16_t* MEMN = (bf16_t*)(ws + WS_MEMN);
    { const float* X = a.in(0); const f32x4* wr = (const f32x4*)a.in(2) + I.lane; f32x4 ww[4];
#pragma unroll
      for (int j = 0; j < 4; ++j) ww[j] = wr[64 * j];
      f32x4 v[4], vn[4];
      if (gw < NTOK) {
#pragma unroll
          for (int j = 0; j < 4; ++j) v[j] = __builtin_nontemporal_load((const f32x4*)(X + (size_t)gw * 1024) + I.lane + 64 * j); }
      for (int m = gw; m < NTOK; m += NGW) {
          const int mn = m + NGW;
          if (mn < NTOK) {
#pragma unroll
              for (int j = 0; j < 4; ++j) vn[j] = __builtin_nontemporal_load((const f32x4*)(X + (size_t)mn * 1024) + I.lane + 64 * j); }
          float s = 0.f;
#pragma unroll
          for (int j = 0; j < 4; ++j) s += (v[j].x * v[j].x + v[j].y * v[j].y) + (v[j].z * v[j].z + v[j].w * v[j].w);
          const float rstd = 1.f / sqrtf(wave_sum(s) * (1.f / 1024.f) + 1e-5f);
#pragma unroll
          for (int j = 0; j < 4; ++j) { const float y0 = v[j].x * rstd * ww[j].x, y1 = v[j].y * rstd * ww[j].y, y2 = v[j].z * rstd * ww[j].z, y3 = v[j].w * rstd * ww[j].w;
              if (!G1_FP8) { u32x2 o; o.x = pk2(y0, y1); o.y = pk2(y2, y3); ((u32x2*)(XN + (size_t)m * 1024) + I.lane)[64 * j] = o; }
              ((unsigned*)(ws + WS_XN8 + (size_t)m * 1024))[I.lane + 64 * j] = cvt_fp8x4(y0, y1, y2, y3); }
#pragma unroll
          for (int j = 0; j < 4; ++j) v[j] = vn[j];
      } }
    for (int m = gw; m < NMEM; m += NGW) rms_row_to_bf16(a.in(1) + (size_t)m * 1024, a.in(3), MEMN + (size_t)m * 1024, I.lane, nullptr);
}
__device__ __forceinline__ void t_load4(const TItem& t, f32x4 (&v)[8], int lane) {
    const int nblk = t.N / 32, kb = t.item / nblk, nb = t.item % nblk, k0 = 64 * kb, n0 = 32 * nb;
    const float* p = t.W + (size_t)(k0 + (lane >> 3)) * t.N + n0 + 4 * (lane & 7);
#pragma unroll
    for (int i = 0; i < 8; ++i) v[i] = *(const f32x4*)(p + (size_t)(8 * i) * t.N);
}
__device__ __forceinline__ void t_store4(const TItem& t, const f32x4 (&v)[8], LAS float* scr, int lane) {
    const int nblk = t.N / 32, kb = t.item / nblk, nb = t.item % nblk, k0 = 64 * kb, n0 = 32 * nb;
#pragma unroll
    for (int i = 0; i < 8; ++i) { const int kk = 8 * i + (lane >> 3); f32x4 x = v[i]; if (t.ksc) x = x * t.ksc[k0 + kk];
        LAS float* d = scr + kk * 33 + 4 * (lane & 7); d[0] = x[0]; d[1] = x[1]; d[2] = x[2]; d[3] = x[3]; }
    LDS_WAIT(); asm volatile("" ::: "memory");
    const int c = lane & 7;
#pragma unroll
    for (int j = 0; j < 4; ++j) { const int n = (lane >> 3) + 8 * j; const LAS float* s = scr + (8 * c) * 33 + n;
        if (t.f8) { u32x2 o; o.x = cvt_fp8x4(s[0 * 33] * W8_SCALE, s[1 * 33] * W8_SCALE, s[2 * 33] * W8_SCALE, s[3 * 33] * W8_SCALE); o.y = cvt_fp8x4(s[4 * 33] * W8_SCALE, s[5 * 33] * W8_SCALE, s[6 * 33] * W8_SCALE, s[7 * 33] * W8_SCALE);
            *(u32x2*)((unsigned char*)t.WT + (size_t)(t.row_off + n0 + n) * t.K + k0 + 8 * c) = o; }
        else { u32x4 o; o.x = pk2(s[0 * 33], s[1 * 33]); o.y = pk2(s[2 * 33], s[3 * 33]); o.z = pk2(s[4 * 33], s[5 * 33]); o.w = pk2(s[6 * 33], s[7 * 33]);
        *(u32x4*)(t.WT + (size_t)(t.row_off + n0 + n) * t.K + k0 + 8 * c) = o; } }
    LDS_WAIT(); asm volatile("" ::: "memory");
}
__device__ __forceinline__ void phase0_moe(const KA& a, const Ctx& C) {
    const Ids I = get_ids();
    unsigned char* ws = a.ws();
    LAS float* scr = (LAS float*)(C.lds + I.wave * 16384);
    bf16_t* W1T = (bf16_t*)(ws + WS_W1T); bf16_t* W2T = (bf16_t*)(ws + WS_W2T);
    constexpr int I_E1 = 16 * 64, I_E2 = 16 * 32, NM = NEXP * (I_E1 + I_E2), NCH = 16;
    unsigned* ctr = (unsigned*)(ws + WS_CTL) + CW_MOEW;
    auto decode = [&](int r) -> TItem {
        TItem t; t.ksc = nullptr; t.row_off = 0; t.K = 1024; t.N = 1024; t.f8 = MOE_FP8;
        if (r < NEXP * I_E1) { const int e = r / I_E1; t.W = a.in(25) + (size_t)e * 1024 * 2048; t.N = 2048; t.WT = (bf16_t*)((unsigned char*)W1T + (size_t)e * 2048 * 1024 * (MOE_FP8 ? 1 : 2)); t.ksc = a.in(22); t.item = r % I_E1; return t; } r -= NEXP * I_E1;
        { const int e = r / I_E2; t.W = a.in(27) + (size_t)e * 1024 * 1024; t.WT = (bf16_t*)((unsigned char*)W2T + (size_t)e * 1024 * 1024 * (MOE_FP8 ? 1 : 2)); t.item = r % I_E2; return t; }
    };
    __syncthreads();
    for (;;) {
        unsigned c0 = 0u; if (I.lane == 0) c0 = __hip_atomic_fetch_add(ctr, (unsigned)NCH, __ATOMIC_RELAXED, __HIP_MEMORY_SCOPE_AGENT);
        const int c = __builtin_amdgcn_readfirstlane((int)c0);
        if (c >= NM) break;
        f32x4 v0[8], v1[8], v2[8], v3[8];
        t_load4(decode(c), v0, I.lane); t_load4(decode(c + 1), v1, I.lane); t_load4(decode(c + 2), v2, I.lane);
#pragma unroll 1
        for (int j = 0; j < NCH; j += 4) {
            t_load4(decode(c + j + 3), v3, I.lane); t_store4(decode(c + j), v0, scr, I.lane);
            if (j + 4 < NCH) t_load4(decode(c + j + 4), v0, I.lane); t_store4(decode(c + j + 1), v1, scr, I.lane);
            if (j + 5 < NCH) t_load4(decode(c + j + 5), v1, I.lane); t_store4(decode(c + j + 2), v2, scr, I.lane);
            if (j + 6 < NCH) t_load4(decode(c + j + 6), v2, I.lane); t_store4(decode(c + j + 3), v3, scr, I.lane); }
    }
    __syncthreads();
}

__device__ __forceinline__ void phase_lerp(const KA& a, const Ctx& C) {
    const Ids I = get_ids();
    unsigned char* ws = a.ws();
    const bf16_t* P = (const bf16_t*)(ws + WS_P); const float* mu = a.in(6); bf16_t* LIN = (bf16_t*)(ws + WS_LIN);
    const int gw = C.bid * NWAVES + I.wave, NGW = C.G * NWAVES;
    const int c = 192 + (I.lane & 31), col0 = c * 8, half = I.lane >> 5;
    const f32x4 m0 = *(const f32x4*)(mu + c * 8), m1 = *(const f32x4*)(mu + c * 8 + 4);
    u32x4 pa, pb, na, nb;
#define LERP_LOAD(q, A, B) do { const int _m = 2 * (q) + half; const bf16_t* _cur = P + (size_t)_m * 3072 + col0; A = *(const u32x4*)_cur; B = (u32x4){0u, 0u, 0u, 0u}; if ((_m & (SEQ - 1)) != 0) B = *(const u32x4*)(_cur - 3072); } while (0)
    if (gw < NTOK / 2) LERP_LOAD(gw, pa, pb);
    for (int q = gw; q < NTOK / 2; q += NGW) {
        if (q + NGW < NTOK / 2) LERP_LOAD(q + NGW, na, nb);
        const int m = 2 * q + half; const u32x4 qa = pa, qb = pb;
        float v[8];
        v[0] = bf_lo(qa.x) + (bf_lo(qb.x) - bf_lo(qa.x)) * m0[0]; v[1] = bf_hi(qa.x) + (bf_hi(qb.x) - bf_hi(qa.x)) * m0[1];
        v[2] = bf_lo(qa.y) + (bf_lo(qb.y) - bf_lo(qa.y)) * m0[2]; v[3] = bf_hi(qa.y) + (bf_hi(qb.y) - bf_hi(qa.y)) * m0[3];
        v[4] = bf_lo(qa.z) + (bf_lo(qb.z) - bf_lo(qa.z)) * m1[0]; v[5] = bf_hi(qa.z) + (bf_hi(qb.z) - bf_hi(qa.z)) * m1[1];
        v[6] = bf_lo(qa.w) + (bf_lo(qb.w) - bf_lo(qa.w)) * m1[2]; v[7] = bf_hi(qa.w) + (bf_hi(qb.w) - bf_hi(qa.w)) * m1[3];
        if (col0 < 1600) {
#pragma unroll
            for (int j = 0; j < 8; ++j) { const float e2 = fexp(2.0f * v[j]); v[j] = 1.0f - 2.0f * __builtin_amdgcn_rcpf(e2 + 1.0f); }
        } else if (col0 >= 1664) {
#pragma unroll
            for (int j = 0; j < 8; ++j) v[j] = fsigmoid(v[j]);
        }
        u32x4 o; o.x = pk2(v[0], v[1]); o.y = pk2(v[2], v[3]); o.z = pk2(v[4], v[5]); o.w = pk2(v[6], v[7]);
        *(u32x4*)(LIN + (size_t)m * 256 + (col0 - 1536)) = o;
        pa = na; pb = nb;
    }
#undef LERP_LOAD
}

__device__ __forceinline__ s16x4 vtr(LAS const unsigned char* p) { typedef short v4i16_t __attribute__((ext_vector_type(4))); return __builtin_bit_cast(s16x4, __builtin_amdgcn_ds_read_tr16_b64_v4i16((LAS v4i16_t*)p)); }
template <int DH, int NKT, int KP, bool SWA>
__device__ __forceinline__ void attn_qtile(const bf16x8 (&qf)[DH / 32], LAS const unsigned char* Kl, LAS const unsigned char* Vl, int lane, float scale,
                                           int t, int s0, int smin, float slope, float sink, f32x4 (&o)[DH / 16]) {
    const int fr = lane & 15, fq = lane >> 4;
    f32x4 s[NKT];
#pragma unroll
    for (int kt = 0; kt < NKT; ++kt) { s[kt] = (f32x4){0.f, 0.f, 0.f, 0.f};
#pragma unroll
        for (int ks = 0; ks < DH / 32; ++ks) { const bf16x8 kf = *(const LAS bf16x8*)(Kl + (kt * 16 + fr) * KP + (ks * 32 + fq * 8) * 2);
            s[kt] = __builtin_amdgcn_mfma_f32_16x16x32_bf16(kf, qf[ks], s[kt], 0, 0, 0); } }
    float mx = -1e30f;
#pragma unroll
    for (int kt = 0; kt < NKT; ++kt)
#pragma unroll
        for (int r = 0; r < 4; ++r) { float v = s[kt][r] * scale;
            if (SWA) { const int sp = s0 + kt * 16 + fq * 4 + r; const int dist = t - sp; const bool valid = (dist >= 0) && (dist < 128) && (sp >= smin); v = valid ? v - slope * (float)dist : -1e30f; }
            s[kt][r] = v; mx = fmaxf(mx, v); }
    mx = fmaxf(mx, __shfl_xor(mx, 16)); mx = fmaxf(mx, __shfl_xor(mx, 32));
    if (SWA) mx = fmaxf(mx, sink);
    float sum = 0.f;
#pragma unroll
    for (int kt = 0; kt < NKT; ++kt)
#pragma unroll
        for (int r = 0; r < 4; ++r) { const float p = fexp(s[kt][r] - mx); s[kt][r] = p; sum += p; }
    sum += __shfl_xor(sum, 16); sum += __shfl_xor(sum, 32);
    if (SWA) sum += fexp(sink - mx);
    const float inv = 1.0f / sum;
#pragma unroll
    for (int dt = 0; dt < DH / 16; ++dt) o[dt] = (f32x4){0.f, 0.f, 0.f, 0.f};
    const int q4 = fr >> 2, p4 = fr & 3;
#pragma unroll
    for (int c = 0; c < NKT / 2; ++c) {
        u32x4 pw; pw.x = cvt_pk_bf16(s[2 * c][0], s[2 * c][1]); pw.y = cvt_pk_bf16(s[2 * c][2], s[2 * c][3]); pw.z = cvt_pk_bf16(s[2 * c + 1][0], s[2 * c + 1][1]); pw.w = cvt_pk_bf16(s[2 * c + 1][2], s[2 * c + 1][3]);
        const bf16x8 pf = __builtin_bit_cast(bf16x8, pw);
#pragma unroll
        for (int dt = 0; dt < DH / 16; ++dt) {
            const s16x4 lo = vtr(Vl + (c * 32 + fq * 4 + q4) * KP + (dt * 16 + p4 * 4) * 2);
            const s16x4 hi = vtr(Vl + (c * 32 + 16 + fq * 4 + q4) * KP + (dt * 16 + p4 * 4) * 2);
            bf16x8 vf; vf[0] = lo[0]; vf[1] = lo[1]; vf[2] = lo[2]; vf[3] = lo[3]; vf[4] = hi[0]; vf[5] = hi[1]; vf[6] = hi[2]; vf[7] = hi[3];
            o[dt] = __builtin_amdgcn_mfma_f32_16x16x32_bf16(vf, pf, o[dt], 0, 0, 0); } }
#pragma unroll
    for (int dt = 0; dt < DH / 16; ++dt) o[dt] = o[dt] * inv;
}

__device__ __forceinline__ void phase_swa(const KA& a, const Ctx& C) {
    const Ids I = get_ids();
    unsigned char* ws = a.ws();
    const bf16_t* P = (const bf16_t*)(ws + WS_P); bf16_t* Y = (bf16_t*)(ws + WS_YB1); const float* sinks = a.in(17);
    constexpr int KP = 144, ROWS = 272;
    LAS unsigned char* Kl = C.lds; LAS unsigned char* Vl = C.lds + ROWS * KP;
    for (int u = C.bid; u < BATCH * 2 * 32; u += C.G) {
        const int qb = u & 31, hk = (u >> 5) & 1, b = u >> 6;
        const int pos0 = qb * 128 - 128;
        __syncthreads();
        { u32x4 vst[9];
#pragma unroll
          for (int u = 0; u < 9; ++u) { const int i = I.tid + 512 * u; const int which = i >= ROWS * 8; const int j = which ? i - ROWS * 8 : i; const int r = j >> 3, ch = j & 7; const int pos = pos0 + r;
              vst[u] = (u32x4){0u, 0u, 0u, 0u};
              if (i < ROWS * 8 * 2 && pos >= 0 && r < 256) vst[u] = *(const u32x4*)(P + (size_t)(b * SEQ + pos) * 3072 + SWA_OFF + 512 + which * 128 + hk * 64 + ch * 8); }
#pragma unroll
          for (int u = 0; u < 9; ++u) { const int i = I.tid + 512 * u; const int which = i >= ROWS * 8; const int j = which ? i - ROWS * 8 : i; const int r = j >> 3, ch = j & 7;
              if (i < ROWS * 8 * 2) *(LAS u32x4*)((which ? Vl : Kl) + r * KP + ch * 16) = vst[u]; } }
        __syncthreads();
        const int g = I.wave >> 1, half = I.wave & 1, h = hk * 4 + g;
        const float slope = __builtin_amdgcn_exp2f(-(float)(h + 1)); const float sink = sinks[h];
        const int fr = I.lane & 15, fq = I.lane >> 4;
#pragma unroll 1
        for (int qt = 0; qt < 4; ++qt) {
            const int trel = half * 64 + qt * 16;
            const int tq = qb * 128 + trel + fr;
            const bf16_t* qrow = P + (size_t)(b * SEQ + tq) * 3072 + SWA_OFF + h * 64;
            bf16x8 qf[2]; qf[0] = *(const bf16x8*)(qrow + fq * 8); qf[1] = *(const bf16x8*)(qrow + 32 + fq * 8);
            f32x4 o[4];
            attn_qtile<64, 10, KP, true>(qf, Kl + trel * KP, Vl + trel * KP, I.lane, 0.125f, tq, pos0 + trel, 0, slope, sink, o);
            bf16_t* yrow = Y + (size_t)(b * SEQ + tq) * 512 + h * 64;
#pragma unroll
            for (int dt = 0; dt < 4; ++dt) { u32x2 w; w.x = cvt_pk_bf16(o[dt][0], o[dt][1]); w.y = cvt_pk_bf16(o[dt][2], o[dt][3]); *(u32x2*)(yrow + dt * 16 + fq * 4) = w; }
        }
    }
    __syncthreads();
}

__device__ __forceinline__ void phase_mem(const KA& a, const Ctx& C) {
    const Ids I = get_ids();
    unsigned char* ws = a.ws();
    const bf16_t* P = (const bf16_t*)(ws + WS_P); const bf16_t* KVM = (const bf16_t*)(ws + WS_KVM); bf16_t* Y = (bf16_t*)(ws + WS_YB2);
    constexpr int KP = 272, ROWS = 256;
    LAS unsigned char* Kl = C.lds; LAS unsigned char* Vl = C.lds + ROWS * KP;
    for (int u = C.bid; u < BATCH * 4 * 8; u += C.G) {
        const int qb = u & 7, h = (u >> 3) & 3, b = u >> 5;
        __syncthreads();
#pragma unroll 1
        for (int i0 = I.tid; i0 < ROWS * 16 * 2; i0 += 512 * 8) { u32x4 vst[8];
#pragma unroll
            for (int u = 0; u < 8; ++u) { const int i = i0 + 512 * u; const int which = i >= ROWS * 16; const int j = which ? i - ROWS * 16 : i; const int r = j >> 4, ch = j & 15;
                vst[u] = *(const u32x4*)(KVM + (size_t)(b * MEM_LEN + r) * 1024 + which * 512 + h * 128 + ch * 8); }
#pragma unroll
            for (int u = 0; u < 8; ++u) { const int i = i0 + 512 * u; const int which = i >= ROWS * 16; const int j = which ? i - ROWS * 16 : i; const int r = j >> 4, ch = j & 15;
                *(LAS u32x4*)((which ? Vl : Kl) + r * KP + ch * 16) = vst[u]; } }
        __syncthreads();
        const int fr = I.lane & 15, fq = I.lane >> 4;
#pragma unroll 1
        for (int qt = 0; qt < 4; ++qt) {
            const int tq = qb * 512 + I.wave * 64 + qt * 16 + fr;
            const bf16_t* qrow = P + (size_t)(b * SEQ + tq) * 3072 + MEMQ_OFF + h * 128;
            bf16x8 qf[4];
#pragma unroll
            for (int ks = 0; ks < 4; ++ks) qf[ks] = *(const bf16x8*)(qrow + ks * 32 + fq * 8);
            f32x4 o[8];
            attn_qtile<128, 16, KP, false>(qf, Kl, Vl, I.lane, 0.08838834764831845f, 0, 0, 0, 0.f, 0.f, o);
            bf16_t* yrow = Y + (size_t)(b * SEQ + tq) * 512 + h * 128;
#pragma unroll
            for (int dt = 0; dt < 8; ++dt) { u32x2 w; w.x = cvt_pk_bf16(o[dt][0], o[dt][1]); w.y = cvt_pk_bf16(o[dt][2], o[dt][3]); *(u32x2*)(yrow + dt * 16 + fq * 4) = w; }
        }
    }
    __syncthreads();
}
__device__ __forceinline__ float dpp_add16(float x) {
    x += __builtin_bit_cast(float, __builtin_amdgcn_update_dpp(0, __builtin_bit_cast(int, x), 0xB1, 0xF, 0xF, true));
    x += __builtin_bit_cast(float, __builtin_amdgcn_update_dpp(0, __builtin_bit_cast(int, x), 0x4E, 0xF, 0xF, true));
    x += __builtin_bit_cast(float, __builtin_amdgcn_update_dpp(0, __builtin_bit_cast(int, x), 0x124, 0xF, 0xF, true));
    x += __builtin_bit_cast(float, __builtin_amdgcn_update_dpp(0, __builtin_bit_cast(int, x), 0x128, 0xF, 0xF, true));
    return x;
}
struct RwRaw { u32x2 r, kr, as, v; f32x4 w; };
struct RwOps { f32x4 w4, a4, b4, k4, r4; float vv; };
__device__ __forceinline__ void phase_rwkv(const KA& a, const Ctx& C) {
    const Ids I = get_ids();
    unsigned char* ws = a.ws();
    const bf16_t* R = (const bf16_t*)(ws + WS_R); const bf16_t* KR = (const bf16_t*)(ws + WS_KR); const bf16_t* V = (const bf16_t*)(ws + WS_V); const bf16_t* ASIG = (const bf16_t*)(ws + WS_ASIG);
    const float* W = (const float*)(ws + WS_W); float* YRAW = (float*)(ws + WS_YRAW); float* BONUS = (float*)(ws + MS_BONUS);
    const float* k_k = a.in(12); const float* k_a = a.in(13); const float* r_k = a.in(14);
    constexpr int TC = 32, NCH = SEQ / TC;
    LAS float* SEQB = (LAS float*)C.lds;
    LAS float* VB = (LAS float*)(C.lds + 2 * TC * 5 * 64 * 4);
    LAS float* YO = VB + 2 * TC * 16;
    LAS float* DUMMY = YO + 2 * TC * 16;
    for (int item = C.bid; item < BATCH * 8 * 4; item += C.G) {
        const int rg = item & 3, h = (item >> 2) & 7, b = item >> 5;
        const int colh = h * 64; const size_t row0 = (size_t)b * SEQ;
        const bool loader = I.wave >= 4; const int lw = I.wave - 4;
        const int g4 = I.lane >> 4, q = I.lane & 15;
        f32x4 kkc = (f32x4){0.f, 0.f, 0.f, 0.f}, kac = kkc, rkc = kkc;
        if (loader) { kkc = *(const f32x4*)(k_k + colh + 4 * q); kac = *(const f32x4*)(k_a + colh + 4 * q); rkc = *(const f32x4*)(r_k + colh + 4 * q); }
        f32x2 s01 = (f32x2){0.f, 0.f}, s23 = s01;
        const int crow = I.tid >> 4, kq = I.tid & 15;
        RwRaw cur[2], nxt[2];
#define RW_LOAD(cn, raw) do { _Pragma("unroll") for (int j = 0; j < 2; ++j) { const size_t m = row0 + (size_t)(cn) * TC + lw * 8 + j * 4 + g4; const size_t o = m * 512 + colh + 4 * q; \
            raw[j].r = *(const u32x2*)(R + o); raw[j].kr = *(const u32x2*)(KR + o); raw[j].as = *(const u32x2*)(ASIG + o); raw[j].w = *(const f32x4*)(W + o); \
            raw[j].v = *(const u32x2*)(V + m * 512 + colh + rg * 16 + 4 * (q & 3)); } } while (0)
        if (loader) RW_LOAD(0, cur);
        __syncthreads();
#pragma unroll 1
        for (int c = -1; c < NCH; ++c) {
            if (loader) {
                if (c + 2 < NCH) RW_LOAD(c + 2, nxt);
                if (c + 1 < NCH) {
                    const int buf = (c + 1) & 1;
#pragma unroll
                    for (int j = 0; j < 2; ++j) { const int tl = lw * 8 + j * 4 + g4;
                        const f32x4 r = (f32x4){bf_lo(cur[j].r.x), bf_hi(cur[j].r.x), bf_lo(cur[j].r.y), bf_hi(cur[j].r.y)};
                        const f32x4 kr = (f32x4){bf_lo(cur[j].kr.x), bf_hi(cur[j].kr.x), bf_lo(cur[j].kr.y), bf_hi(cur[j].kr.y)};
                        const f32x4 as = (f32x4){bf_lo(cur[j].as.x), bf_hi(cur[j].as.x), bf_lo(cur[j].as.y), bf_hi(cur[j].as.y)};
                        const f32x4 kkv = kr * kkc;
                        const float n2 = dpp_add16((kkv[0] * kkv[0] + kkv[1] * kkv[1]) + (kkv[2] * kkv[2] + kkv[3] * kkv[3]));
                        const f32x4 kkn = kkv * (1.0f / fmaxf(sqrtf(n2), 1e-12f));
                        const f32x4 kmod = kr * ((as - 1.0f) * kac + 1.0f);
                        LAS float* d = SEQB + ((buf * TC + tl) * 5) * 64 + 4 * q;
                        *(LAS f32x4*)(d) = cur[j].w; *(LAS f32x4*)(d + 64) = -kkn; *(LAS f32x4*)(d + 128) = kkn * as; *(LAS f32x4*)(d + 192) = kmod; *(LAS f32x4*)(d + 256) = r;
                        if (q < 4) *(LAS f32x4*)(VB + (buf * TC + tl) * 16 + 4 * q) = (f32x4){bf_lo(cur[j].v.x), bf_hi(cur[j].v.x), bf_lo(cur[j].v.y), bf_hi(cur[j].v.y)};
                        if (rg == 0) { const f32x4 t = r * kmod * rkc; const float bs = dpp_add16((t[0] + t[1]) + (t[2] + t[3])); if (q == 0) BONUS[(row0 + (size_t)(c + 1) * TC + tl) * 8 + h] = bs; } }
                }
                if (c >= 1) {
                    const int buf = (c - 1) & 1; const int lt = I.tid - 256;
#pragma unroll
                    for (int i = 0; i < 2; ++i) { const int e = lt + 256 * i; const int tl = e >> 4, rr = e & 15;
                        YRAW[(row0 + (size_t)(c - 1) * TC + tl) * 512 + colh + rg * 16 + rr] = YO[(buf * TC + tl) * 16 + rr]; }
                }
                cur[0] = nxt[0]; cur[1] = nxt[1];
            } else if (c >= 0) {
                const int buf = c & 1;
                const LAS float* dbase = SEQB + (buf * TC * 5) * 64 + kq * 4; const LAS float* vbase = VB + buf * TC * 16 + crow;
                LAS float* ybase = (kq == 0) ? (YO + buf * TC * 16 + crow) : (DUMMY + I.tid);
#define RW_OPS(o, tl) do { const LAS float* d = dbase + (tl) * 320; o.w4 = *(const LAS f32x4*)(d); o.a4 = *(const LAS f32x4*)(d + 64); o.b4 = *(const LAS f32x4*)(d + 128); o.k4 = *(const LAS f32x4*)(d + 192); o.r4 = *(const LAS f32x4*)(d + 256); o.vv = vbase[(tl) * 16]; } while (0)
                RwOps oc, on; RW_OPS(oc, 0);
#pragma unroll
                for (int tl = 0; tl < TC; ++tl) {
                    if (tl + 1 < TC) RW_OPS(on, tl + 1);
                    const f32x2 vv2 = (f32x2){oc.vv, oc.vv};
                    f32x2 pa = s01 * (f32x2){oc.a4[0], oc.a4[1]}; pa = s23 * (f32x2){oc.a4[2], oc.a4[3]} + pa;
                    float sa = pa[0] + pa[1];
                    const f32x2 t01 = s01 * (f32x2){oc.w4[0], oc.w4[1]} + vv2 * (f32x2){oc.k4[0], oc.k4[1]}, t23 = s23 * (f32x2){oc.w4[2], oc.w4[3]} + vv2 * (f32x2){oc.k4[2], oc.k4[3]};
                    sa = dpp_add16(sa);
                    const f32x2 sa2 = (f32x2){sa, sa};
                    s01 = sa2 * (f32x2){oc.b4[0], oc.b4[1]} + t01; s23 = sa2 * (f32x2){oc.b4[2], oc.b4[3]} + t23;
                    f32x2 py = s01 * (f32x2){oc.r4[0], oc.r4[1]}; py = s23 * (f32x2){oc.r4[2], oc.r4[3]} + py;
                    float y = py[0] + py[1];
                    y = dpp_add16(y);
                    ybase[tl * 16] = y;
                    oc = on;
                }
#undef RW_OPS
            }
            __syncthreads();
        }
#undef RW_LOAD
        if (loader) {
            const int buf = (NCH - 1) & 1; const int lt = I.tid - 256;
#pragma unroll
            for (int i = 0; i < 2; ++i) { const int e = lt + 256 * i; const int tl = e >> 4, rr = e & 15;
                YRAW[(row0 + (size_t)(NCH - 1) * TC + tl) * 512 + colh + rg * 16 + rr] = YO[(buf * TC + tl) * 16 + rr]; }
        }
    }
    __syncthreads();
}

__device__ __forceinline__ void phase_gn(const KA& a, const Ctx& C) {
    const Ids I = get_ids();
    unsigned char* ws = a.ws();
    const float* YRAW = (const float*)(ws + WS_YRAW); const float* BONUS = (const float*)(ws + MS_BONUS); const bf16_t* V = (const bf16_t*)(ws + WS_V);
    bf16_t* Y0 = (bf16_t*)(ws + WS_YB0);
    const float* lw = a.in(15); const float* lb = a.in(16);
    const int gw = C.bid * NWAVES + I.wave, NGW = C.G * NWAVES;
    float lwv[8], lbv[8];
#pragma unroll
    for (int h = 0; h < 8; ++h) { lwv[h] = lw[h * 64 + I.lane]; lbv[h] = lb[h * 64 + I.lane]; }
    for (int m = gw; m < NTOK; m += NGW) {
        const size_t o = (size_t)m * 512 + I.lane;
        float y[8], s1[8], vv[8], gg[8], bn[8];
#pragma unroll
        for (int h = 0; h < 8; ++h) { y[h] = YRAW[o + h * 64]; vv[h] = bf1(V[o + h * 64]); gg[h] = bf1(Y0[o + h * 64]); bn[h] = BONUS[m * 8 + h]; s1[h] = y[h]; }
#pragma unroll
        for (int of = 1; of < 64; of <<= 1) {
#pragma unroll
            for (int h = 0; h < 8; ++h) s1[h] += __shfl_xor(s1[h], of); }
        float d[8], s2[8];
#pragma unroll
        for (int h = 0; h < 8; ++h) { d[h] = y[h] - s1[h] * (1.0f / 64.0f); s2[h] = d[h] * d[h]; }
#pragma unroll
        for (int of = 1; of < 64; of <<= 1) {
#pragma unroll
            for (int h = 0; h < 8; ++h) s2[h] += __shfl_xor(s2[h], of); }
#pragma unroll
        for (int h = 0; h < 8; ++h) { float yn = d[h] * (1.0f / sqrtf(s2[h] * (1.0f / 64.0f) + 64e-5f)) * lwv[h] + lbv[h]; yn += bn[h] * vv[h]; Y0[o + h * 64] = (bf16_t)f2bf(yn * gg[h]); }
    }
}

__device__ __forceinline__ void phase_router(const KA& a, const Ctx& C) {
    const Ids I = get_ids();
    unsigned char* ws = a.ws();
    const bf16_t* H1 = (const bf16_t*)(ws + WS_H1B); bf16_t* HB = (bf16_t*)(ws + WS_HB); const bf16_t* WRT = (const bf16_t*)(ws + MS_WRT); const float* b_router = a.in(24);
    float* RSTD2 = (float*)(ws + MS_RSTD2); int* TOKE = (int*)(ws + MS_TOKE); int* TOKPOS = (int*)(ws + MS_TOKPOS); float* TOKG = (float*)(ws + MS_TOKG);
    unsigned* cnt = (unsigned*)(ws + WS_CTL) + CW_CNT;
    constexpr int WP = 2080;
    LAS unsigned char* WL = C.lds;
    LAS float* LG = (LAS float*)(C.lds + 64 * WP + I.wave * 2304);
    LAS unsigned* lcnt = (LAS unsigned*)(C.lds + 64 * WP + 8 * 2304);
    const int gw = C.bid * NWAVES + I.wave, NGW = C.G * NWAVES;
    const int fr = I.lane & 15, fq = I.lane >> 4;
    u32x4 xa[8], xb[8], xc[8];
#define RT_LOADQ(X, hr, q) do { _Pragma("unroll") for (int s = 0; s < 8; ++s) X[s] = *(const u32x4*)((hr) + ((q) * 8 + s) * 32 + fq * 8); } while (0)
    { const int grpF = C.bid * NWAVES + I.wave; const int mF = (grpF < NTOK / 16 ? grpF : 0) * 16 + fr; RT_LOADQ(xa, H1 + (size_t)mF * 1024, 0); RT_LOADQ(xb, H1 + (size_t)mF * 1024, 1); }
#pragma unroll
    for (int q = 0; q < 16; ++q) { const int rq = I.wave + 8 * q, row = rq >> 1, half = rq & 1;
        __builtin_amdgcn_global_load_lds((const unsigned*)(WRT + (size_t)row * 1024 + half * 512 + I.lane * 8), (LAS unsigned*)(WL + row * WP + half * 1024), 16, 0, 0); }
    asm volatile("s_waitcnt vmcnt(0)" ::: "memory");
    for (int grp0 = C.bid * NWAVES; grp0 < NTOK / 16; grp0 += NGW) {
        const int grp = grp0 + I.wave; const bool live = grp < NTOK / 16;
        if (I.tid < 64) lcnt[I.tid] = 0u;
        __syncthreads();
        const int m = (live ? grp : 0) * 16 + fr;
        const bf16_t* hrow = H1 + (size_t)m * 1024;
        f32x4 acc0 = (f32x4){0.f, 0.f, 0.f, 0.f}, acc1 = acc0; float ss = 0.f;
#define RT_COMPQ(X, q) do { _Pragma("unroll") for (int s = 0; s < 8; ++s) { const int k0 = ((q) * 8 + s) * 32 + fq * 8; const u32x4 hi = X[s]; \
            const f32x4 x0 = (f32x4){bf_lo(hi.x), bf_hi(hi.x), bf_lo(hi.y), bf_hi(hi.y)}, x1 = (f32x4){bf_lo(hi.z), bf_hi(hi.z), bf_lo(hi.w), bf_hi(hi.w)}; \
            ss += (x0[0] * x0[0] + x0[1] * x0[1]) + (x0[2] * x0[2] + x0[3] * x0[3]) + (x1[0] * x1[0] + x1[1] * x1[1]) + (x1[2] * x1[2] + x1[3] * x1[3]); \
            { u32x2 q8; q8.x = cvt_fp8x4(x0[0], x0[1], x0[2], x0[3]); q8.y = cvt_fp8x4(x1[0], x1[1], x1[2], x1[3]); *(u32x2*)((unsigned char*)HB + (size_t)m * 1024 + k0) = q8; } \
            const bf16x8 ah = __builtin_bit_cast(bf16x8, hi); \
            LAS const unsigned char* _w = WL + fr * WP + k0 * 2; \
            const bf16x8 wh0 = *(const LAS bf16x8*)_w, wh1 = *(const LAS bf16x8*)(_w + 16 * WP), wl0 = *(const LAS bf16x8*)(_w + 32 * WP), wl1 = *(const LAS bf16x8*)(_w + 48 * WP); \
            acc0 = __builtin_amdgcn_mfma_f32_16x16x32_bf16(ah, wh0, acc0, 0, 0, 0); acc0 = __builtin_amdgcn_mfma_f32_16x16x32_bf16(ah, wl0, acc0, 0, 0, 0); \
            acc1 = __builtin_amdgcn_mfma_f32_16x16x32_bf16(ah, wh1, acc1, 0, 0, 0); acc1 = __builtin_amdgcn_mfma_f32_16x16x32_bf16(ah, wl1, acc1, 0, 0, 0); } } while (0)
        if (grp0 != C.bid * NWAVES) { RT_LOADQ(xa, hrow, 0); RT_LOADQ(xb, hrow, 1); }
        RT_LOADQ(xc, hrow, 2); RT_COMPQ(xa, 0);
        RT_LOADQ(xa, hrow, 3); RT_COMPQ(xb, 1);
        RT_COMPQ(xc, 2); RT_COMPQ(xa, 3);
#undef RT_COMPQ
        ss += __shfl_xor(ss, 16); ss += __shfl_xor(ss, 32);
        const float rstd = 1.0f / sqrtf(ss * (1.0f / 1024.0f) + 1e-5f);
#pragma unroll
        for (int r = 0; r < 4; ++r) { LG[(fq * 4 + r) * 36 + fr] = acc0[r]; LG[(fq * 4 + r) * 36 + 16 + fr] = acc1[r]; }
        LDS_WAIT(); asm volatile("" ::: "memory");
        int sel[4] = {0, 0, 0, 0}; unsigned lpos[4] = {0u, 0u, 0u, 0u};
        if (I.lane < 16 && live) {
            float lg[32];
#pragma unroll
            for (int e = 0; e < 32; ++e) lg[e] = LG[fr * 36 + e] * rstd + b_router[e];
            float sv[4];
#pragma unroll
            for (int j = 0; j < 4; ++j) { float best = -3.0e38f; int bi = 0;
#pragma unroll
                for (int e = 0; e < 32; ++e) { const bool take = lg[e] > best; best = take ? lg[e] : best; bi = take ? e : bi; }
                sel[j] = bi; sv[j] = best;
#pragma unroll
                for (int e = 0; e < 32; ++e) lg[e] = (e == bi) ? -3.0e38f : lg[e]; }
            const float e0 = 1.0f, e1 = fexp(sv[1] - sv[0]), e2 = fexp(sv[2] - sv[0]), e3 = fexp(sv[3] - sv[0]); const float inv = 1.0f / (e0 + e1 + e2 + e3);
            const float gt[4] = {e0 * inv, e1 * inv, e2 * inv, e3 * inv};
            RSTD2[m] = rstd;
#pragma unroll
            for (int j = 0; j < 4; ++j) { lpos[j] = __hip_atomic_fetch_add(lcnt + sel[j], 1u, __ATOMIC_RELAXED, __HIP_MEMORY_SCOPE_WORKGROUP); TOKE[m * 4 + j] = sel[j]; TOKG[m * 4 + j] = gt[j]; }
        }
        __syncthreads();
        if (I.tid < 32) { const unsigned n = lcnt[I.tid]; lcnt[32 + I.tid] = n ? atomicAdd(cnt + I.tid * 64, n) : 0u; }
        __syncthreads();
        if (I.lane < 16 && live) {
#pragma unroll
            for (int j = 0; j < 4; ++j) TOKPOS[m * 4 + j] = (int)(lcnt[32 + sel[j]] + lpos[j]);
        }
        __syncthreads();
    }
}

#undef RT_LOADQ
__device__ __forceinline__ void phase_slots(const KA& a, const Ctx& C) {
    const Ids I = get_ids();
    unsigned char* ws = a.ws();
    const unsigned* cnt = (const unsigned*)(ws + WS_CTL) + CW_CNT; unsigned* ctl = (unsigned*)(ws + WS_CTL);
    const float* RSTD2 = (const float*)(ws + MS_RSTD2); const int* TOKE = (const int*)(ws + MS_TOKE); const int* TOKPOS = (const int*)(ws + MS_TOKPOS); const float* TOKG = (const float*)(ws + MS_TOKG);
    int* TOKSLOT = (int*)(ws + MS_TOKSLOT); int* SLOTTOK = (int*)(ws + MS_SLOTTOK); float* SLOTG = (float*)(ws + MS_SLOTG); float* SLOTRS = (float*)(ws + MS_SLOTRS); int* TILEE = (int*)(ws + MS_TILEE);
    LAS int* off = (LAS int*)C.lds; LAS int* cn = off + 40;
    __syncthreads();
    if (I.wave == 0) {
        const int e = I.lane & 31; const int c = (int)__hip_atomic_load(cnt + e * 64, __ATOMIC_RELAXED, __HIP_MEMORY_SCOPE_AGENT);
        const int pad = ((c + 255) >> 8) << 8; int incl = pad;
#pragma unroll
        for (int o = 1; o < 32; o <<= 1) { const int t = __shfl_up(incl, o); if ((I.lane & 31) >= o) incl += t; }
        if (I.lane < 32) { off[e] = incl - pad; cn[e] = c; if (e == NEXP - 1) off[NEXP] = incl; } }
    __syncthreads();
    if (C.bid == 0) {
        if (I.tid == 0) ctl[CW_NTILES] = (unsigned)(off[NEXP] >> 8);
        for (int e = 0; e < NEXP; ++e) for (int t = (off[e] >> 8) + I.tid; t < (off[e + 1] >> 8); t += 512) TILEE[t] = e;
    }
    for (int i = C.bid * 512 + I.tid; i < NTOK * 4; i += C.G * 512) { const int m = i >> 2; const int e = TOKE[i]; const int slot = off[e] + TOKPOS[i];
        TOKSLOT[i] = slot; SLOTTOK[slot] = m; SLOTG[slot] = TOKG[i]; SLOTRS[slot] = RSTD2[m]; }
    for (int e = 0; e < NEXP; ++e) for (int s = off[e] + cn[e] + C.bid * 512 + I.tid; s < off[e + 1]; s += C.G * 512) { SLOTTOK[s] = 0; SLOTG[s] = 0.f; SLOTRS[s] = 0.f; }
    __syncthreads();
}

__device__ __forceinline__ void phase_final(const KA& a, const Ctx& C) {
    const Ids I = get_ids();
    unsigned char* ws = a.ws();
    float* OUT = a.out(); const bf16_t* H1B = (const bf16_t*)(ws + WS_H1B); const bf16_t* YS = (const bf16_t*)(ws + WS_YSLOT); const int* TOKSLOT = (const int*)(ws + MS_TOKSLOT); const float* fw = a.in(29);
    const int gw = C.bid * NWAVES + I.wave, NGW = C.G * NWAVES;
    const f32x4* fwp = (const f32x4*)fw + I.lane; f32x4 fwv[4];
#pragma unroll
    for (int j = 0; j < 4; ++j) fwv[j] = fwp[64 * j];
    f32x4 v[4]; u32x2 hv[4], hvn[4], hv2[4]; unsigned ys[4][4], ysn[4][4]; int sl[4], sln[4], sl2[4];
#define FIN_LOAD_A(mm, V, S) do { const u32x2* _o = (const u32x2*)(H1B + (size_t)(mm) * 1024) + I.lane; _Pragma("unroll") for (int j = 0; j < 4; ++j) { V[j] = _o[64 * j]; S[j] = TOKSLOT[(mm) * 4 + j]; } } while (0)
#define FIN_LOAD_B(S, Y) do { _Pragma("unroll") for (int s = 0; s < 4; ++s) { const unsigned* _y = (const unsigned*)((const unsigned char*)YS + (size_t)S[s] * 1024) + I.lane; _Pragma("unroll") for (int j = 0; j < 4; ++j) Y[s][j] = _y[64 * j]; } } while (0)
    if (gw < NTOK) { FIN_LOAD_A(gw, hv, sl); FIN_LOAD_B(sl, ys); }
    if (gw + NGW < NTOK) FIN_LOAD_A(gw + NGW, hvn, sln);
    for (int m = gw; m < NTOK; m += NGW) {
        f32x4* orow = (f32x4*)(OUT + (size_t)m * 1024) + I.lane;
        const bool has1 = m + NGW < NTOK, has2 = m + 2 * NGW < NTOK;
        if (has2) FIN_LOAD_A(m + 2 * NGW, hv2, sl2);
        if (has1) FIN_LOAD_B(sln, ysn);
#pragma unroll
        for (int j = 0; j < 4; ++j) v[j] = (f32x4){bf_lo(hv[j].x), bf_hi(hv[j].x), bf_lo(hv[j].y), bf_hi(hv[j].y)};
#pragma unroll
        for (int s = 0; s < 4; ++s)
#pragma unroll
            for (int j = 0; j < 4; ++j) { const int y = (int)ys[s][j]; v[j][0] += __builtin_amdgcn_cvt_f32_fp8(y, 0); v[j][1] += __builtin_amdgcn_cvt_f32_fp8(y, 1); v[j][2] += __builtin_amdgcn_cvt_f32_fp8(y, 2); v[j][3] += __builtin_amdgcn_cvt_f32_fp8(y, 3); }
        float ss = 0.f;
#pragma unroll
        for (int j = 0; j < 4; ++j) ss += (v[j][0] * v[j][0] + v[j][1] * v[j][1]) + (v[j][2] * v[j][2] + v[j][3] * v[j][3]);
        const float rstd = 1.0f / sqrtf(wave_sum(ss) * (1.0f / 1024.0f) + 1e-5f);
#pragma unroll
        for (int j = 0; j < 4; ++j) __builtin_nontemporal_store(v[j] * rstd * fwv[j], orow + 64 * j);
#pragma unroll
        for (int j = 0; j < 4; ++j) { hv[j] = hvn[j]; sl[j] = sln[j]; hvn[j] = hv2[j]; sln[j] = sl2[j];
#pragma unroll
            for (int s = 0; s < 4; ++s) ys[s][j] = ysn[s][j]; }
    }
#undef FIN_LOAD_A
#undef FIN_LOAD_B
}

constexpr size_t WS_RWT = WS_RWT0;
constexpr size_t WS_RWS = 936 * MiB;
constexpr size_t WS_GC = WS_MISC + 8 * MiB;
constexpr int RT_TA = 0, RT_TL = 1, RT_BT = 2, RT_KT = 3, RT_RT = 4, RT_VT = 5;
__device__ __forceinline__ int toff(int r, int c16) { return r * 128 + ((c16 ^ ((r >> 1) & 7)) << 4); }
__device__ __forceinline__ bf16x8 frag_row(LAS const unsigned char* t, int row, int ks, int fq) { return *(const LAS bf16x8*)(t + toff(row, 4 * ks + fq)); }
__device__ __forceinline__ bf16x8 frag_row_slots(LAS const unsigned char* t, int row, int js, int fq) {
    const u32x2 lo = *(const LAS u32x2*)(t + toff(row, 4 * js + (fq >> 1)) + (fq & 1) * 8), hi = *(const LAS u32x2*)(t + toff(row, 4 * js + 2 + (fq >> 1)) + (fq & 1) * 8);
    u32x4 w; w.x = lo.x; w.y = lo.y; w.z = hi.x; w.w = hi.y; return __builtin_bit_cast(bf16x8, w);
}
__device__ __forceinline__ bf16x8 frag_tr(LAS const unsigned char* t, int ct, int js, int lane) {
    const int fq = lane >> 4, i = lane & 15, q = i >> 2, p = i & 3;
    const int r0 = 32 * js + 4 * fq + q, r1 = r0 + 16; const int c16 = 2 * ct + (p >> 1), bo = (p & 1) * 8;
    const s16x4 lo = vtr(t + toff(r0, c16) + bo), hi = vtr(t + toff(r1, c16) + bo);
    bf16x8 f; f[0] = lo[0]; f[1] = lo[1]; f[2] = lo[2]; f[3] = lo[3]; f[4] = hi[0]; f[5] = hi[1]; f[6] = hi[2]; f[7] = hi[3]; return f;
}
__device__ __forceinline__ float dpp_add8(float x) {
    x += __builtin_bit_cast(float, __builtin_amdgcn_update_dpp(0, __builtin_bit_cast(int, x), 0xB1, 0xF, 0xF, true));
    x += __builtin_bit_cast(float, __builtin_amdgcn_update_dpp(0, __builtin_bit_cast(int, x), 0x4E, 0xF, 0xF, true));
    x += __builtin_bit_cast(float, __builtin_amdgcn_update_dpp(0, __builtin_bit_cast(int, x), 0x141, 0xF, 0xF, true));
    return x;
}
#define MFMA16(a, b, c) __builtin_amdgcn_mfma_f32_16x16x32_bf16(a, b, c, 0, 0, 0)

struct RcRaw { u32x4 kr, as, r, v, krp, rp, vp; f32x4 lw0, lw1, kk0, kk1, ka0, ka1, rk0, rk1; };
#define RC_LBAR() do { asm volatile("s_waitcnt lgkmcnt(0)" ::: "memory"); __builtin_amdgcn_s_barrier(); asm volatile("" ::: "memory"); } while (0)
__device__ __forceinline__ void phase_rwkv_pre(const KA& a, const Ctx& C) {
    const Ids I = get_ids();
    unsigned char* ws = a.ws();
    const bf16_t* P = (const bf16_t*)(ws + WS_P); const bf16_t* ASIG = (const bf16_t*)(ws + WS_ASIG); const float* mu = a.in(6);
    const float* LW = (const float*)(ws + WS_W); float* BONUS = (float*)(ws + MS_BONUS); float* GC = (float*)(ws + WS_GC);
    unsigned char* RWT = ws + WS_RWT; unsigned char* SCR = ws + WS_RWS + (size_t)C.bid * (8 * 40960);
    const float* k_k = a.in(12); const float* k_a = a.in(13); const float* r_k = a.in(14);
    LAS unsigned char* lds = C.lds;
    const int tid = I.tid, lane = I.lane, wave = I.wave, fr = lane & 15, fq = lane >> 4;
    const int ri = tid >> 3, cg = tid & 7;
    LAS float* MU = (LAS float*)(lds + 114688);
    { const float u0 = mu[tid], u1 = mu[tid + 512], u2 = mu[tid + 1024]; MU[tid] = u0; MU[tid + 512] = u1; MU[tid + 1024] = u2; }
    __syncthreads();
    for (int grp = C.bid; grp < 512; grp += C.G) {
        RcRaw cur, nxt;
#define RC_LOAD(task, raw) do { const int _bh = (task) >> 6, _ch = (task) & 63; const size_t _m = (size_t)(_bh >> 3) * SEQ + _ch * 64 + ri; const size_t _o = _m * 512 + (_bh & 7) * 64 + 8 * cg; \
        { const bf16_t* _p = P + _m * 3072 + (_bh & 7) * 64 + 8 * cg; raw.r = *(const u32x4*)_p; raw.kr = *(const u32x4*)(_p + 512); raw.v = *(const u32x4*)(_p + 1024); \
          raw.rp = (u32x4){0u, 0u, 0u, 0u}; raw.krp = raw.rp; raw.vp = raw.rp; if ((_m & (SEQ - 1)) != 0) { raw.rp = *(const u32x4*)(_p - 3072); raw.krp = *(const u32x4*)(_p - 3072 + 512); raw.vp = *(const u32x4*)(_p - 3072 + 1024); } } \
        raw.as = *(const u32x4*)(ASIG + _o); raw.lw0 = *(const f32x4*)(LW + _o); raw.lw1 = *(const f32x4*)(LW + _o + 4); const int _hc = (_bh & 7) * 64 + 8 * cg; \
        raw.kk0 = *(const f32x4*)(k_k + _hc); raw.kk1 = *(const f32x4*)(k_k + _hc + 4); raw.ka0 = *(const f32x4*)(k_a + _hc); raw.ka1 = *(const f32x4*)(k_a + _hc + 4); raw.rk0 = *(const f32x4*)(r_k + _hc); raw.rk1 = *(const f32x4*)(r_k + _hc + 4); } while (0)
        RC_LOAD(grp * 8, cur);
#pragma unroll 1
        for (int tk = 0; tk < 8; ++tk) {
            const int task = grp * 8 + tk; const int bh = task >> 6, ch = task & 63, h = bh & 7; const size_t m = (size_t)(bh >> 3) * SEQ + ch * 64 + ri;
            if (tk + 1 < 8) RC_LOAD(task + 1, nxt);
            LAS float* LWB = (LAS float*)lds;
            LAS float* SCAN = (LAS float*)(lds + 40960);
            LAS unsigned char* AT = lds + 16384; LAS unsigned char* BT = lds + 24576; LAS unsigned char* KT = lds + 32768;
            unsigned char* gt = RWT + (size_t)task * (6 * 8192); unsigned char* sc = SCR + tk * 40960;
            float kr[8], as[8], rr[8], lw[8];
            u32x4 vblend;
            { const u32x4 x = cur.kr, y = cur.as, z = cur.r;
              kr[0] = bf_lo(x.x); kr[1] = bf_hi(x.x); kr[2] = bf_lo(x.y); kr[3] = bf_hi(x.y); kr[4] = bf_lo(x.z); kr[5] = bf_hi(x.z); kr[6] = bf_lo(x.w); kr[7] = bf_hi(x.w);
              as[0] = bf_lo(y.x); as[1] = bf_hi(y.x); as[2] = bf_lo(y.y); as[3] = bf_hi(y.y); as[4] = bf_lo(y.z); as[5] = bf_hi(y.z); as[6] = bf_lo(y.w); as[7] = bf_hi(y.w);
              rr[0] = bf_lo(z.x); rr[1] = bf_hi(z.x); rr[2] = bf_lo(z.y); rr[3] = bf_hi(z.y); rr[4] = bf_lo(z.z); rr[5] = bf_hi(z.z); rr[6] = bf_lo(z.w); rr[7] = bf_hi(z.w);
              lw[0] = cur.lw0[0]; lw[1] = cur.lw0[1]; lw[2] = cur.lw0[2]; lw[3] = cur.lw0[3]; lw[4] = cur.lw1[0]; lw[5] = cur.lw1[1]; lw[6] = cur.lw1[2]; lw[7] = cur.lw1[3];
              { const u32x4 xp = cur.krp, zp = cur.rp, w = cur.v, wp = cur.vp; const int hc = h * 64 + 8 * cg;
                const f32x4 mr0 = *(const LAS f32x4*)(MU + hc), mr1 = *(const LAS f32x4*)(MU + hc + 4), mk0 = *(const LAS f32x4*)(MU + 512 + hc), mk1 = *(const LAS f32x4*)(MU + 512 + hc + 4), mv0 = *(const LAS f32x4*)(MU + 1024 + hc), mv1 = *(const LAS f32x4*)(MU + 1024 + hc + 4);
                const float kp[8] = {bf_lo(xp.x), bf_hi(xp.x), bf_lo(xp.y), bf_hi(xp.y), bf_lo(xp.z), bf_hi(xp.z), bf_lo(xp.w), bf_hi(xp.w)};
                const float rp[8] = {bf_lo(zp.x), bf_hi(zp.x), bf_lo(zp.y), bf_hi(zp.y), bf_lo(zp.z), bf_hi(zp.z), bf_lo(zp.w), bf_hi(zp.w)};
                const float vc[8] = {bf_lo(w.x), bf_hi(w.x), bf_lo(w.y), bf_hi(w.y), bf_lo(w.z), bf_hi(w.z), bf_lo(w.w), bf_hi(w.w)};
                const float vq[8] = {bf_lo(wp.x), bf_hi(wp.x), bf_lo(wp.y), bf_hi(wp.y), bf_lo(wp.z), bf_hi(wp.z), bf_lo(wp.w), bf_hi(wp.w)};
                float vb[8];
#pragma unroll
                for (int j = 0; j < 8; ++j) { const float cr = j < 4 ? mr0[j & 3] : mr1[j & 3], ck = j < 4 ? mk0[j & 3] : mk1[j & 3], cv = j < 4 ? mv0[j & 3] : mv1[j & 3];
                    rr[j] = rr[j] + (rp[j] - rr[j]) * cr; kr[j] = kr[j] + (kp[j] - kr[j]) * ck; vb[j] = vc[j] + (vq[j] - vc[j]) * cv; }
                { const unsigned r01 = pk2(rr[0], rr[1]), r23 = pk2(rr[2], rr[3]), r45 = pk2(rr[4], rr[5]), r67 = pk2(rr[6], rr[7]);
                  rr[0] = bf_lo(r01); rr[1] = bf_hi(r01); rr[2] = bf_lo(r23); rr[3] = bf_hi(r23); rr[4] = bf_lo(r45); rr[5] = bf_hi(r45); rr[6] = bf_lo(r67); rr[7] = bf_hi(r67);
                  const unsigned k01 = pk2(kr[0], kr[1]), k23 = pk2(kr[2], kr[3]), k45 = pk2(kr[4], kr[5]), k67 = pk2(kr[6], kr[7]);
                  kr[0] = bf_lo(k01); kr[1] = bf_hi(k01); kr[2] = bf_lo(k23); kr[3] = bf_hi(k23); kr[4] = bf_lo(k45); kr[5] = bf_hi(k45); kr[6] = bf_lo(k67); kr[7] = bf_hi(k67); }
                vblend.x = pk2(vb[0], vb[1]); vblend.y = pk2(vb[2], vb[3]); vblend.z = pk2(vb[4], vb[5]); vblend.w = pk2(vb[6], vb[7]); } }
            const f32x4 kk0 = cur.kk0, kk1 = cur.kk1, ka0 = cur.ka0, ka1 = cur.ka1, rk0 = cur.rk0, rk1 = cur.rk1;
            float kkn[8], km[8]; float n2 = 0.f, bs = 0.f;
#pragma unroll
            for (int j = 0; j < 8; ++j) { const float kkc = j < 4 ? kk0[j & 3] : kk1[j & 3], kac = j < 4 ? ka0[j & 3] : ka1[j & 3], rkc = j < 4 ? rk0[j & 3] : rk1[j & 3];
                kkn[j] = kr[j] * kkc; n2 += kkn[j] * kkn[j]; km[j] = kr[j] * (1.0f + (as[j] - 1.0f) * kac); bs += rr[j] * km[j] * rkc; }
            n2 = dpp_add8(n2); bs = dpp_add8(bs);
            const float inv = 1.0f / fmaxf(sqrtf(n2), 1e-12f);
            if (cg == 0) BONUS[m * 8 + h] = bs;
            *(LAS f32x4*)(LWB + ri * 64 + 8 * cg) = cur.lw0; *(LAS f32x4*)(LWB + ri * 64 + 8 * cg + 4) = cur.lw1;
            RC_LBAR();
            { const int c = tid & 63, rb = tid >> 6; float p[8]; float run = 0.f;
#pragma unroll
              for (int j = 0; j < 8; ++j) { run += LWB[(8 * rb + j) * 64 + c]; p[j] = run; }
              SCAN[rb * 64 + c] = run;
              RC_LBAR();
              float off = 0.f;
#pragma unroll
              for (int q = 0; q < 8; ++q) off += (q < rb) ? SCAN[q * 64 + c] : 0.f;
#pragma unroll
              for (int j = 0; j < 8; ++j) LWB[(8 * rb + j) * 64 + c] = p[j] + off; }
            RC_LBAR();
            { const f32x4 g0 = *(const LAS f32x4*)(LWB + ri * 64 + 8 * cg), g1 = *(const LAS f32x4*)(LWB + ri * 64 + 8 * cg + 4);
              float at[8], bt[8], kt[8], rt[8];
#pragma unroll
              for (int j = 0; j < 8; ++j) { const float g = j < 4 ? g0[j & 3] : g1[j & 3]; const float eg = fexp(g), egi = fexp(-g), egp = fexp(g - lw[j]); const float kn = kkn[j] * inv;
                  at[j] = -kn * egp; bt[j] = kn * as[j] * egi; kt[j] = km[j] * egi; rt[j] = rr[j] * eg;
                  if (ri == 63) GC[(size_t)task * 64 + 8 * cg + j] = eg; }
              const int so = toff(ri, cg);
              u32x4 pa, pb, pk, pr; pa.x = pk2(at[0], at[1]); pa.y = pk2(at[2], at[3]); pa.z = pk2(at[4], at[5]); pa.w = pk2(at[6], at[7]);
              pb.x = pk2(bt[0], bt[1]); pb.y = pk2(bt[2], bt[3]); pb.z = pk2(bt[4], bt[5]); pb.w = pk2(bt[6], bt[7]);
              pk.x = pk2(kt[0], kt[1]); pk.y = pk2(kt[2], kt[3]); pk.z = pk2(kt[4], kt[5]); pk.w = pk2(kt[6], kt[7]);
              pr.x = pk2(rt[0], rt[1]); pr.y = pk2(rt[2], rt[3]); pr.z = pk2(rt[4], rt[5]); pr.w = pk2(rt[6], rt[7]);
              *(LAS u32x4*)(AT + so) = pa; *(LAS u32x4*)(BT + so) = pb; *(LAS u32x4*)(KT + so) = pk;
              *(u32x4*)(sc + 24576 + so) = pa; *(u32x4*)(gt + RT_BT * 8192 + so) = pb; *(u32x4*)(gt + RT_KT * 8192 + so) = pk; *(u32x4*)(gt + RT_RT * 8192 + so) = pr; *(u32x4*)(gt + RT_VT * 8192 + so) = vblend; }
            RC_LBAR();
            {
              const int which = wave >> 2, it = wave & 3; LAS const unsigned char* XT = which ? KT : BT;
              const bf16x8 b0 = frag_row(AT, 16 * it + fr, 0, fq), b1 = frag_row(AT, 16 * it + fr, 1, fq);
#pragma unroll
              for (int jt = 0; jt < 4; ++jt) { f32x4 d = (f32x4){0.f, 0.f, 0.f, 0.f};
                  if (jt <= it) { d = MFMA16(frag_row(XT, 16 * jt + fr, 0, fq), b0, d); d = MFMA16(frag_row(XT, 16 * jt + fr, 1, fq), b1, d); }
                  const int i = 16 * it + fr, j0 = 16 * jt + 4 * fq;
#pragma unroll
                  for (int r = 0; r < 4; ++r) d[r] = (j0 + r < i) ? d[r] : 0.f;
                  if (which == 0) { u32x2 w; w.x = pk2(d[0], d[1]); w.y = pk2(d[2], d[3]); *(LAS u32x2*)(lds + 43008 + tk * 8192 + (i * 64 + j0) * 2) = w; }
                  else { u32x2 w; w.x = pk2(d[0], d[1]); w.y = pk2(d[2], d[3]); *(u32x2*)(sc + 16384 + toff(i, 2 * jt + (fq >> 1)) + (fq & 1) * 8) = w; } } }
            RC_LBAR();
            cur = nxt;
        }
#undef RC_LOAD
        __syncthreads();
        { int ln = lane; asm volatile("" : "+v"(ln));
          LAS unsigned char* L = lds + 43008 + wave * 8192;
          float t[64];
#pragma unroll
          for (int i = 0; i < 64; ++i) { float a0 = (ln == i) ? 1.0f : 0.f, a1 = 0.f, a2 = 0.f, a3 = 0.f;
#pragma unroll
              for (int jb = 0; jb < (i + 3) / 4; ++jb) { const u32x2 l4 = *(const LAS u32x2*)(L + (i * 64 + 4 * jb) * 2);
                  a0 += bf_lo(l4.x) * t[4 * jb]; if (4 * jb + 1 < i) a1 += bf_hi(l4.x) * t[4 * jb + 1]; if (4 * jb + 2 < i) a2 += bf_lo(l4.y) * t[4 * jb + 2]; if (4 * jb + 3 < i) a3 += bf_hi(l4.y) * t[4 * jb + 3]; }
              t[i] = (a0 + a1) + (a2 + a3); }
          LDS_WAIT(); asm volatile("" ::: "memory");
#pragma unroll
          for (int i = 0; i < 64; ++i) *(LAS bf16_t*)(L + toff(i, ln >> 3) + (ln & 7) * 2) = (bf16_t)f2bf(t[i]);
        }
        __syncthreads();
        { u32x4 nA, nK;
          { const unsigned char* sc = SCR; nA = *(const u32x4*)(sc + 24576 + tid * 16); nK = *(const u32x4*)(sc + 16384 + tid * 16); }
#pragma unroll 1
          for (int tk = 0; tk < 8; ++tk) {
            const int task = grp * 8 + tk; unsigned char* gt = RWT + (size_t)task * (6 * 8192);
            LAS unsigned char* TT = lds + 43008 + tk * 8192; LAS unsigned char* AT = lds + 8192; LAS unsigned char* LK = lds + 16384;
            *(LAS u32x4*)(AT + tid * 16) = nA; *(LAS u32x4*)(LK + tid * 16) = nK;
            if (tk + 1 < 8) { const unsigned char* sc = SCR + (tk + 1) * 40960; nA = *(const u32x4*)(sc + 24576 + tid * 16); nK = *(const u32x4*)(sc + 16384 + tid * 16); }
            RC_LBAR();
            { const int which = wave >> 2, it = wave & 3; LAS const unsigned char* X = which ? LK : AT;
              const bf16x8 b0 = frag_row_slots(TT, 16 * it + fr, 0, fq), b1 = frag_row_slots(TT, 16 * it + fr, 1, fq);
#pragma unroll
              for (int ct = 0; ct < 4; ++ct) { f32x4 d = (f32x4){0.f, 0.f, 0.f, 0.f};
                  d = MFMA16(frag_tr(X, ct, 0, lane), b0, d); d = MFMA16(frag_tr(X, ct, 1, lane), b1, d);
                  u32x2 w; w.x = pk2(d[0], d[1]); w.y = pk2(d[2], d[3]);
                  *(u32x2*)(gt + (which ? RT_TL : RT_TA) * 8192 + toff(16 * it + fr, 2 * ct + (fq >> 1)) + (fq & 1) * 8) = w; } }
            RC_LBAR();
          } }
        __syncthreads();
    }
}

struct RsStage { u32x4 t[6]; };
__device__ __forceinline__ void phase_rwkv_seq(const KA& a, const Ctx& C) {
    const Ids I = get_ids();
    unsigned char* ws = a.ws();
    const unsigned char* RWT = ws + WS_RWT; const float* GC = (const float*)(ws + WS_GC); const float* BONUS = (const float*)(ws + MS_BONUS);
    bf16_t* Y0 = (bf16_t*)(ws + WS_YB0);
    const float* lnw = a.in(15); const float* lnb = a.in(16);
    LAS unsigned char* lds = C.lds;
    const int tid0 = I.tid, lane0 = I.lane, wave = I.wave;
    const int tid = tid0, lane = lane0, fr = lane & 15, fq = lane >> 4;
#define RS_OPAQUE_IDS() int lane = lane0; asm volatile("" : "+v"(lane)); const int fr = lane & 15, fq = lane >> 4, tid = wave * 64 + lane; (void)tid; (void)fr; (void)fq
    LAS unsigned char* L_TA = lds; LAS unsigned char* L_TL = lds + 8192; LAS unsigned char* L_Z = lds + 12 * 8192;
    LAS float* L_GC = (LAS float*)(lds + 13 * 8192); LAS float* L_LN = (LAS float*)(lds + 13 * 8192 + 16384);
#define L_BT(bf) (lds + (2 + (bf)) * 8192)
#define L_KT(bf) (lds + (4 + (bf)) * 8192)
#define L_RT(bf) (lds + (6 + (bf)) * 8192)
#define L_VT(bf) (lds + (8 + (bf)) * 8192)
#define L_S(bf)  (lds + (10 + (bf)) * 8192)
#define RS_LOAD(st, chn) do { const unsigned char* _g = gt0 + (size_t)(chn) * (6 * 8192) + tid * 16; _Pragma("unroll") for (int _q = 0; _q < 6; ++_q) st.t[_q] = *(const u32x4*)(_g + _q * 8192); } while (0)
#define RS_WRITE4(st, bfn) do { *(LAS u32x4*)(L_BT(bfn) + tid * 16) = st.t[RT_BT]; *(LAS u32x4*)(L_KT(bfn) + tid * 16) = st.t[RT_KT]; *(LAS u32x4*)(L_RT(bfn) + tid * 16) = st.t[RT_RT]; *(LAS u32x4*)(L_VT(bfn) + tid * 16) = st.t[RT_VT]; } while (0)
#define RS_WRITE2(st) do { *(LAS u32x4*)(L_TA + tid * 16) = st.t[RT_TA]; *(LAS u32x4*)(L_TL + tid * 16) = st.t[RT_TL]; } while (0)
#define RS_BAR() do { asm volatile("s_waitcnt lgkmcnt(0)" ::: "memory"); __builtin_amdgcn_s_barrier(); asm volatile("" ::: "memory"); } while (0)
    for (int bh = C.bid; bh < BATCH * 8; bh += C.G) {
        const int h = bh & 7; const size_t row0 = (size_t)(bh >> 3) * SEQ;
        const unsigned char* gt0 = RWT + (size_t)bh * 64 * (6 * 8192);
        const float* gc0 = GC + (size_t)bh * 64 * 64;
        __syncthreads();
        RsStage sA, sB;
        RS_LOAD(sA, 0);
        *(LAS u32x4*)(L_S(0) + tid * 16) = (u32x4){0u, 0u, 0u, 0u};
        RS_WRITE4(sA, 0); RS_WRITE2(sA);
        RS_LOAD(sA, 1); RS_LOAD(sB, 2);
#pragma unroll
        for (int q = 0; q < 2; ++q) *(LAS f32x4*)(L_GC + (q * 512 + tid) * 4) = *(const f32x4*)(gc0 + (size_t)(q * 512 + tid) * 4);
        if (tid < 64) { L_LN[tid] = lnw[h * 64 + tid]; L_LN[64 + tid] = lnb[h * 64 + tid]; }
        if (wave < 4) {
            const int vt = wave;
            f32x4 sm[4];
#pragma unroll
            for (int kt = 0; kt < 4; ++kt) sm[kt] = (f32x4){0.f, 0.f, 0.f, 0.f};
            __syncthreads();
#define RS_SCHUNK(ch, SX) do { const int bf = (ch) & 1; RS_OPAQUE_IDS(); \
                RS_WRITE4(SX, bf ^ 1); \
                  \
                { const bf16x8 s0 = frag_row(L_S(bf), 16 * vt + fr, 0, fq), s1 = frag_row(L_S(bf), 16 * vt + fr, 1, fq); \
                  const bf16x8 v0 = frag_tr(L_VT(bf), vt, 0, lane), v1 = frag_tr(L_VT(bf), vt, 1, lane); \
                  _Pragma("unroll") for (int it = 0; it < 4; ++it) { f32x4 d = (f32x4){0.f, 0.f, 0.f, 0.f}; \
                      d = MFMA16(s0, frag_row(L_TA, 16 * it + fr, 0, fq), d); d = MFMA16(s1, frag_row(L_TA, 16 * it + fr, 1, fq), d); \
                      d = MFMA16(v0, frag_row_slots(L_TL, 16 * it + fr, 0, fq), d); d = MFMA16(v1, frag_row_slots(L_TL, 16 * it + fr, 1, fq), d); \
                      u32x2 w; w.x = pk2(d[0], d[1]); w.y = pk2(d[2], d[3]); \
                      *(LAS u32x2*)(L_Z + toff(16 * it + fr, 2 * vt + (fq >> 1)) + (fq & 1) * 8) = w; } } \
                RS_BAR();                                          \
                RS_WRITE2(SX); RS_LOAD(SX, (ch) + 3); \
                  \
                { const bf16x8 z0 = frag_tr(L_Z, vt, 0, lane), z1 = frag_tr(L_Z, vt, 1, lane), v0 = frag_tr(L_VT(bf), vt, 0, lane), v1 = frag_tr(L_VT(bf), vt, 1, lane); \
                  _Pragma("unroll") for (int kt = 0; kt < 4; ++kt) { f32x4 d = sm[kt]; \
                      d = MFMA16(frag_tr(L_BT(bf), kt, 0, lane), z0, d); d = MFMA16(frag_tr(L_BT(bf), kt, 1, lane), z1, d); \
                      d = MFMA16(frag_tr(L_KT(bf), kt, 0, lane), v0, d); d = MFMA16(frag_tr(L_KT(bf), kt, 1, lane), v1, d); \
                      d = d * *(const LAS f32x4*)(L_GC + (ch) * 64 + 16 * kt + 4 * fq); sm[kt] = d; \
                      u32x2 w; w.x = pk2(d[0], d[1]); w.y = pk2(d[2], d[3]); \
                      *(LAS u32x2*)(L_S(bf ^ 1) + toff(16 * vt + fr, 2 * kt + (fq >> 1)) + (fq & 1) * 8) = w; } } \
                RS_BAR();                                          \
            } while (0)
#pragma unroll 1
            for (int c2 = 0; c2 < 64; c2 += 2) { RS_SCHUNK(c2, sA); RS_SCHUNK(c2 + 1, sB); }
#undef RS_SCHUNK
        } else {
            const int it = wave - 4;
            u32x2 g8A[4], g8B[4]; float bonA, bonB;
#define RS_SMALL(chn, G8, BON) do { const size_t _m = row0 + (size_t)(chn) * 64 + 16 * it + fr; _Pragma("unroll") for (int _v = 0; _v < 4; ++_v) G8[_v] = *(const u32x2*)(Y0 + _m * 512 + h * 64 + 16 * _v + 4 * fq); BON = BONUS[_m * 8 + h]; } while (0)
            RS_SMALL(0, g8A, bonA);
            __syncthreads();
#define RS_YCHUNK(ch, SX, G8C, BONC, G8N, BONN) do { const int bf = (ch) & 1; RS_OPAQUE_IDS(); \
                RS_WRITE4(SX, bf ^ 1); RS_SMALL((ch) + 1, G8N, BONN); \
                  \
                const bf16x8 r0 = frag_row(L_RT(bf), 16 * it + fr, 0, fq), r1 = frag_row(L_RT(bf), 16 * it + fr, 1, fq); \
                u32x4 mbw[2], mkw[2]; \
                _Pragma("unroll") for (int jt = 0; jt < 4; ++jt) { f32x4 db = (f32x4){0.f, 0.f, 0.f, 0.f}, dk = db; \
                    if (jt <= it) { db = MFMA16(frag_row(L_BT(bf), 16 * jt + fr, 0, fq), r0, db); db = MFMA16(frag_row(L_BT(bf), 16 * jt + fr, 1, fq), r1, db); \
                                    dk = MFMA16(frag_row(L_KT(bf), 16 * jt + fr, 0, fq), r0, dk); dk = MFMA16(frag_row(L_KT(bf), 16 * jt + fr, 1, fq), r1, dk); } \
                    const int i = 16 * it + fr, j0 = 16 * jt + 4 * fq; \
                    _Pragma("unroll") for (int r = 0; r < 4; ++r) { const bool keep = (j0 + r <= i); db[r] = keep ? db[r] : 0.f; dk[r] = keep ? dk[r] : 0.f; } \
                    if (jt & 1) { mbw[jt >> 1].z = pk2(db[0], db[1]); mbw[jt >> 1].w = pk2(db[2], db[3]); mkw[jt >> 1].z = pk2(dk[0], dk[1]); mkw[jt >> 1].w = pk2(dk[2], dk[3]); } \
                    else        { mbw[jt >> 1].x = pk2(db[0], db[1]); mbw[jt >> 1].y = pk2(db[2], db[3]); mkw[jt >> 1].x = pk2(dk[0], dk[1]); mkw[jt >> 1].y = pk2(dk[2], dk[3]); } } \
                const bf16x8 mb0 = __builtin_bit_cast(bf16x8, mbw[0]), mb1 = __builtin_bit_cast(bf16x8, mbw[1]), mk0 = __builtin_bit_cast(bf16x8, mkw[0]), mk1 = __builtin_bit_cast(bf16x8, mkw[1]); \
                RS_BAR();                                          \
                RS_WRITE2(SX); RS_LOAD(SX, (ch) + 3); \
                  \
                { const size_t m = row0 + (size_t)(ch) * 64 + 16 * it + fr; bf16_t* yrow = Y0 + m * 512 + h * 64; \
                  f32x4 y[4]; float s1 = 0.f, s2 = 0.f; \
                  _Pragma("unroll") for (int vt = 0; vt < 4; ++vt) { f32x4 d = (f32x4){0.f, 0.f, 0.f, 0.f}; \
                      d = MFMA16(frag_row(L_S(bf), 16 * vt + fr, 0, fq), r0, d); d = MFMA16(frag_row(L_S(bf), 16 * vt + fr, 1, fq), r1, d); \
                      d = MFMA16(frag_tr(L_Z, vt, 0, lane), mb0, d); d = MFMA16(frag_tr(L_Z, vt, 1, lane), mb1, d); \
                      d = MFMA16(frag_tr(L_VT(bf), vt, 0, lane), mk0, d); d = MFMA16(frag_tr(L_VT(bf), vt, 1, lane), mk1, d); \
                      y[vt] = d; s1 += (d[0] + d[1]) + (d[2] + d[3]); s2 += (d[0] * d[0] + d[1] * d[1]) + (d[2] * d[2] + d[3] * d[3]); } \
                  s1 += __shfl_xor(s1, 16); s1 += __shfl_xor(s1, 32); s2 += __shfl_xor(s2, 16); s2 += __shfl_xor(s2, 32); \
                  const float mean = s1 * (1.0f / 64.0f); const float var = fmaxf(s2 * (1.0f / 64.0f) - mean * mean, 0.f); const float rstd = 1.0f / sqrtf(var + 64e-5f); \
                  _Pragma("unroll") for (int vt = 0; vt < 4; ++vt) { const u32x2 vv = *(const LAS u32x2*)(L_VT(bf) + toff(16 * it + fr, 2 * vt + (fq >> 1)) + (fq & 1) * 8); \
                      const float vf[4] = {bf_lo(vv.x), bf_hi(vv.x), bf_lo(vv.y), bf_hi(vv.y)}; const float gf[4] = {bf_lo(G8C[vt].x), bf_hi(G8C[vt].x), bf_lo(G8C[vt].y), bf_hi(G8C[vt].y)}; \
                      const f32x4 lw4 = *(const LAS f32x4*)(L_LN + 16 * vt + 4 * fq), lb4 = *(const LAS f32x4*)(L_LN + 64 + 16 * vt + 4 * fq); \
                      float o[4]; \
                      _Pragma("unroll") for (int r = 0; r < 4; ++r) o[r] = ((y[vt][r] - mean) * rstd * lw4[r] + lb4[r] + BONC * vf[r]) * gf[r]; \
                      u32x2 w; w.x = pk2(o[0], o[1]); w.y = pk2(o[2], o[3]); *(u32x2*)(yrow + 16 * vt + 4 * fq) = w; } } \
                RS_BAR();                                          \
            } while (0)
#pragma unroll 1
            for (int c2 = 0; c2 < 64; c2 += 2) { RS_YCHUNK(c2, sA, g8A, bonA, g8B, bonB); RS_YCHUNK(c2 + 1, sB, g8B, bonB, g8A, bonA); }
#undef RS_YCHUNK
#undef RS_SMALL
        }
    }
#undef RS_BAR
#undef RS_OPAQUE_IDS
#undef RS_LOAD
#undef RS_WRITE4
#undef RS_WRITE2
#undef L_BT
#undef L_KT
#undef L_RT
#undef L_VT
#undef L_S
    __syncthreads();
}

constexpr int N_PHASES = 14;
__global__ void __launch_bounds__(512, 2) mega(Args a_unused) {
    const KA a;
    extern __shared__ __attribute__((aligned(16))) unsigned char lds_raw[];
    cg::grid_group grid = cg::this_grid();
    Ctx C; C.lds = (LAS unsigned char*)lds_raw; C.G = gridDim.x; C.bid = blockIdx.x;
    const int lo = a.ph_lo(), hi = a.ph_hi();
#define ws (a.ws())
    volatile LAS unsigned* xst = (volatile LAS unsigned*)(C.lds + LDS_BYTES - 16);
    if (threadIdx.x < 4) xst[threadIdx.x] = 0u;
    __syncthreads();
    const XcdBarrier xbar = xcd_barrier_post((unsigned*)(ws + WS_CTL) + CW_BAR, xst);
#define IN(k) (lo <= (k) && (k) < hi)
#ifdef PROBE_A
#define STAMP(k) do { if (blockIdx.x == 0 && threadIdx.x == 0) ((unsigned long long*)(ws + WS_CTL + 4096))[k] = __builtin_amdgcn_s_memrealtime(); } while (0)
#else
#define STAMP(k) do { } while (0)
#endif
#define SEAM(k) do { if (IN(k) && IN((k) + 1)) { if (lo < 0) grid.sync(); else xcd_barrier(xbar); } STAMP((k) + 1); } while (0)
    STAMP(0);
    if (IN(0)) phase0(a, C);
    SEAM(0);
    if (IN(1)) {
#if G1_FP8
        { int KE = 512; asm volatile("" : "+s"(KE));
          DenseSched S{(const char*)(ws + WS_XN8), (const char*)(ws + WS_WBIG), NTOK / 256, 3072 / 256, KE, C.G, C.bid};
          EpiIn E{(bf16_t*)(ws + WS_P), (bf16_t*)(ws + WS_GATE), a.in(5), 1.0f, 1.0f / W8_SCALE};
          pg8::gemm_phase<EpiIn, DenseSched, false, true>(C.lds, KE, S, E); }
#else
        { DenseSched S{(const char*)(ws + WS_XN), (const char*)(ws + WS_WBIG), NTOK / 256, 3072 / 256, 1024, C.G, C.bid};
          EpiIn E{(bf16_t*)(ws + WS_P), (bf16_t*)(ws + WS_GATE), a.in(5)};
          pg8::gemm_phase<EpiIn, DenseSched, false>(C.lds, 1024, S, E); }
#endif
        if (C.G <= 96) {
          DenseSched S{(const char*)(ws + WS_MEMN), (const char*)(ws + WS_WMKV), NMEM / 256, 1024 / 256, 1024, C.G, C.bid};
          EpiPlain E{(bf16_t*)(ws + WS_KVM), 1024};
          pg8::gemm_phase<EpiPlain, DenseSched, false>(C.lds, 1024, S, E); }
    }
    SEAM(1);
    if (IN(2)) phase_lerp(a, C);
    SEAM(2);
    if (IN(3)) {
        int Kl = 256; asm volatile("" : "+s"(Kl)); int Kh = 128; asm volatile("" : "+s"(Kh));
        LoraSched S{(const char*)(ws + WS_LIN), (const char*)(ws + WS_WRW), NTOK / 256, 1536 / 256, Kl, C.G, C.bid};
        EpiLora E{ws, a.in(7), a.in(9)};
        pg8::gemm_phase<EpiLora, LoraSched, false>(C.lds, Kl, S, E, Kh);
    }
    SEAM(3);
    if (IN(4)) phase_rwkv_pre(a, C);
    SEAM(4);
    if (IN(5)) {
        if (C.G > 96) { if (C.bid < 64) { Ctx C2 = C; C2.G = 64; phase_rwkv_seq(a, C2); phase0_moe(a, C2); } else { Ctx C2 = C; C2.bid = C.bid - 64; C2.G = C.G - 64;
              unsigned* kvc = (unsigned*)(ws + WS_CTL) + CW_KV;
              if (C2.bid < 32) {
                  DenseSched S{(const char*)(ws + WS_MEMN), (const char*)(ws + WS_WMKV), NMEM / 256, 1024 / 256, 1024, 32, C2.bid};
                  EpiPlain E{(bf16_t*)(ws + WS_KVM), 1024};
                  pg8::gemm_phase<EpiPlain, DenseSched, false>(C.lds, 1024, S, E);
                  asm volatile("s_waitcnt vmcnt(0)" ::: "memory"); __syncthreads();
                  if (threadIdx.x == 0) { __builtin_amdgcn_fence(__ATOMIC_RELEASE, "agent"); asm volatile("s_waitcnt vmcnt(0)" ::: "memory"); (void)__hip_atomic_fetch_add(kvc, 1u, __ATOMIC_RELAXED, __HIP_MEMORY_SCOPE_AGENT); }
              }
              phase_swa(a, C2);
              if (threadIdx.x == 0) { unsigned sp = 0; while (__hip_atomic_load(kvc, __ATOMIC_RELAXED, __HIP_MEMORY_SCOPE_AGENT) < 32u && ++sp < (1u << 24)) __builtin_amdgcn_s_sleep(2);
                  __builtin_amdgcn_fence(__ATOMIC_ACQUIRE, "agent"); asm volatile("s_waitcnt vmcnt(0)" ::: "memory"); }
              __syncthreads();
              phase_mem(a, C2);
              phase0_moe(a, C2); } }
        else { phase_rwkv_seq(a, C); phase_swa(a, C); phase_mem(a, C); phase0_moe(a, C); }
    }
    SEAM(5);
    if (IN(6)) {
        int KE = 512; asm volatile("" : "+s"(KE));
        EpiGateNT E{(bf16_t*)(ws + WS_P), (bf16_t*)(ws + WS_GATE), a.in(5), 1.0f / W8_SCALE};
        { GateSched S{(const char*)(ws + WS_XN8), (const char*)(ws + WS_WG8), NTOK / 256, 4, KE, C.G, C.bid};
          pg8::gemm_phase<EpiGateNT, GateSched, false, true>(C.lds, KE, S, E); }
    }
    STAMP(7);
    if (IN(7)) {
        BranchSched S{(const char*)ws, (const char*)(ws + WS_WBR), NTOK / 256, 4, C.G, C.bid};
        EpiBranch E{(bf16_t*)(ws + WS_MERGED), (const bf16_t*)(ws + WS_GATE)};
        pg8::gemm_phase<EpiBranch, BranchSched, false>(C.lds, 512, S, E);
    }
    SEAM(7);
    if (IN(8)) {
        DenseSched S{(const char*)(ws + WS_MERGED), (const char*)(ws + WS_WOUT), NTOK / 256, 4, 1024, C.G, C.bid};
        EpiOut E{a.in(0), (bf16_t*)(ws + WS_H1B)};
        pg8::gemm_phase<EpiOut, DenseSched, false>(C.lds, 1024, S, E);
    }
    SEAM(8);
    if (IN(9)) phase_router(a, C);
    SEAM(9);
    if (IN(10)) phase_slots(a, C);
    SEAM(10);
    if (IN(11)) {
        const int ntiles = __builtin_amdgcn_readfirstlane((int)__hip_atomic_load((unsigned*)(ws + WS_CTL) + CW_NTILES, __ATOMIC_RELAXED, __HIP_MEMORY_SCOPE_AGENT));
        int KE = MOE_FP8 ? 512 : 1024; asm volatile("" : "+s"(KE));
        LAS int* te_lds = (LAS int*)(C.lds + pg8::STAGE_BYTES + 8192);
        { const int* _te = (const int*)(ws + MS_TILEE); const int _i0 = threadIdx.x, _i1 = threadIdx.x + 512; const int _t0 = _te[_i0 < ntiles ? _i0 : 0], _t1 = _te[(_i1 < 544 && _i1 < ntiles) ? _i1 : 0]; te_lds[_i0] = _t0; if (_i1 < 544) te_lds[_i1] = _t1; }
        __syncthreads();
        MoeSched S{(const char*)(ws + WS_HB), (const char*)(ws + WS_W1T), (const int*)(ws + MS_TILEE), (const int*)(ws + MS_SLOTTOK), ntiles, 8, KE, C.G, C.bid, (size_t)2048 * KE * 2, te_lds};
        EpiUp E{(bf16_t*)(ws + WS_ACT), a.in(26), (const float*)(ws + MS_SLOTRS)};
        pg8::gemm_phase<EpiUp, MoeSched, true, MOE_FP8 != 0>(C.lds, KE, S, E);
    }
    SEAM(11);
    if (IN(12)) {
        const int ntiles = __builtin_amdgcn_readfirstlane((int)__hip_atomic_load((unsigned*)(ws + WS_CTL) + CW_NTILES, __ATOMIC_RELAXED, __HIP_MEMORY_SCOPE_AGENT));
        int KE = MOE_FP8 ? 512 : 1024; asm volatile("" : "+s"(KE));
        LAS int* te_lds = (LAS int*)(C.lds + pg8::STAGE_BYTES + 8192);
        { const int* _te = (const int*)(ws + MS_TILEE); const int _i0 = threadIdx.x, _i1 = threadIdx.x + 512; const int _t0 = _te[_i0 < ntiles ? _i0 : 0], _t1 = _te[(_i1 < 544 && _i1 < ntiles) ? _i1 : 0]; te_lds[_i0] = _t0; if (_i1 < 544) te_lds[_i1] = _t1; }
        __syncthreads();
        MoeSched2 S{(const char*)(ws + WS_ACT), (const char*)(ws + WS_W2T), (const int*)(ws + MS_TILEE), ntiles, 4, KE, C.G, C.bid, (size_t)1024 * KE * 2, te_lds};
        EpiDown E{(bf16_t*)(ws + WS_YSLOT), a.in(28), (const float*)(ws + MS_SLOTG)};
        pg8::gemm_phase<EpiDown, MoeSched2, false, MOE_FP8 != 0>(C.lds, KE, S, E);
    }
    SEAM(12);
    if (IN(13)) phase_final(a, C);
#ifdef PROBE_A
    STAMP(14);
    __syncthreads();
    if (blockIdx.x == 0 && threadIdx.x == 0) {
        asm volatile("s_waitcnt vmcnt(0)" ::: "memory");
        const unsigned long long* ts = (const unsigned long long*)(ws + WS_CTL + 4096);
        const float da = (float)(ts[PROBE_A + 1] - ts[PROBE_A]) * 0.001f;
        a.out()[0] += da;
        const unsigned long long db = (ts[PROBE_B + 1] - ts[PROBE_B]) * 4ull;
        const unsigned long long t0 = __builtin_amdgcn_s_memrealtime();
        while (__builtin_amdgcn_s_memrealtime() - t0 < db) __builtin_amdgcn_s_sleep(8);
    }
#endif
#undef IN
#undef SEAM
#undef ws
}

#ifndef MK_MULTI
#define MK_MULTI 0
#endif
extern "C" void kernel_launch(void* const* d_in, const int* in_sizes, int n_in, void* d_out, int out_size, void* d_ws, size_t ws_size, hipStream_t stream) {
    static int grid = 0;
    if (grid == 0) {
        int dev = 0, cus = 0, per_cu = 0;
        if (n_in != 30 || ws_size < WS_END) { fprintf(stderr, "kernel_launch: unexpected n_in %d / ws %zu\n", n_in, ws_size); grid = -1; return; }
        (void)hipGetDevice(&dev); (void)hipDeviceGetAttribute(&cus, hipDeviceAttributeMultiprocessorCount, dev);
        (void)hipFuncSetAttribute((const void*)mega, hipFuncAttributeMaxDynamicSharedMemorySize, LDS_BYTES);
        (void)hipOccupancyMaxActiveBlocksPerMultiprocessor(&per_cu, (const void*)mega, 512, LDS_BYTES);
        (void)hipGetLastError();
        if (per_cu < 1) per_cu = 1;
        grid = cus;
        fprintf(stderr, "kernel_launch: cus %d per_cu %d grid %d ws %zu\n", cus, per_cu, grid, ws_size);
    }
    if (grid < 0) return;
    (void)hipMemsetAsync((char*)d_ws + WS_CTL, 0, CTL_BYTES, stream);
    Args a{};
    for (int i = 0; i < 30; ++i) a.in[i] = (const float*)d_in[i];
    a.out = (float*)d_out; a.ws = (unsigned char*)d_ws;
#if MK_MULTI
    for (int p = 0; p < N_PHASES; ++p) { a.ph_lo = p; a.ph_hi = p + 1; hipLaunchKernelGGL(mega, dim3(grid), dim3(512), LDS_BYTES, stream, a); }
#else
    a.ph_lo = 0; a.ph_hi = N_PHASES;
    void* args[] = {&a};
    hipError_t e = hipLaunchCooperativeKernel((const void*)mega, dim3(grid), dim3(512), args, LDS_BYTES, stream);
    if (e != hipSuccess) fprintf(stderr, "cooperative launch failed: %s (grid %d)\n", hipGetErrorString(e), grid);
#endif
}
```
